# Optimizing an MI355X kernel written in HIP

```python
import math
import jax, jax.numpy as jnp
from jax import lax
import numpy as np

D_MODEL = 2048
BATCH = 4
SEQ = 4096
DEPTH = 1

EPS = 1e-6
ROPE_THETA = 10000.0
NEG = -1e30
Q_BLOCK = 128

MIX_WIDTH = D_MODEL
MLA_NOPE = 128
MLA_ROPE = 64
MLA_V = 128
MLA_WIDTH = MIX_WIDTH // 2
MLA_HEADS = MLA_WIDTH // MLA_V
MLA_Q_RANK = 768
MLA_KV_RANK = 512
MLA_QK = MLA_NOPE + MLA_ROPE
DIL_WIDTH = MIX_WIDTH - MLA_WIDTH
DIL_HEAD_DIM = 128
DIL_HEADS = DIL_WIDTH // DIL_HEAD_DIM
DIL_PATTERNS = ((128, 1), (512, 4), (2048, 16))

IN_SPLITS = (MLA_Q_RANK, MLA_KV_RANK, MLA_ROPE, MLA_WIDTH, 3 * DIL_WIDTH, DIL_WIDTH)
IN_COLS = MLA_Q_RANK + MLA_KV_RANK + MLA_ROPE + MLA_WIDTH + 3 * DIL_WIDTH + DIL_WIDTH

kernel_name = "hybrid_mla_dilated_parallel_heads"


def rmsnorm(x, g):
    xf = x.astype(jnp.float32)
    y = xf * lax.rsqrt(jnp.mean(xf * xf, axis=-1, keepdims=True) + EPS)
    return (y * g.astype(jnp.float32)).astype(x.dtype)


def rope(x, pos):
    d = x.shape[-1]
    inv = ROPE_THETA ** (-jnp.arange(0, d, 2, dtype=jnp.float32) / d)
    ang = pos.astype(jnp.float32)[:, None] * inv[None, :]
    cos = jnp.cos(ang)[:, None, :]
    sin = jnp.sin(ang)[:, None, :]
    xf = x.astype(jnp.float32)
    x1, x2 = xf[..., : d // 2], xf[..., d // 2:]
    out = jnp.concatenate([x1 * cos - x2 * sin, x2 * cos + x1 * sin], axis=-1)
    return out.astype(x.dtype)


def split_cols(proj):
    parts, off = [], 0
    for n in IN_SPLITS:
        parts.append(proj[..., off:off + n])
        off += n
    return parts


def causal_block_attention(q, k, v, scale):
    B, S, H, Dk = q.shape
    Dv = v.shape[-1]
    nb = S // Q_BLOCK
    qb = q.astype(jnp.float32).reshape(B, nb, Q_BLOCK, H, Dk).transpose(1, 0, 2, 3, 4)
    kf = k.astype(jnp.float32)
    vf = v.astype(jnp.float32)
    kpos = jnp.arange(S)

    def one_block(args):
        i, qi = args
        s = jnp.einsum('bqhd,bkhd->bhqk', qi, kf) * scale
        qpos = i * Q_BLOCK + jnp.arange(Q_BLOCK)
        s = jnp.where(kpos[None, :] <= qpos[:, None], s, NEG)
        p = jax.nn.softmax(s, axis=-1)
        return jnp.einsum('bhqk,bkhd->bqhd', p, vf)

    out = lax.map(one_block, (jnp.arange(nb), qb))
    return out.transpose(1, 0, 2, 3, 4).reshape(B, S, H, Dv)


def dilated_window_attention(q, k, v, window, dilation):
    B, S, H, D = q.shape
    n_back = window // dilation
    L = S // dilation
    nb = -(-L // Q_BLOCK)
    Lp = nb * Q_BLOCK

    def sub(t):
        t = t.astype(jnp.float32).reshape(B, L, dilation, H, D).transpose(0, 2, 1, 3, 4)
        return jnp.pad(t, ((0, 0), (0, 0), (0, Lp - L), (0, 0), (0, 0)))

    def band(t):
        tp = jnp.pad(t, ((0, 0), (0, 0), (Q_BLOCK, 0), (0, 0), (0, 0)))
        prev = tp[:, :, :Lp].reshape(B, dilation, nb, Q_BLOCK, H, D)
        cur = t.reshape(B, dilation, nb, Q_BLOCK, H, D)
        return jnp.concatenate([prev, cur], axis=3)

    qb = sub(q).reshape(B, dilation, nb, Q_BLOCK, H, D)
    kb = band(sub(k))
    vb = band(sub(v))
    s = jnp.einsum('brnqhd,brnkhd->brnhqk', qb, kb) * (1.0 / math.sqrt(D))
    qi = jnp.arange(Q_BLOCK)[:, None]
    kj = jnp.arange(2 * Q_BLOCK)[None, :]
    dist = qi + Q_BLOCK - kj
    key_idx = jnp.arange(nb)[:, None, None] * Q_BLOCK + kj[None] - Q_BLOCK
    mask = (dist[None] >= 0) & (dist[None] <= n_back) & (key_idx >= 0)
    s = jnp.where(mask[:, None], s, NEG)
    m = jnp.max(s, axis=-1, keepdims=True)
    e = jnp.exp(s - m)
    den = jnp.sum(e, axis=-1, keepdims=True)
    o = jnp.einsum('brnhqk,brnkhd->brnqhd', e / den, vb)
    lse = (m + jnp.log(den))[..., 0]
    o = o.reshape(B, dilation, Lp, H, D)[:, :, :L].transpose(0, 2, 1, 3, 4).reshape(B, S, H, D)
    lse = lse.transpose(0, 1, 2, 4, 3).reshape(B, dilation, Lp, H)[:, :, :L]
    lse = lse.transpose(0, 2, 1, 3).reshape(B, S, H)
    return o, lse


def setup_inputs(seed: int = 0) -> dict:
    key = jax.random.key(seed)
    ks = jax.random.split(key, 16)

    def gain(k, n):
        return 1.0 + 0.02 * jax.random.normal(k, (DEPTH, n), jnp.float32)

    def w(k, fan_in, fan_out):
        return jax.random.normal(k, (DEPTH, fan_in, fan_out), jnp.float32) * fan_in ** -0.5

    return {
        "x": jax.random.normal(ks[0], (BATCH, SEQ, D_MODEL), jnp.float32),
        "norm_gain": gain(ks[1], D_MODEL),
        "w_in": w(ks[2], D_MODEL, IN_COLS),
        "q_a_norm_gain": gain(ks[3], MLA_Q_RANK),
        "kv_a_norm_gain": gain(ks[4], MLA_KV_RANK),
        "w_uq": w(ks[5], MLA_Q_RANK, MLA_HEADS * MLA_QK),
        "w_ukv": w(ks[6], MLA_KV_RANK, MLA_HEADS * (MLA_NOPE + MLA_V)),
        "mla_q_norm_gain": gain(ks[7], MLA_QK),
        "mla_k_norm_gain": gain(ks[8], MLA_QK),
        "dil_q_norm_gain": gain(ks[9], DIL_HEAD_DIM),
        "dil_k_norm_gain": gain(ks[10], DIL_HEAD_DIM),
        "mla_out_norm_gain": gain(ks[11], MLA_WIDTH),
        "dil_out_norm_gain": gain(ks[12], DIL_WIDTH),
        "w_out": w(ks[13], MIX_WIDTH, D_MODEL),
    }


def reference(x, norm_gain, w_in, q_a_norm_gain, kv_a_norm_gain, w_uq, w_ukv,
              mla_q_norm_gain, mla_k_norm_gain, dil_q_norm_gain, dil_k_norm_gain,
              mla_out_norm_gain, dil_out_norm_gain, w_out):
    B, S, _ = x.shape
    pos = jnp.arange(S, dtype=jnp.int32)
    h = x
    for l in range(DEPTH):
        hn = rmsnorm(h, norm_gain[l])
        proj = jnp.einsum('bsd,de->bse', hn, w_in[l])
        c_q, c_kv, k_r, g_a, qkv_b, g_b = split_cols(proj)

        gq, gk = mla_q_norm_gain[l], mla_k_norm_gain[l]
        q_a = jnp.einsum('bsr,re->bse', rmsnorm(c_q, q_a_norm_gain[l]), w_uq[l])
        q_a = q_a.reshape(B, S, MLA_HEADS, MLA_QK)
        kv_a = jnp.einsum('bsr,re->bse', rmsnorm(c_kv, kv_a_norm_gain[l]), w_ukv[l])
        kv_a = kv_a.reshape(B, S, MLA_HEADS, MLA_NOPE + MLA_V)
        q_nope = rmsnorm(q_a[..., :MLA_NOPE], gq[:MLA_NOPE])
        q_rope = rope(rmsnorm(q_a[..., MLA_NOPE:], gq[MLA_NOPE:]), pos)
        k_nope = rmsnorm(kv_a[..., :MLA_NOPE], gk[:MLA_NOPE])
        v_a = kv_a[..., MLA_NOPE:]
        k_rope = rope(rmsnorm(k_r, gk[MLA_NOPE:])[:, :, None, :], pos)
        q_full = jnp.concatenate([q_nope, q_rope], axis=-1)
        k_full = jnp.concatenate(
            [k_nope, jnp.broadcast_to(k_rope, (B, S, MLA_HEADS, MLA_ROPE))], axis=-1)
        o_a = causal_block_attention(q_full, k_full, v_a, 1.0 / math.sqrt(MLA_QK))
        o_a = o_a.reshape(B, S, MLA_WIDTH).astype(h.dtype)
        y_a = rmsnorm(o_a, mla_out_norm_gain[l]) * jax.nn.silu(g_a)

        q_b, k_b, v_b = jnp.split(qkv_b, 3, axis=-1)
        q_b = rope(rmsnorm(q_b.reshape(B, S, DIL_HEADS, DIL_HEAD_DIM), dil_q_norm_gain[l]), pos)
        k_b = rope(rmsnorm(k_b.reshape(B, S, DIL_HEADS, DIL_HEAD_DIM), dil_k_norm_gain[l]), pos)
        v_b = v_b.reshape(B, S, DIL_HEADS, DIL_HEAD_DIM)
        outs, lses = [], []
        for window, dilation in DIL_PATTERNS:
            o_p, lse_p = dilated_window_attention(q_b, k_b, v_b, window, dilation)
            outs.append(o_p)
            lses.append(lse_p)
        wts = jax.nn.softmax(jnp.stack(lses, axis=0), axis=0)
        o_b = jnp.sum(wts[..., None] * jnp.stack(outs, axis=0), axis=0)
        o_b = o_b.reshape(B, S, DIL_WIDTH).astype(h.dtype)
        y_b = rmsnorm(o_b, dil_out_norm_gain[l]) * jax.nn.silu(g_b)

        y = jnp.concatenate([y_a, y_b], axis=-1)
        h = h + jnp.einsum('bse,ed->bsd', y, w_out[l])
    return h
```

```cpp
#include <hip/hip_runtime.h>
#include <hip/hip_cooperative_groups.h>
#include <cstdio>
#include <cstdint>
namespace cg = cooperative_groups;
#define MK_N_LAUNCHES 1
#define NAIVE_ATTN 1
namespace pg8 {
#define PG8_LAS __attribute__((address_space(3)))
typedef unsigned short bf16_t;
typedef short bf16x8 __attribute__((ext_vector_type(8)));
typedef float f32x4 __attribute__((ext_vector_type(4)));
typedef unsigned u32x4 __attribute__((ext_vector_type(4)));
constexpr int BM = 256, BK = 64, HALF = 128, HTB = HALF * BK * 2  , STAGE_BYTES = 8 * HTB, NXCD = 8, WGM = 8;

__host__ __device__ __forceinline__ int lds_byte(int r, int c) { const int st = (r >> 4) * 2 + (c >> 5), rr = r & 15, cc = c & 31, ob = rr * 64 + cc * 2; return st * 1024 + (ob ^ (((ob >> 9) & 1) << 5)); }
__host__ __device__ __forceinline__ void stage_rc(int b, int& R, int& C) { const int st = b / 1024, sb = b % 1024, swz = sb ^ (((sb >> 9) & 1) << 5); R = (st >> 1) * 16 + swz / 64; C = (st & 1) * 32 + (swz % 64) / 2; }
__host__ __device__ __forceinline__ int perm32(int rho) { const int n = rho >> 4, i = rho & 15; return 8 * (i >> 2) + 4 * n + (i & 3); }

struct Unit { int pm, pn; };
struct Gemm { const bf16_t* A; const bf16_t* Bt; int M, N, K, lda; };

struct StaticOrder {
    int nM, nN, nwg, G, c;
    __host__ __device__ void init(int M, int N, int G_, int c_) { nM = M / BM; nN = N / BM; nwg = nM * nN; G = G_; c = c_; }
    __host__ __device__ bool next(int i, Unit& u) const {
        const long L = (long)i * G + c; if (L >= nwg) return false;
        int wgid = (int)L; { const int q = nwg / NXCD, r = nwg % NXCD, xcd = wgid % NXCD, off = wgid / NXCD; wgid = (xcd < r ? xcd * (q + 1) : r * (q + 1) + (xcd - r) * q) + off; }
        const int nig = WGM * nN, gid = wgid / nig, fm = gid * WGM, gsz = (nM - fm) < WGM ? (nM - fm) : WGM;
        u.pm = fm + ((wgid % nig) % gsz); u.pn = (wgid % nig) / gsz; return true;
    }
    __device__ __forceinline__ void a_ready(const Unit&) const {}
    __device__ __forceinline__ void done(const Unit&) const {}
};

__device__ __forceinline__ unsigned cvt_pk_bf16(float lo, float hi) { unsigned r; asm volatile("v_cvt_pk_bf16_f32 %0, %1, %2" : "=v"(r) : "v"(lo), "v"(hi)); return r; }
typedef float f32x2 __attribute__((ext_vector_type(2)));
__device__ __forceinline__ f32x2 gelu_pk(f32x2 v) {
    const f32x2 av = __builtin_elementwise_abs(v), d = av * 0.2316418882f + 1.0f;
    f32x2 t; t.x = __builtin_amdgcn_rcpf(d.x); t.y = __builtin_amdgcn_rcpf(d.y);
    f32x2 q = t * 0.5307027145f + (-0.7265760135f); q = q * t + 0.7107068705f; q = q * t + (-0.142248368f); q = q * t + 0.127414796f; q = q * t;
    const f32x2 s = (v * v) * (-0.72134752044f);
    f32x2 e; e.x = __builtin_amdgcn_exp2f(s.x); e.y = __builtin_amdgcn_exp2f(s.y);
    const f32x2 m = v * (q * e), r = v - m;
    f32x2 o; o.x = v.x < 0.f ? m.x : r.x; o.y = v.y < 0.f ? m.y : r.y; return o;
}

template <int ACT  > struct EpiBf16 {
    static constexpr bool PERM = true, AFTER_DRAIN = false; static_assert(ACT == 0 || ACT == 1, "EpiBf16: ACT is 0 (none) or 1 (gelu_pk)");
    bf16_t* O; int ldc; const float* bias; int split_cols; size_t split_stride; float scale0;
    __device__ __forceinline__ void operator()(const f32x4 (&acc)[2][2][4][2], const Unit& u, int wr, int wc, int fr, int fq) const {
        const int row0 = u.pm * BM + wr * 64 + fr; int colt = u.pn * BM; bf16_t* base = O;
        float sc = 1.f; if (split_cols) { const int t = colt / split_cols; base += (size_t)t * split_stride; colt -= t * split_cols; if (t == 0) sc = scale0; }
        const int col0 = colt + wc * 32 + 8 * fq, bcol0 = u.pn * BM + wc * 32 + 8 * fq;
        f32x4 bv[2][2];
#pragma unroll
        for (int bj = 0; bj < 2; ++bj)
#pragma unroll
            for (int n = 0; n < 2; ++n) bv[bj][n] = bias ? *(const f32x4*)(bias + bcol0 + bj * HALF + 4 * n) : (f32x4){0.f, 0.f, 0.f, 0.f};
#pragma unroll
        for (int ai = 0; ai < 2; ++ai)
#pragma unroll
            for (int m = 0; m < 4; ++m) { bf16_t* rowp = base + (size_t)(row0 + ai * HALF + m * 16) * ldc + col0;
#pragma unroll
                for (int bj = 0; bj < 2; ++bj) { f32x4 v0 = acc[ai][bj][m][0] + bv[bj][0], v1 = acc[ai][bj][m][1] + bv[bj][1];
                    if (ACT == 1) { f32x2 a = gelu_pk((f32x2){v0[0], v0[1]}), b = gelu_pk((f32x2){v0[2], v0[3]}), c = gelu_pk((f32x2){v1[0], v1[1]}), d = gelu_pk((f32x2){v1[2], v1[3]});
                        v0 = (f32x4){a.x, a.y, b.x, b.y}; v1 = (f32x4){c.x, c.y, d.x, d.y}; }
                    v0 = v0 * sc; v1 = v1 * sc; u32x4 w; w.x = cvt_pk_bf16(v0[0], v0[1]); w.y = cvt_pk_bf16(v0[2], v0[3]); w.z = cvt_pk_bf16(v1[0], v1[1]); w.w = cvt_pk_bf16(v1[2], v1[3]);
                    *(u32x4*)(rowp + bj * HALF) = w; } }
    }
};

struct EpiResF32 {
    static constexpr bool PERM = true, AFTER_DRAIN = false;
    const float* base; float* out; int ldc;
    __device__ __forceinline__ void operator()(const f32x4 (&acc)[2][2][4][2], const Unit& u, int wr, int wc, int fr, int fq) const {
        const int row0 = u.pm * BM + wr * 64 + fr, col0 = u.pn * BM + wc * 32 + 8 * fq;
#pragma unroll
        for (int ai = 0; ai < 2; ++ai)
#pragma unroll
            for (int m = 0; m < 4; ++m) { const size_t off = (size_t)(row0 + ai * HALF + m * 16) * ldc + col0;
#pragma unroll
                for (int bj = 0; bj < 2; ++bj) {
                    const f32x4 b0 = *(const f32x4*)(base + off + bj * HALF), b1 = *(const f32x4*)(base + off + bj * HALF + 4);
                    *(f32x4*)(out + off + bj * HALF) = acc[ai][bj][m][0] + b0; *(f32x4*)(out + off + bj * HALF + 4) = acc[ai][bj][m][1] + b1; } }
    }
};
template <class Epi, class Sched, bool ALIGN_EPI = false, bool SP2 = false>
__device__ __forceinline__ void gemm_phase(PG8_LAS unsigned char* lds, const Gemm g, const Sched& S, const Epi& E) {
    const int tid = threadIdx.x, wid = __builtin_amdgcn_readfirstlane(tid >> 6), lane = tid & 63, wr = wid >> 2, wc = wid & 3, fr = lane & 15, fq = lane >> 4;
    const int K = g.K, nt = K / BK;
    unsigned voffA[2], voffB[2];
#pragma unroll
    for (int i = 0; i < 2; ++i) { int R, C; stage_rc(tid * 16 + i * 8192, R, C); const int Rb = Epi::PERM ? ((R & ~31) + perm32(R & 31)) : R;
        voffA[i] = (unsigned)(R * g.lda + C) * 2u; voffB[i] = (unsigned)(Rb * K + C) * 2u; }
    const size_t kstep = (size_t)(BK * 2);
    const size_t hstepA = (size_t)HALF * g.lda * 2, hstepB = (size_t)HALF * K * 2;
    const size_t tstepA = 2 * hstepA, tstepB = 2 * hstepB;
    const unsigned ldsw = (unsigned)wid * 1024u;
    const int aoff = lds_byte(wr * 64 + fr, fq * 8), boff = lds_byte(wc * 32 + fr, fq * 8);
#define PG8_SA(b, h) (((b) * 2 + (h)) * HTB)
#define PG8_SB(b, h) ((4 + (b) * 2 + (h)) * HTB)
#define PG8_STAGE(bufoff, gbase, voff) do { _Pragma("unroll") for (int _i = 0; _i < 2; ++_i) \
        __builtin_amdgcn_global_load_lds((const unsigned*)((const char*)(gbase) + (voff)[_i]), (PG8_LAS unsigned*)(lds + (bufoff) + ldsw + _i * 8192), 16, 0, 0); } while (0)
#define PG8_LDA(dst, b, h) do { _Pragma("unroll") for (int m = 0; m < 4; ++m) _Pragma("unroll") for (int k = 0; k < 2; ++k) dst[m][k] = *(const PG8_LAS bf16x8*)(lds + PG8_SA(b, h) + aoff + m * 2048 + k * 1024); } while (0)
#define PG8_LDB(dst, b, h) do { _Pragma("unroll") for (int n = 0; n < 2; ++n) _Pragma("unroll") for (int k = 0; k < 2; ++k) dst[n][k] = *(const PG8_LAS bf16x8*)(lds + PG8_SB(b, h) + boff + n * 2048 + k * 1024); } while (0)
#define PG8_MMA(ai, bj, At, Bt) do { __builtin_amdgcn_s_setprio(1); _Pragma("unroll") for (int m = 0; m < 4; ++m) _Pragma("unroll") for (int n = 0; n < 2; ++n) _Pragma("unroll") for (int k = 0; k < 2; ++k) \
        acc[ai][bj][m][n] = __builtin_amdgcn_mfma_f32_16x16x32_bf16(Bt[n][k], At[m][k], acc[ai][bj][m][n], 0, 0, 0); __builtin_amdgcn_s_setprio(0); } while (0)
#define PG8_WAIT_V(n) asm volatile("s_waitcnt vmcnt(" #n ")" ::: "memory")
#define PG8_WAIT_L(n) asm volatile("s_waitcnt lgkmcnt(" #n ")" ::: "memory")
#define PG8_BAR __builtin_amdgcn_s_barrier()
#define PG8_SCHED __builtin_amdgcn_sched_barrier(0)
    Unit cur, nxt; int ui = 0;
    if (!S.next(0, cur)) return;
    f32x4 acc[2][2][4][2];
#pragma unroll
    for (int a = 0; a < 2; ++a)
#pragma unroll
        for (int b = 0; b < 2; ++b)
#pragma unroll
            for (int m = 0; m < 4; ++m)
#pragma unroll
                for (int n = 0; n < 2; ++n) acc[a][b][m][n] = (f32x4){0.f, 0.f, 0.f, 0.f};
    bf16x8 At[4][2], B0[2][2], B1[2][2];
    const char* cA = (const char*)g.A + (size_t)cur.pm * tstepA; const char* cB = (const char*)g.Bt + (size_t)cur.pn * tstepB;
    S.a_ready(cur);
    if constexpr (SP2) {
        PG8_STAGE(PG8_SB(0, 0), cB, voffB); PG8_STAGE(PG8_SB(0, 1), cB + hstepB, voffB); PG8_STAGE(PG8_SA(0, 0), cA, voffA); PG8_STAGE(PG8_SA(0, 1), cA + hstepA, voffA);
        if (wr == 1) PG8_BAR;
        PG8_WAIT_V(2); PG8_BAR;
        PG8_STAGE(PG8_SB(1, 0), cB + kstep, voffB); PG8_STAGE(PG8_SA(1, 0), cA + kstep, voffA); PG8_STAGE(PG8_SB(1, 1), cB + hstepB + kstep, voffB);
        PG8_WAIT_V(6); PG8_BAR;
    } else {
        PG8_STAGE(PG8_SB(0, 0), cB, voffB); PG8_STAGE(PG8_SA(0, 0), cA, voffA); PG8_STAGE(PG8_SB(0, 1), cB + hstepB, voffB); PG8_STAGE(PG8_SA(0, 1), cA + hstepA, voffA);
        if (wr == 1) PG8_BAR;
        PG8_WAIT_V(4); PG8_BAR;
        PG8_STAGE(PG8_SB(1, 0), cB + kstep, voffB); PG8_STAGE(PG8_SA(1, 0), cA + kstep, voffA); PG8_STAGE(PG8_SB(1, 1), cB + hstepB + kstep, voffB);
        PG8_WAIT_V(6); PG8_BAR;
    }
    for (;;) {
        const bool has_next = S.next(ui + 1, nxt);
        const char* nA = has_next ? (const char*)g.A + (size_t)nxt.pm * tstepA : cA; const char* nB = has_next ? (const char*)g.Bt + (size_t)nxt.pn * tstepB : cB;
        for (int t = 0; t < nt; t += 2) {
            const bool last = (t == nt - 2);
            const char* a1 = cA + (size_t)(t + 1) * kstep;
            const char* a2 = last ? nA : cA + (size_t)(t + 2) * kstep; const char* b2 = last ? nB : cB + (size_t)(t + 2) * kstep;
            const char* a3 = a2 + kstep; const char* b3 = b2 + kstep;
            if (last && has_next) S.a_ready(nxt);
            if constexpr (SP2) {
            PG8_LDB(B0, 0, 0); PG8_LDB(B1, 0, 1); PG8_SCHED; PG8_LDA(At, 0, 0); PG8_STAGE(PG8_SA(1, 1), a1 + hstepA, voffA);
            PG8_WAIT_V(8); PG8_WAIT_L(0); PG8_BAR; PG8_MMA(0, 0, At, B0); PG8_MMA(0, 1, At, B1); PG8_BAR; PG8_SCHED;
            PG8_LDA(At, 0, 1); PG8_STAGE(PG8_SB(0, 0), b2, voffB); PG8_STAGE(PG8_SB(0, 1), b2 + hstepB, voffB); PG8_STAGE(PG8_SA(0, 0), a2, voffA);
            PG8_WAIT_V(8); PG8_WAIT_L(0); PG8_BAR; PG8_MMA(1, 0, At, B0); PG8_MMA(1, 1, At, B1); PG8_BAR; PG8_SCHED;
            PG8_LDB(B0, 1, 0); PG8_LDB(B1, 1, 1); PG8_SCHED; PG8_LDA(At, 1, 0); PG8_STAGE(PG8_SA(0, 1), a2 + hstepA, voffA);
            PG8_WAIT_V(8); PG8_WAIT_L(0); PG8_BAR; PG8_MMA(0, 0, At, B0); PG8_MMA(0, 1, At, B1); PG8_BAR; PG8_SCHED;
            PG8_LDA(At, 1, 1); PG8_STAGE(PG8_SB(1, 0), b3, voffB); PG8_STAGE(PG8_SB(1, 1), b3 + hstepB, voffB); PG8_STAGE(PG8_SA(1, 0), a3, voffA);
            PG8_WAIT_V(8); PG8_WAIT_L(0); PG8_BAR; PG8_MMA(1, 0, At, B0); PG8_MMA(1, 1, At, B1); PG8_BAR; PG8_SCHED;
            } else {
            PG8_LDB(B0, 0, 0); PG8_SCHED; PG8_LDA(At, 0, 0); PG8_STAGE(PG8_SA(1, 1), a1 + hstepA, voffA);
            PG8_WAIT_L(8); PG8_BAR; PG8_WAIT_L(0); PG8_MMA(0, 0, At, B0); PG8_BAR; PG8_SCHED;
            PG8_LDB(B1, 0, 1); PG8_STAGE(PG8_SB(0, 0), b2, voffB);
            PG8_BAR; PG8_WAIT_L(0); PG8_MMA(0, 1, At, B1); PG8_BAR;
            PG8_LDA(At, 0, 1); PG8_STAGE(PG8_SA(0, 0), a2, voffA);
            PG8_BAR; PG8_WAIT_L(0); PG8_MMA(1, 0, At, B0); PG8_BAR; PG8_SCHED;
            PG8_STAGE(PG8_SB(0, 1), b2 + hstepB, voffB);
            PG8_WAIT_V(6); PG8_BAR; PG8_MMA(1, 1, At, B1); PG8_BAR;
            PG8_LDB(B0, 1, 0); PG8_SCHED; PG8_LDA(At, 1, 0); PG8_STAGE(PG8_SA(0, 1), a2 + hstepA, voffA);
            PG8_WAIT_L(8); PG8_BAR; PG8_WAIT_L(0); PG8_MMA(0, 0, At, B0); PG8_BAR; PG8_SCHED;
            PG8_LDB(B1, 1, 1); PG8_STAGE(PG8_SB(1, 0), b3, voffB);
            PG8_BAR; PG8_WAIT_L(0); PG8_MMA(0, 1, At, B1); PG8_BAR;
            PG8_LDA(At, 1, 1); PG8_STAGE(PG8_SA(1, 0), a3, voffA);
            PG8_BAR; PG8_WAIT_L(0); PG8_MMA(1, 0, At, B0); PG8_BAR; PG8_SCHED;
            PG8_STAGE(PG8_SB(1, 1), b3 + hstepB, voffB);
            PG8_WAIT_V(6); PG8_BAR; PG8_MMA(1, 1, At, B1); PG8_BAR;
            }
        }
        if constexpr (ALIGN_EPI) { if (wr == 0) PG8_BAR; }
        if constexpr (!Epi::AFTER_DRAIN) { E(acc, cur, wr, wc, fr, fq); S.done(cur); }
        if (!has_next) break;
#pragma unroll
        for (int a = 0; a < 2; ++a)
#pragma unroll
            for (int b = 0; b < 2; ++b)
#pragma unroll
                for (int m = 0; m < 4; ++m)
#pragma unroll
                    for (int n = 0; n < 2; ++n) acc[a][b][m][n] = (f32x4){0.f, 0.f, 0.f, 0.f};
        cur = nxt; cA = nA; cB = nB; ++ui;
        if constexpr (ALIGN_EPI) { if (wr == 1) PG8_BAR; }
    }
    PG8_WAIT_V(0);
    if constexpr (!ALIGN_EPI) { if (wr == 0) PG8_BAR; }
    PG8_BAR;
    if constexpr (Epi::AFTER_DRAIN) { E.fused(acc, cur, wr, wc, fr, fq, lds, wid, lane); S.done(cur); }
#undef PG8_SA
#undef PG8_SB
#undef PG8_STAGE
#undef PG8_LDA
#undef PG8_LDB
#undef PG8_MMA
#undef PG8_WAIT_V
#undef PG8_WAIT_L
#undef PG8_BAR
#undef PG8_SCHED
}
}
#ifndef PG8_SP2
#define PG8_SP2 true
#endif
#ifndef PG8_ALIGN
#define PG8_ALIGN true
#endif
#ifndef MK_N_LAUNCHES
#define MK_N_LAUNCHES 1
#endif
#ifndef NAIVE_ATTN
#define NAIVE_ATTN 0
#endif

constexpr int NBATCH = 4, SEQ = 4096, DM = 2048, TOK = NBATCH * SEQ;
constexpr int NC = 6464, NCP = 6656;
constexpr int C_CQ = 0, C_CKV = 768, C_KR = 1280, C_GA = 1344, C_QB = 2368, C_KB = 3392, C_VB = 4416, C_GB = 5440;
constexpr int QA_W = 1536, KVA_W = 2048;
constexpr float EPS = 1e-6f;
constexpr float LOG2E = 1.4426950408889634f, LN2 = 0.6931471805599453f;
constexpr float QSCALE_MLA = 0.07216878364870322f * LOG2E;
constexpr float QSCALE_DIL = 0.08838834764831845f * LOG2E;
constexpr int NPH = 8;

constexpr size_t MiB = 1u << 20;
constexpr size_t WS_TAB128 = 0, WS_TAB64 = 2 * MiB;
constexpr size_t WS_WIN = 4 * MiB, WS_WUQ = 30 * MiB, WS_WUKV = 33 * MiB, WS_WOUT = 35 * MiB;
constexpr size_t WS_PROJ = 44 * MiB;
constexpr size_t WS_HN = 252 * MiB;
constexpr size_t WS_OA = 252 * MiB, WS_OD1 = 284 * MiB;
constexpr size_t WS_QA = 316 * MiB;
constexpr size_t WS_KVA = 364 * MiB;
constexpr size_t WS_OD2 = 428 * MiB, WS_OD3 = 460 * MiB;
constexpr size_t WS_LSE = 492 * MiB;
constexpr size_t WS_Y = 316 * MiB;
constexpr size_t WS_END = 494 * MiB;
constexpr int LDS_BYTES = 139264;

#define LAS __attribute__((address_space(3)))
#define DI __device__ __forceinline__
typedef unsigned short bf16_t;
typedef unsigned u32x4 __attribute__((ext_vector_type(4)));
typedef unsigned u32x2 __attribute__((ext_vector_type(2)));
typedef float f32x4 __attribute__((ext_vector_type(4)));
typedef float f32x2 __attribute__((ext_vector_type(2)));

struct Params { const float* in[14]; float* out; unsigned char* ws; int ph_lo, ph_hi; };

DI float bflo(unsigned w) { return __uint_as_float(w << 16); }
DI float bfhi(unsigned w) { return __uint_as_float(w & 0xffff0000u); }
DI unsigned pk2(float lo, float hi) { return pg8::cvt_pk_bf16(lo, hi); }
DI void unpack8(const u32x4 v, f32x4& a, f32x4& b) { a = (f32x4){bflo(v.x), bfhi(v.x), bflo(v.y), bfhi(v.y)}; b = (f32x4){bflo(v.z), bfhi(v.z), bflo(v.w), bfhi(v.w)}; }
DI u32x4 pack8(const f32x4 a, const f32x4 b) { u32x4 r; r.x = pk2(a.x, a.y); r.y = pk2(a.z, a.w); r.z = pk2(b.x, b.y); r.w = pk2(b.z, b.w); return r; }
DI float sumsq8(const f32x4 a, const f32x4 b) { return (a.x * a.x + a.y * a.y) + (a.z * a.z + a.w * a.w) + (b.x * b.x + b.y * b.y) + (b.z * b.z + b.w * b.w); }
DI float wave_sum(float v) {
#pragma unroll
    for (int o = 1; o < 64; o <<= 1) v += __shfl_xor(v, o);
    return v; }
DI float wave_max(float v) {
#pragma unroll
    for (int o = 1; o < 64; o <<= 1) v = fmaxf(v, __shfl_xor(v, o));
    return v; }
DI float grp_sum8(float v) { v += __shfl_xor(v, 1); v += __shfl_xor(v, 2); v += __shfl_xor(v, 4); return v; }
DI float grp_sum16(float v) { v = grp_sum8(v); v += __shfl_xor(v, 8); return v; }
DI float rstd_of(float ss, float inv_n) { return 1.0f / sqrtf(ss * inv_n + EPS); }
DI float silu(float x) { return x / (1.0f + __expf(-x)); }
DI f32x4 silu4(f32x4 x) { return (f32x4){silu(x.x), silu(x.y), silu(x.z), silu(x.w)}; }
DI void rope8(f32x4& a, f32x4& b, int xr, bool first, const f32x4* tab) {
    f32x4 pa, pb;
    pa.x = __shfl_xor(a.x, xr); pa.y = __shfl_xor(a.y, xr); pa.z = __shfl_xor(a.z, xr); pa.w = __shfl_xor(a.w, xr);
    pb.x = __shfl_xor(b.x, xr); pb.y = __shfl_xor(b.y, xr); pb.z = __shfl_xor(b.z, xr); pb.w = __shfl_xor(b.w, xr);
    const float sg = first ? -1.f : 1.f;
    const f32x4 t0 = tab[0], t1 = tab[1], t2 = tab[2], t3 = tab[3];
    a.x = a.x * t0.x + sg * pa.x * t0.y; a.y = a.y * t0.z + sg * pa.y * t0.w; a.z = a.z * t1.x + sg * pa.z * t1.y; a.w = a.w * t1.z + sg * pa.w * t1.w;
    b.x = b.x * t2.x + sg * pb.x * t2.y; b.y = b.y * t2.z + sg * pb.y * t2.w; b.z = b.z * t3.x + sg * pb.z * t3.y; b.w = b.w * t3.z + sg * pb.w * t3.w;
}

DI void p0_transpose_item(const float* W, int K, int N, bf16_t* WT, LAS float* scr, int item, int lane) {
    const int nblk = N / 32, kb = item / nblk, nb = item % nblk, k0 = 64 * kb, n0 = 32 * nb;
#pragma unroll 8
    for (int i = 0; i < 32; ++i) { const int kk = 2 * i + (lane >> 5); scr[kk * 33 + (lane & 31)] = W[(size_t)(k0 + kk) * N + n0 + (lane & 31)]; }
    asm volatile("s_waitcnt lgkmcnt(0)" ::: "memory");
    const int c = lane & 7;
#pragma unroll
    for (int j = 0; j < 4; ++j) { const int n = (lane >> 3) + 8 * j; const LAS float* s = scr + (8 * c) * 33 + n;
        u32x4 o; o.x = pk2(s[0 * 33], s[1 * 33]); o.y = pk2(s[2 * 33], s[3 * 33]); o.z = pk2(s[4 * 33], s[5 * 33]); o.w = pk2(s[6 * 33], s[7 * 33]);
        *(u32x4*)(WT + (size_t)(n0 + n) * K + k0 + 8 * c) = o; }
    asm volatile("s_waitcnt lgkmcnt(0)" ::: "memory");
}
DI void phase0(const Params& p, LAS unsigned char* lds, int gw, int NGW, int lane, int wave) {
    unsigned char* ws = p.ws;
    LAS float* scr = (LAS float*)(lds + wave * 16384);
    constexpr int I_IN = (DM / 64) * (NC / 32), I_UQ = (768 / 64) * (QA_W / 32), I_UKV = (512 / 64) * (KVA_W / 32), I_OUT = (DM / 64) * (DM / 32);
    constexpr int NITEMS = I_IN + I_UQ + I_UKV + I_OUT;
    for (int it = gw; it < NITEMS; it += NGW) {
        int r = it;
        if (r < I_IN) { p0_transpose_item(p.in[2], DM, NC, (bf16_t*)(ws + WS_WIN), scr, r, lane); continue; } r -= I_IN;
        if (r < I_UQ) { p0_transpose_item(p.in[5], 768, QA_W, (bf16_t*)(ws + WS_WUQ), scr, r, lane); continue; } r -= I_UQ;
        if (r < I_UKV) { p0_transpose_item(p.in[6], 512, KVA_W, (bf16_t*)(ws + WS_WUKV), scr, r, lane); continue; } r -= I_UKV;
        p0_transpose_item(p.in[13], DM, DM, (bf16_t*)(ws + WS_WOUT), scr, r, lane);
    }
    const int gt = gw * 64 + lane, NGT = NGW * 64;
    {
        u32x4* z = (u32x4*)((bf16_t*)(ws + WS_WIN) + (size_t)NC * DM);
        for (int i = gt; i < (NCP - NC) * DM / 8; i += NGT) z[i] = (u32x4){0u, 0u, 0u, 0u};
    }
    for (int i = gt; i < SEQ * 96; i += NGT) {
        int s, j; float e; f32x2* dst;
        if (i < SEQ * 64) { s = i >> 6; j = i & 63; e = (float)(2 * j) * (1.0f / 128.0f); dst = (f32x2*)(ws + WS_TAB128) + i; }
        else { const int k = i - SEQ * 64; s = k >> 5; j = k & 31; e = (float)(2 * j) * (1.0f / 64.0f); dst = (f32x2*)(ws + WS_TAB64) + k; }
        const float inv = (float)exp2(-(double)e * 13.287712379549449);
        const float ang = (float)s * inv;
        const double rev = (double)ang * 0.15915494309189535;
        const float fr = (float)(rev - rint(rev));
        *dst = (f32x2){__builtin_amdgcn_cosf(fr), __builtin_amdgcn_sinf(fr)};
    }
    const f32x4* g4 = (const f32x4*)p.in[1];
    for (int m = gw; m < TOK; m += NGW) {
        const f32x4* xr = (const f32x4*)(p.in[0] + (size_t)m * DM) + lane;
        f32x4 v[8]; float ss = 0.f;
#pragma unroll
        for (int j = 0; j < 8; ++j) { v[j] = xr[64 * j]; ss += (v[j].x * v[j].x + v[j].y * v[j].y) + (v[j].z * v[j].z + v[j].w * v[j].w); }
        const float rstd = rstd_of(wave_sum(ss), 1.0f / DM);
        u32x2* o8 = (u32x2*)((bf16_t*)(ws + WS_HN) + (size_t)m * DM) + lane;
#pragma unroll
        for (int j = 0; j < 8; ++j) { const f32x4 g = g4[64 * j + lane]; const f32x4 y = v[j] * rstd * g; o8[64 * j] = (u32x2){pk2(y.x, y.y), pk2(y.z, y.w)}; }
    }
}

DI void e1_row(const Params& p, int row, int lane) {
    unsigned char* ws = p.ws;
    const int t = row & (SEQ - 1);
    u32x4* r16 = (u32x4*)((bf16_t*)(ws + WS_PROJ) + (size_t)row * NCP);
    {
        const u32x4 v0 = r16[lane]; const u32x4 v1 = lane < 32 ? r16[64 + lane] : (u32x4){0u, 0u, 0u, 0u};
        f32x4 a0, b0, a1, b1; unpack8(v0, a0, b0); unpack8(v1, a1, b1);
        const float rstd = rstd_of(wave_sum(sumsq8(a0, b0) + sumsq8(a1, b1)), 1.0f / 768.0f);
        const f32x4* g = (const f32x4*)p.in[3];
        r16[lane] = pack8(a0 * rstd * g[2 * lane], b0 * rstd * g[2 * lane + 1]);
        if (lane < 32) r16[64 + lane] = pack8(a1 * rstd * g[2 * (64 + lane)], b1 * rstd * g[2 * (64 + lane) + 1]);
    }
    {
        f32x4 a, b; unpack8(r16[96 + lane], a, b);
        const float rstd = rstd_of(wave_sum(sumsq8(a, b)), 1.0f / 512.0f);
        const f32x4* g = (const f32x4*)p.in[4];
        r16[96 + lane] = pack8(a * rstd * g[2 * lane], b * rstd * g[2 * lane + 1]);
    }
    {
        const int c = lane & 7;
        f32x4 a, b; unpack8(r16[160 + c], a, b);
        const float rstd = rstd_of(grp_sum8(sumsq8(a, b)), 1.0f / 64.0f);
        const f32x4* g = (const f32x4*)p.in[8] + 32;
        a = a * rstd * g[2 * c]; b = b * rstd * g[2 * c + 1];
        rope8(a, b, 4, c < 4, (const f32x4*)(ws + WS_TAB64) + (t * 32 + (c & 3) * 8) / 2);
        if (lane < 8) r16[160 + c] = pack8(a, b);
    }
#pragma unroll
    for (int it = 0; it < 4; ++it) {
        const int c = lane & 15;
        u32x4* ptr = r16 + (C_QB / 8) + it * 64 + lane;
        f32x4 a, b; unpack8(*ptr, a, b);
        const float rstd = rstd_of(grp_sum16(sumsq8(a, b)), 1.0f / 128.0f);
        const f32x4* g = (const f32x4*)(it < 2 ? p.in[9] : p.in[10]);
        a = a * rstd * g[2 * c]; b = b * rstd * g[2 * c + 1];
        rope8(a, b, 8, c < 8, (const f32x4*)(ws + WS_TAB128) + (t * 64 + (c & 7) * 8) / 2);
        if (it < 2) { a = a * QSCALE_DIL; b = b * QSCALE_DIL; }
        *ptr = pack8(a, b);
    }
}

DI void e2_row(const Params& p, int row, int lane) {
    unsigned char* ws = p.ws;
    const int t = row & (SEQ - 1);
    u32x4* q16 = (u32x4*)((bf16_t*)(ws + WS_QA) + (size_t)row * QA_W);
    u32x4* kv16 = (u32x4*)((bf16_t*)(ws + WS_KVA) + (size_t)row * KVA_W);
    const f32x4* gq = (const f32x4*)p.in[7];
    const f32x4* gk = (const f32x4*)p.in[8];
#pragma unroll
    for (int it = 0; it < 2; ++it) {
        const int idx = it * 64 + lane, h = idx >> 4, c = idx & 15;
        u32x4* ptr = q16 + h * 24 + c;
        f32x4 a, b; unpack8(*ptr, a, b);
        const float rstd = rstd_of(grp_sum16(sumsq8(a, b)), 1.0f / 128.0f) * QSCALE_MLA;
        *ptr = pack8(a * rstd * gq[2 * c], b * rstd * gq[2 * c + 1]);
    }
    {
        const int h = lane >> 3, c = lane & 7;
        u32x4* ptr = q16 + h * 24 + 16 + c;
        f32x4 a, b; unpack8(*ptr, a, b);
        const float rstd = rstd_of(grp_sum8(sumsq8(a, b)), 1.0f / 64.0f);
        a = a * rstd * gq[32 + 2 * c]; b = b * rstd * gq[32 + 2 * c + 1];
        rope8(a, b, 4, c < 4, (const f32x4*)(ws + WS_TAB64) + (t * 32 + (c & 3) * 8) / 2);
        *ptr = pack8(a * QSCALE_MLA, b * QSCALE_MLA);
    }
#pragma unroll
    for (int it = 0; it < 2; ++it) {
        const int idx = it * 64 + lane, h = idx >> 4, c = idx & 15;
        u32x4* ptr = kv16 + h * 32 + c;
        f32x4 a, b; unpack8(*ptr, a, b);
        const float rstd = rstd_of(grp_sum16(sumsq8(a, b)), 1.0f / 128.0f);
        *ptr = pack8(a * rstd * gk[2 * c], b * rstd * gk[2 * c + 1]);
    }
}

DI void e3_row(const Params& p, int row, int lane) {
    unsigned char* ws = p.ws;
    const u32x4* r16 = (const u32x4*)((const bf16_t*)(ws + WS_PROJ) + (size_t)row * NCP);
    u32x4* y16 = (u32x4*)((bf16_t*)(ws + WS_Y) + (size_t)row * DM);
    {
        const u32x4* o16 = (const u32x4*)((const bf16_t*)(ws + WS_OA) + (size_t)row * 1024);
        f32x4 a0, b0, a1, b1; unpack8(o16[lane], a0, b0); unpack8(o16[64 + lane], a1, b1);
        const float rstd = rstd_of(wave_sum(sumsq8(a0, b0) + sumsq8(a1, b1)), 1.0f / 1024.0f);
        const f32x4* g = (const f32x4*)p.in[11];
        f32x4 ga0, gb0, ga1, gb1; unpack8(r16[C_GA / 8 + lane], ga0, gb0); unpack8(r16[C_GA / 8 + 64 + lane], ga1, gb1);
        y16[lane] = pack8(a0 * rstd * g[2 * lane] * silu4(ga0), b0 * rstd * g[2 * lane + 1] * silu4(gb0));
        y16[64 + lane] = pack8(a1 * rstd * g[2 * (64 + lane)] * silu4(ga1), b1 * rstd * g[2 * (64 + lane) + 1] * silu4(gb1));
    }
    {
        const float* lse = (const float*)(ws + WS_LSE);
        f32x4 oa[2], ob[2]; float ss = 0.f;
#pragma unroll
        for (int j = 0; j < 2; ++j) {
            const int cidx = j * 64 + lane, h = cidx >> 4;
            const float l0 = lse[(size_t)row * 8 + h], l1 = lse[(size_t)TOK * 8 + (size_t)row * 8 + h], l2 = lse[(size_t)2 * TOK * 8 + (size_t)row * 8 + h];
            const float mx = fmaxf(l0, fmaxf(l1, l2));
            float w0 = __expf(l0 - mx), w1 = __expf(l1 - mx), w2 = __expf(l2 - mx);
            const float inv = 1.0f / (w0 + w1 + w2); w0 *= inv; w1 *= inv; w2 *= inv;
            f32x4 a, b, c, d, e, f;
            unpack8(((const u32x4*)((const bf16_t*)(ws + WS_OD1) + (size_t)row * 1024))[cidx], a, b);
            unpack8(((const u32x4*)((const bf16_t*)(ws + WS_OD2) + (size_t)row * 1024))[cidx], c, d);
            unpack8(((const u32x4*)((const bf16_t*)(ws + WS_OD3) + (size_t)row * 1024))[cidx], e, f);
            oa[j] = a * w0 + c * w1 + e * w2; ob[j] = b * w0 + d * w1 + f * w2;
            ss += sumsq8(oa[j], ob[j]);
        }
        const float rstd = rstd_of(wave_sum(ss), 1.0f / 1024.0f);
        const f32x4* g = (const f32x4*)p.in[12];
#pragma unroll
        for (int j = 0; j < 2; ++j) {
            const int cidx = j * 64 + lane;
            f32x4 ga, gb; unpack8(r16[C_GB / 8 + cidx], ga, gb);
            y16[128 + cidx] = pack8(oa[j] * rstd * g[2 * cidx] * silu4(ga), ob[j] * rstd * g[2 * cidx + 1] * silu4(gb));
        }
    }
}

DI void naive_attn_row(const bf16_t* q, const bf16_t* k1, size_t k1s, const bf16_t* k2, size_t k2s, const bf16_t* v, size_t vs,
                       int t, int d, int nkeys, bf16_t* o, float* lse, LAS float* qs, int lane) {
    const int DK = k2 ? 192 : 128;
    for (int i = lane; i < DK; i += 64) qs[i] = __uint_as_float((unsigned)q[i] << 16);
    asm volatile("s_waitcnt lgkmcnt(0)" ::: "memory");
    float m = -1e30f, l = 0.f, o0 = 0.f, o1 = 0.f;
    for (int c0 = 0; c0 < nkeys; c0 += 64) {
        const int ik = c0 + lane; const bool valid = ik < nkeys; const int j = valid ? t - d * ik : t;
        float s = 0.f;
        const u32x4* kp = (const u32x4*)(k1 + (size_t)j * k1s);
#pragma unroll 4
        for (int ch = 0; ch < 16; ++ch) { f32x4 a, b; unpack8(kp[ch], a, b); const LAS f32x4* qq = (const LAS f32x4*)(qs + ch * 8); const f32x4 qa = qq[0], qb = qq[1];
            s += (a.x * qa.x + a.y * qa.y) + (a.z * qa.z + a.w * qa.w) + (b.x * qb.x + b.y * qb.y) + (b.z * qb.z + b.w * qb.w); }
        if (k2) { const u32x4* kp2 = (const u32x4*)(k2 + (size_t)j * k2s);
#pragma unroll 4
            for (int ch = 0; ch < 8; ++ch) { f32x4 a, b; unpack8(kp2[ch], a, b); const LAS f32x4* qq = (const LAS f32x4*)(qs + 128 + ch * 8); const f32x4 qa = qq[0], qb = qq[1];
                s += (a.x * qa.x + a.y * qa.y) + (a.z * qa.z + a.w * qa.w) + (b.x * qb.x + b.y * qb.y) + (b.z * qb.z + b.w * qb.w); } }
        s = valid ? s : -1e30f;
        const float mn = fmaxf(m, wave_max(s)); const float corr = exp2f(m - mn); const float pe = valid ? exp2f(s - mn) : 0.f;
        l = l * corr + wave_sum(pe); o0 *= corr; o1 *= corr; m = mn;
        const int cnt = min(64, nkeys - c0);
        for (int i = 0; i < cnt; ++i) { const float pi = __shfl(pe, i); const int jj = t - d * (c0 + i);
            const unsigned vv = *(const unsigned*)(v + (size_t)jj * vs + 2 * lane); o0 += pi * bflo(vv); o1 += pi * bfhi(vv); }
    }
    const float il = 1.0f / l;
    *(unsigned*)(o + 2 * lane) = pk2(o0 * il, o1 * il);
    if (lse && lane == 0) *lse = (m + log2f(l)) * LN2;
    asm volatile("s_waitcnt lgkmcnt(0)" ::: "memory");
}
DI void phase5_naive(const Params& p, LAS unsigned char* lds, int gw, int NGW, int lane, int wave) {
    unsigned char* ws = p.ws;
    LAS float* qs = (LAS float*)(lds + wave * 1024);
    const bf16_t* proj = (const bf16_t*)(ws + WS_PROJ); const bf16_t* qa = (const bf16_t*)(ws + WS_QA); const bf16_t* kva = (const bf16_t*)(ws + WS_KVA);
    for (int item = gw; item < 4 * TOK * 8; item += NGW) {
        const int type = item / (TOK * 8), rem = item % (TOK * 8), row = rem >> 3, h = rem & 7, b = row >> 12, t = row & (SEQ - 1);
        const size_t brow = (size_t)b * SEQ;
        if (type == 0) {
            naive_attn_row(qa + (size_t)row * QA_W + h * 192, kva + brow * KVA_W + h * 256, KVA_W, proj + brow * NCP + C_KR, NCP, kva + brow * KVA_W + h * 256 + 128, KVA_W,
                           t, 1, t + 1, (bf16_t*)(ws + WS_OA) + (size_t)row * 1024 + h * 128, nullptr, qs, lane);
        } else {
            const int pidx = type - 1, d = pidx == 0 ? 1 : (pidx == 1 ? 4 : 16);
            bf16_t* od = (bf16_t*)(ws + (pidx == 0 ? WS_OD1 : (pidx == 1 ? WS_OD2 : WS_OD3)));
            naive_attn_row(proj + (size_t)row * NCP + C_QB + h * 128, proj + brow * NCP + C_KB + h * 128, NCP, nullptr, 0, proj + brow * NCP + C_VB + h * 128, NCP,
                           t, d, min(t / d, 128) + 1, od + (size_t)row * 1024 + h * 128, (float*)(ws + WS_LSE) + (size_t)pidx * TOK * 8 + (size_t)row * 8 + h, qs, lane);
        }
    }
}

__global__ void __launch_bounds__(512, 2) fwd_kernel(Params p) {
    extern __shared__ __attribute__((aligned(16))) unsigned char lds_raw[];
    LAS unsigned char* lds = (LAS unsigned char*)lds_raw;
    cg::grid_group grid = cg::this_grid();
    const int tid = threadIdx.x, lane = tid & 63, wave = __builtin_amdgcn_readfirstlane(tid >> 6);
    const int G = gridDim.x, gw = blockIdx.x * 8 + wave, NGW = G * 8;
    unsigned char* ws = p.ws;
    const int lo = p.ph_lo, hi = p.ph_hi;
#define IN(k) (lo <= (k) && (k) < hi)
#define SEAM(k) do { if (IN(k) && IN((k) + 1)) grid.sync(); } while (0)

    if (IN(0)) { phase0(p, lds, gw, NGW, lane, wave); } SEAM(0);

    if (IN(1)) {
        pg8::Gemm g{(const bf16_t*)(ws + WS_HN), (const bf16_t*)(ws + WS_WIN), TOK, NCP, DM, DM}; pg8::StaticOrder S; S.init(TOK, NCP, G, (int)blockIdx.x);
        pg8::EpiBf16<0> E{(bf16_t*)(ws + WS_PROJ), NCP, nullptr, 0, 0, 1.f};
        pg8::gemm_phase<pg8::EpiBf16<0>, pg8::StaticOrder, PG8_ALIGN, PG8_SP2>(lds, g, S, E);
    } SEAM(1);

    if (IN(2)) { for (int m = gw; m < TOK; m += NGW) e1_row(p, m, lane); } SEAM(2);

    if (IN(3)) {
        { pg8::Gemm g{(const bf16_t*)(ws + WS_PROJ) + C_CQ, (const bf16_t*)(ws + WS_WUQ), TOK, QA_W, 768, NCP}; pg8::StaticOrder S; S.init(TOK, QA_W, G, (int)blockIdx.x);
          pg8::EpiBf16<0> E{(bf16_t*)(ws + WS_QA), QA_W, nullptr, 0, 0, 1.f};
          pg8::gemm_phase<pg8::EpiBf16<0>, pg8::StaticOrder, PG8_ALIGN, PG8_SP2>(lds, g, S, E); }
        __syncthreads();
        { pg8::Gemm g{(const bf16_t*)(ws + WS_PROJ) + C_CKV, (const bf16_t*)(ws + WS_WUKV), TOK, KVA_W, 512, NCP}; pg8::StaticOrder S; S.init(TOK, KVA_W, G, (int)blockIdx.x);
          pg8::EpiBf16<0> E{(bf16_t*)(ws + WS_KVA), KVA_W, nullptr, 0, 0, 1.f};
          pg8::gemm_phase<pg8::EpiBf16<0>, pg8::StaticOrder, PG8_ALIGN, PG8_SP2>(lds, g, S, E); }
    } SEAM(3);

    if (IN(4)) { for (int m = gw; m < TOK; m += NGW) e2_row(p, m, lane); } SEAM(4);

    if (IN(5)) {
        phase5_naive(p, lds, gw, NGW, lane, wave);
    } SEAM(5);

    if (IN(6)) { for (int m = gw; m < TOK; m += NGW) e3_row(p, m, lane); } SEAM(6);

    if (IN(7)) {
        pg8::Gemm g{(const bf16_t*)(ws + WS_Y), (const bf16_t*)(ws + WS_WOUT), TOK, DM, DM, DM}; pg8::StaticOrder S; S.init(TOK, DM, G, (int)blockIdx.x);
        pg8::EpiResF32 E{p.in[0], p.out, DM};
        pg8::gemm_phase<pg8::EpiResF32, pg8::StaticOrder, PG8_ALIGN, PG8_SP2>(lds, g, S, E);
    }
#undef IN
#undef SEAM
}

extern "C" void kernel_launch(void* const* d_in, const int* in_sizes, int n_in, void* d_out, int out_size, void* d_ws, size_t ws_size, hipStream_t stream) {
    static int grid = 0;
    if (grid == 0) {
        if (n_in != 14 || in_sizes[0] != TOK * DM || out_size != TOK * DM || ws_size < WS_END) {
            fprintf(stderr, "kernel_launch: unexpected shapes: n_in %d in0 %d out %d ws %zu (need %zu)\n", n_in, n_in > 0 ? in_sizes[0] : -1, out_size, ws_size, (size_t)WS_END); grid = -1; return; }
        int dev = 0, cus = 0, per_cu = 0;
        if (hipGetDevice(&dev) != hipSuccess || hipDeviceGetAttribute(&cus, hipDeviceAttributeMultiprocessorCount, dev) != hipSuccess) { fprintf(stderr, "kernel_launch: device query failed\n"); grid = -1; return; }
        if (hipFuncSetAttribute((const void*)fwd_kernel, hipFuncAttributeMaxDynamicSharedMemorySize, LDS_BYTES) != hipSuccess) { fprintf(stderr, "kernel_launch: hipFuncSetAttribute failed\n"); grid = -1; return; }
        if (hipOccupancyMaxActiveBlocksPerMultiprocessor(&per_cu, (const void*)fwd_kernel, 512, LDS_BYTES) != hipSuccess || per_cu < 1) { fprintf(stderr, "kernel_launch: occupancy query says %d blocks per CU\n", per_cu); (void)hipGetLastError(); grid = -1; return; }
        grid = cus * 1;
        fprintf(stderr, "kernel_launch: cus %d per_cu %d grid %d\n", cus, per_cu, grid);
    }
    if (grid < 0) return;
    Params p{};
    for (int i = 0; i < 14; ++i) p.in[i] = (const float*)d_in[i];
    p.out = (float*)d_out; p.ws = (unsigned char*)d_ws;
#if MK_N_LAUNCHES == 1
    p.ph_lo = 0; p.ph_hi = NPH;
    void* args[] = {&p};
    const hipError_t e = hipLaunchCooperativeKernel((const void*)fwd_kernel, dim3(grid), dim3(512), args, LDS_BYTES, stream);
    if (e != hipSuccess) fprintf(stderr, "kernel_launch: cooperative launch failed: %s (grid %d)\n", hipGetErrorString(e), grid);
#else
    for (int ph = 0; ph < NPH; ++ph) {
        p.ph_lo = ph; p.ph_hi = ph + 1;
        hipLaunchKernelGGL(fwd_kernel, dim3(grid), dim3(512), LDS_BYTES, stream, p);
        const hipError_t e = hipPeekAtLastError();
        if (e != hipSuccess) { fprintf(stderr, "kernel_launch: launch %d failed: %s\n", ph, hipGetErrorName(e)); break; }
    }
#endif
}
```

```cpp
#include <hip/hip_runtime.h>
#include <hip/hip_cooperative_groups.h>
#include <cstdio>
#include <cstdint>
namespace cg = cooperative_groups;
namespace pg8 {
#define PG8_LAS __attribute__((address_space(3)))
typedef unsigned short bf16_t;
typedef short bf16x8 __attribute__((ext_vector_type(8)));
typedef float f32x4 __attribute__((ext_vector_type(4)));
typedef unsigned u32x4 __attribute__((ext_vector_type(4)));
constexpr int BM = 256, BK = 64, HALF = 128, HTB = HALF * BK * 2  , STAGE_BYTES = 8 * HTB, NXCD = 8, WGM = 8;

__host__ __device__ __forceinline__ int lds_byte(int r, int c) { const int st = (r >> 4) * 2 + (c >> 5), rr = r & 15, cc = c & 31, ob = rr * 64 + cc * 2; return st * 1024 + (ob ^ (((ob >> 9) & 1) << 5)); }
__host__ __device__ __forceinline__ void stage_rc(int b, int& R, int& C) { const int st = b / 1024, sb = b % 1024, swz = sb ^ (((sb >> 9) & 1) << 5); R = (st >> 1) * 16 + swz / 64; C = (st & 1) * 32 + (swz % 64) / 2; }
__host__ __device__ __forceinline__ int perm32(int rho) { const int n = rho >> 4, i = rho & 15; return 8 * (i >> 2) + 4 * n + (i & 3); }

struct Unit { int pm, pn; };
struct Gemm { const bf16_t* A; const bf16_t* Bt; int M, N, K, lda; };

struct StaticOrder {
    int nM, nN, nwg, G, c;
    __host__ __device__ void init(int M, int N, int G_, int c_) { nM = M / BM; nN = N / BM; nwg = nM * nN; G = G_; c = c_; }
    __host__ __device__ bool next(int i, Unit& u) const {
        const long L = (long)i * G + c; if (L >= nwg) return false;
        int wgid = (int)L; { const int q = nwg / NXCD, r = nwg % NXCD, xcd = wgid % NXCD, off = wgid / NXCD; wgid = (xcd < r ? xcd * (q + 1) : r * (q + 1) + (xcd - r) * q) + off; }
        const int nig = WGM * nN, gid = wgid / nig, fm = gid * WGM, gsz = (nM - fm) < WGM ? (nM - fm) : WGM;
        u.pm = fm + ((wgid % nig) % gsz); u.pn = (wgid % nig) / gsz; return true;
    }
    __device__ __forceinline__ void a_ready(const Unit&) const {}
    __device__ __forceinline__ void done(const Unit&) const {}
};

__device__ __forceinline__ unsigned cvt_pk_bf16(float lo, float hi) { unsigned r; asm volatile("v_cvt_pk_bf16_f32 %0, %1, %2" : "=v"(r) : "v"(lo), "v"(hi)); return r; }
typedef float f32x2 __attribute__((ext_vector_type(2)));
__device__ __forceinline__ f32x2 gelu_pk(f32x2 v) {
    const f32x2 av = __builtin_elementwise_abs(v), d = av * 0.2316418882f + 1.0f;
    f32x2 t; t.x = __builtin_amdgcn_rcpf(d.x); t.y = __builtin_amdgcn_rcpf(d.y);
    f32x2 q = t * 0.5307027145f + (-0.7265760135f); q = q * t + 0.7107068705f; q = q * t + (-0.142248368f); q = q * t + 0.127414796f; q = q * t;
    const f32x2 s = (v * v) * (-0.72134752044f);
    f32x2 e; e.x = __builtin_amdgcn_exp2f(s.x); e.y = __builtin_amdgcn_exp2f(s.y);
    const f32x2 m = v * (q * e), r = v - m;
    f32x2 o; o.x = v.x < 0.f ? m.x : r.x; o.y = v.y < 0.f ? m.y : r.y; return o;
}

template <int ACT  > struct EpiBf16 {
    static constexpr bool PERM = true, AFTER_DRAIN = false; static_assert(ACT == 0 || ACT == 1, "EpiBf16: ACT is 0 (none) or 1 (gelu_pk)");
    bf16_t* O; int ldc; const float* bias; int split_cols; size_t split_stride; float scale0;
    __device__ __forceinline__ void operator()(const f32x4 (&acc)[2][2][4][2], const Unit& u, int wr, int wc, int fr, int fq) const {
        const int row0 = u.pm * BM + wr * 64 + fr; int colt = u.pn * BM; bf16_t* base = O;
        float sc = 1.f; if (split_cols) { const int t = colt / split_cols; base += (size_t)t * split_stride; colt -= t * split_cols; if (t == 0) sc = scale0; }
        const int col0 = colt + wc * 32 + 8 * fq, bcol0 = u.pn * BM + wc * 32 + 8 * fq;
        f32x4 bv[2][2];
#pragma unroll
        for (int bj = 0; bj < 2; ++bj)
#pragma unroll
            for (int n = 0; n < 2; ++n) bv[bj][n] = bias ? *(const f32x4*)(bias + bcol0 + bj * HALF + 4 * n) : (f32x4){0.f, 0.f, 0.f, 0.f};
#pragma unroll
        for (int ai = 0; ai < 2; ++ai)
#pragma unroll
            for (int m = 0; m < 4; ++m) { bf16_t* rowp = base + (size_t)(row0 + ai * HALF + m * 16) * ldc + col0;
#pragma unroll
                for (int bj = 0; bj < 2; ++bj) { f32x4 v0 = acc[ai][bj][m][0] + bv[bj][0], v1 = acc[ai][bj][m][1] + bv[bj][1];
                    if (ACT == 1) { f32x2 a = gelu_pk((f32x2){v0[0], v0[1]}), b = gelu_pk((f32x2){v0[2], v0[3]}), c = gelu_pk((f32x2){v1[0], v1[1]}), d = gelu_pk((f32x2){v1[2], v1[3]});
                        v0 = (f32x4){a.x, a.y, b.x, b.y}; v1 = (f32x4){c.x, c.y, d.x, d.y}; }
                    v0 = v0 * sc; v1 = v1 * sc; u32x4 w; w.x = cvt_pk_bf16(v0[0], v0[1]); w.y = cvt_pk_bf16(v0[2], v0[3]); w.z = cvt_pk_bf16(v1[0], v1[1]); w.w = cvt_pk_bf16(v1[2], v1[3]);
                    *(u32x4*)(rowp + bj * HALF) = w; } }
    }
};

struct EpiResF32 {
    static constexpr bool PERM = true, AFTER_DRAIN = false;
    const float* base; float* out; int ldc;
    __device__ __forceinline__ void operator()(const f32x4 (&acc)[2][2][4][2], const Unit& u, int wr, int wc, int fr, int fq) const {
        const int row0 = u.pm * BM + wr * 64 + fr, col0 = u.pn * BM + wc * 32 + 8 * fq;
#pragma unroll
        for (int ai = 0; ai < 2; ++ai)
#pragma unroll
            for (int m = 0; m < 4; ++m) { const size_t off = (size_t)(row0 + ai * HALF + m * 16) * ldc + col0;
#pragma unroll
                for (int bj = 0; bj < 2; ++bj) {
                    const f32x4 b0 = *(const f32x4*)(base + off + bj * HALF), b1 = *(const f32x4*)(base + off + bj * HALF + 4);
                    *(f32x4*)(out + off + bj * HALF) = acc[ai][bj][m][0] + b0; *(f32x4*)(out + off + bj * HALF + 4) = acc[ai][bj][m][1] + b1; } }
    }
};
template <class Epi, class Sched, bool ALIGN_EPI = false, bool SP2 = false>
__device__ __forceinline__ void gemm_phase(PG8_LAS unsigned char* lds, const Gemm g, const Sched& S, const Epi& E) {
    const int tid = threadIdx.x, wid = __builtin_amdgcn_readfirstlane(tid >> 6), lane = tid & 63, wr = wid >> 2, wc = wid & 3, fr = lane & 15, fq = lane >> 4;
    const int K = g.K, nt = K / BK;
    unsigned voffA[2], voffB[2];
#pragma unroll
    for (int i = 0; i < 2; ++i) { int R, C; stage_rc(tid * 16 + i * 8192, R, C); const int Rb = Epi::PERM ? ((R & ~31) + perm32(R & 31)) : R;
        voffA[i] = (unsigned)(R * g.lda + C) * 2u; voffB[i] = (unsigned)(Rb * K + C) * 2u; }
    const size_t kstep = (size_t)(BK * 2);
    const size_t hstepA = (size_t)HALF * g.lda * 2, hstepB = (size_t)HALF * K * 2;
    const size_t tstepA = 2 * hstepA, tstepB = 2 * hstepB;
    const unsigned ldsw = (unsigned)wid * 1024u;
    const int aoff = lds_byte(wr * 64 + fr, fq * 8), boff = lds_byte(wc * 32 + fr, fq * 8);
#define PG8_SA(b, h) (((b) * 2 + (h)) * HTB)
#define PG8_SB(b, h) ((4 + (b) * 2 + (h)) * HTB)
#define PG8_STAGE(bufoff, gbase, voff) do { _Pragma("unroll") for (int _i = 0; _i < 2; ++_i) \
        __builtin_amdgcn_global_load_lds((const unsigned*)((const char*)(gbase) + (voff)[_i]), (PG8_LAS unsigned*)(lds + (bufoff) + ldsw + _i * 8192), 16, 0, 0); } while (0)
#define PG8_LDA(dst, b, h) do { _Pragma("unroll") for (int m = 0; m < 4; ++m) _Pragma("unroll") for (int k = 0; k < 2; ++k) dst[m][k] = *(const PG8_LAS bf16x8*)(lds + PG8_SA(b, h) + aoff + m * 2048 + k * 1024); } while (0)
#define PG8_LDB(dst, b, h) do { _Pragma("unroll") for (int n = 0; n < 2; ++n) _Pragma("unroll") for (int k = 0; k < 2; ++k) dst[n][k] = *(const PG8_LAS bf16x8*)(lds + PG8_SB(b, h) + boff + n * 2048 + k * 1024); } while (0)
#define PG8_MMA(ai, bj, At, Bt) do { __builtin_amdgcn_s_setprio(1); _Pragma("unroll") for (int m = 0; m < 4; ++m) _Pragma("unroll") for (int n = 0; n < 2; ++n) _Pragma("unroll") for (int k = 0; k < 2; ++k) \
        acc[ai][bj][m][n] = __builtin_amdgcn_mfma_f32_16x16x32_bf16(Bt[n][k], At[m][k], acc[ai][bj][m][n], 0, 0, 0); __builtin_amdgcn_s_setprio(0); } while (0)
#define PG8_WAIT_V(n) asm volatile("s_waitcnt vmcnt(" #n ")" ::: "memory")
#define PG8_WAIT_L(n) asm volatile("s_waitcnt lgkmcnt(" #n ")" ::: "memory")
#define PG8_BAR __builtin_amdgcn_s_barrier()
#define PG8_SCHED __builtin_amdgcn_sched_barrier(0)
    Unit cur, nxt; int ui = 0;
    if (!S.next(0, cur)) return;
    f32x4 acc[2][2][4][2];
#pragma unroll
    for (int a = 0; a < 2; ++a)
#pragma unroll
        for (int b = 0; b < 2; ++b)
#pragma unroll
            for (int m = 0; m < 4; ++m)
#pragma unroll
                for (int n = 0; n < 2; ++n) acc[a][b][m][n] = (f32x4){0.f, 0.f, 0.f, 0.f};
    bf16x8 At[4][2], B0[2][2], B1[2][2];
    const char* cA = (const char*)g.A + (size_t)cur.pm * tstepA; const char* cB = (const char*)g.Bt + (size_t)cur.pn * tstepB;
    S.a_ready(cur);
    if constexpr (SP2) {
        PG8_STAGE(PG8_SB(0, 0), cB, voffB); PG8_STAGE(PG8_SB(0, 1), cB + hstepB, voffB); PG8_STAGE(PG8_SA(0, 0), cA, voffA); PG8_STAGE(PG8_SA(0, 1), cA + hstepA, voffA);
        if (wr == 1) PG8_BAR;
        PG8_WAIT_V(2); PG8_BAR;
        PG8_STAGE(PG8_SB(1, 0), cB + kstep, voffB); PG8_STAGE(PG8_SA(1, 0), cA + kstep, voffA); PG8_STAGE(PG8_SB(1, 1), cB + hstepB + kstep, voffB);
        PG8_WAIT_V(6); PG8_BAR;
    } else {
        PG8_STAGE(PG8_SB(0, 0), cB, voffB); PG8_STAGE(PG8_SA(0, 0), cA, voffA); PG8_STAGE(PG8_SB(0, 1), cB + hstepB, voffB); PG8_STAGE(PG8_SA(0, 1), cA + hstepA, voffA);
        if (wr == 1) PG8_BAR;
        PG8_WAIT_V(4); PG8_BAR;
        PG8_STAGE(PG8_SB(1, 0), cB + kstep, voffB); PG8_STAGE(PG8_SA(1, 0), cA + kstep, voffA); PG8_STAGE(PG8_SB(1, 1), cB + hstepB + kstep, voffB);
        PG8_WAIT_V(6); PG8_BAR;
    }
    for (;;) {
        const bool has_next = S.next(ui + 1, nxt);
        const char* nA = has_next ? (const char*)g.A + (size_t)nxt.pm * tstepA : cA; const char* nB = has_next ? (const char*)g.Bt + (size_t)nxt.pn * tstepB : cB;
        for (int t = 0; t < nt; t += 2) {
            const bool last = (t == nt - 2);
            const char* a1 = cA + (size_t)(t + 1) * kstep;
            const char* a2 = last ? nA : cA + (size_t)(t + 2) * kstep; const char* b2 = last ? nB : cB + (size_t)(t + 2) * kstep;
            const char* a3 = a2 + kstep; const char* b3 = b2 + kstep;
            if (last && has_next) S.a_ready(nxt);
            if constexpr (SP2) {
            PG8_LDB(B0, 0, 0); PG8_LDB(B1, 0, 1); PG8_SCHED; PG8_LDA(At, 0, 0); PG8_STAGE(PG8_SA(1, 1), a1 + hstepA, voffA);
            PG8_WAIT_V(8); PG8_WAIT_L(0); PG8_BAR; PG8_MMA(0, 0, At, B0); PG8_MMA(0, 1, At, B1); PG8_BAR; PG8_SCHED;
            PG8_LDA(At, 0, 1); PG8_STAGE(PG8_SB(0, 0), b2, voffB); PG8_STAGE(PG8_SB(0, 1), b2 + hstepB, voffB); PG8_STAGE(PG8_SA(0, 0), a2, voffA);
            PG8_WAIT_V(8); PG8_WAIT_L(0); PG8_BAR; PG8_MMA(1, 0, At, B0); PG8_MMA(1, 1, At, B1); PG8_BAR; PG8_SCHED;
            PG8_LDB(B0, 1, 0); PG8_LDB(B1, 1, 1); PG8_SCHED; PG8_LDA(At, 1, 0); PG8_STAGE(PG8_SA(0, 1), a2 + hstepA, voffA);
            PG8_WAIT_V(8); PG8_WAIT_L(0); PG8_BAR; PG8_MMA(0, 0, At, B0); PG8_MMA(0, 1, At, B1); PG8_BAR; PG8_SCHED;
            PG8_LDA(At, 1, 1); PG8_STAGE(PG8_SB(1, 0), b3, voffB); PG8_STAGE(PG8_SB(1, 1), b3 + hstepB, voffB); PG8_STAGE(PG8_SA(1, 0), a3, voffA);
            PG8_WAIT_V(8); PG8_WAIT_L(0); PG8_BAR; PG8_MMA(1, 0, At, B0); PG8_MMA(1, 1, At, B1); PG8_BAR; PG8_SCHED;
            } else {
            PG8_LDB(B0, 0, 0); PG8_SCHED; PG8_LDA(At, 0, 0); PG8_STAGE(PG8_SA(1, 1), a1 + hstepA, voffA);
            PG8_WAIT_L(8); PG8_BAR; PG8_WAIT_L(0); PG8_MMA(0, 0, At, B0); PG8_BAR; PG8_SCHED;
            PG8_LDB(B1, 0, 1); PG8_STAGE(PG8_SB(0, 0), b2, voffB);
            PG8_BAR; PG8_WAIT_L(0); PG8_MMA(0, 1, At, B1); PG8_BAR;
            PG8_LDA(At, 0, 1); PG8_STAGE(PG8_SA(0, 0), a2, voffA);
            PG8_BAR; PG8_WAIT_L(0); PG8_MMA(1, 0, At, B0); PG8_BAR; PG8_SCHED;
            PG8_STAGE(PG8_SB(0, 1), b2 + hstepB, voffB);
            PG8_WAIT_V(6); PG8_BAR; PG8_MMA(1, 1, At, B1); PG8_BAR;
            PG8_LDB(B0, 1, 0); PG8_SCHED; PG8_LDA(At, 1, 0); PG8_STAGE(PG8_SA(0, 1), a2 + hstepA, voffA);
            PG8_WAIT_L(8); PG8_BAR; PG8_WAIT_L(0); PG8_MMA(0, 0, At, B0); PG8_BAR; PG8_SCHED;
            PG8_LDB(B1, 1, 1); PG8_STAGE(PG8_SB(1, 0), b3, voffB);
            PG8_BAR; PG8_WAIT_L(0); PG8_MMA(0, 1, At, B1); PG8_BAR;
            PG8_LDA(At, 1, 1); PG8_STAGE(PG8_SA(1, 0), a3, voffA);
            PG8_BAR; PG8_WAIT_L(0); PG8_MMA(1, 0, At, B0); PG8_BAR; PG8_SCHED;
            PG8_STAGE(PG8_SB(1, 1), b3 + hstepB, voffB);
            PG8_WAIT_V(6); PG8_BAR; PG8_MMA(1, 1, At, B1); PG8_BAR;
            }
        }
        if constexpr (ALIGN_EPI) { if (wr == 0) PG8_BAR; }
        if constexpr (!Epi::AFTER_DRAIN) { E(acc, cur, wr, wc, fr, fq); S.done(cur); }
        if (!has_next) break;
#pragma unroll
        for (int a = 0; a < 2; ++a)
#pragma unroll
            for (int b = 0; b < 2; ++b)
#pragma unroll
                for (int m = 0; m < 4; ++m)
#pragma unroll
                    for (int n = 0; n < 2; ++n) acc[a][b][m][n] = (f32x4){0.f, 0.f, 0.f, 0.f};
        cur = nxt; cA = nA; cB = nB; ++ui;
        if constexpr (ALIGN_EPI) { if (wr == 1) PG8_BAR; }
    }
    PG8_WAIT_V(0);
    if constexpr (!ALIGN_EPI) { if (wr == 0) PG8_BAR; }
    PG8_BAR;
    if constexpr (Epi::AFTER_DRAIN) { E.fused(acc, cur, wr, wc, fr, fq, lds, wid, lane); S.done(cur); }
#undef PG8_SA
#undef PG8_SB
#undef PG8_STAGE
#undef PG8_LDA
#undef PG8_LDB
#undef PG8_MMA
#undef PG8_WAIT_V
#undef PG8_WAIT_L
#undef PG8_BAR
#undef PG8_SCHED
}
}
#ifndef PG8_SP2
#define PG8_SP2 true
#endif
#ifndef PG8_ALIGN
#define PG8_ALIGN true
#endif
#ifndef MK_N_LAUNCHES
#define MK_N_LAUNCHES 1
#endif
#ifndef FAST_MLA
#define FAST_MLA 1
#endif
#ifndef FAST_DIL
#define FAST_DIL 1
#endif

constexpr int NBATCH = 4, SEQ = 4096, DM = 2048, TOK = NBATCH * SEQ;
constexpr int NC = 6464, NCP = 6656;
constexpr int C_CQ = 0, C_CKV = 768, C_KR = 1280, C_GA = 1344, C_QB = 2368, C_KB = 3392, C_VB = 4416, C_GB = 5440;
constexpr int QA_W = 1536, KVA_W = 2048;
constexpr float EPS = 1e-6f;
constexpr float LOG2E = 1.4426950408889634f, LN2 = 0.6931471805599453f;
constexpr float QSCALE_MLA = 0.07216878364870322f * LOG2E;
constexpr float QSCALE_DIL = 0.08838834764831845f * LOG2E;
constexpr int NPH = 8;

constexpr size_t MiB = 1u << 20;
constexpr size_t WS_TAB128 = 0, WS_TAB64 = 2 * MiB;
constexpr size_t WS_WIN = 4 * MiB, WS_WUQ = 30 * MiB, WS_WUKV = 33 * MiB, WS_WOUT = 35 * MiB;
constexpr size_t WS_PROJ = 44 * MiB;
constexpr size_t WS_HN = 252 * MiB;
constexpr size_t WS_OA = 252 * MiB, WS_OD1 = 284 * MiB;
constexpr size_t WS_QA = 316 * MiB;
constexpr size_t WS_KVA = 364 * MiB;
constexpr size_t WS_OD2 = 428 * MiB, WS_OD3 = 460 * MiB;
constexpr size_t WS_LSE = 492 * MiB;
constexpr size_t WS_Y = 316 * MiB;
constexpr size_t WS_END = 494 * MiB;
constexpr int LDS_BYTES = 139264;

#define LAS __attribute__((address_space(3)))
#define DI __device__ __forceinline__
typedef unsigned short bf16_t;
typedef unsigned u32x4 __attribute__((ext_vector_type(4)));
typedef unsigned u32x2 __attribute__((ext_vector_type(2)));
typedef float f32x4 __attribute__((ext_vector_type(4)));
typedef float f32x2 __attribute__((ext_vector_type(2)));

struct Params { const float* in[14]; float* out; unsigned char* ws; int ph_lo, ph_hi; };

DI float bflo(unsigned w) { return __uint_as_float(w << 16); }
DI float bfhi(unsigned w) { return __uint_as_float(w & 0xffff0000u); }
DI unsigned pk2(float lo, float hi) { return pg8::cvt_pk_bf16(lo, hi); }
DI void unpack8(const u32x4 v, f32x4& a, f32x4& b) { a = (f32x4){bflo(v.x), bfhi(v.x), bflo(v.y), bfhi(v.y)}; b = (f32x4){bflo(v.z), bfhi(v.z), bflo(v.w), bfhi(v.w)}; }
DI u32x4 pack8(const f32x4 a, const f32x4 b) { u32x4 r; r.x = pk2(a.x, a.y); r.y = pk2(a.z, a.w); r.z = pk2(b.x, b.y); r.w = pk2(b.z, b.w); return r; }
DI float sumsq8(const f32x4 a, const f32x4 b) { return (a.x * a.x + a.y * a.y) + (a.z * a.z + a.w * a.w) + (b.x * b.x + b.y * b.y) + (b.z * b.z + b.w * b.w); }
DI float wave_sum(float v) {
#pragma unroll
    for (int o = 1; o < 64; o <<= 1) v += __shfl_xor(v, o);
    return v; }
DI float wave_max(float v) {
#pragma unroll
    for (int o = 1; o < 64; o <<= 1) v = fmaxf(v, __shfl_xor(v, o));
    return v; }
DI float grp_sum8(float v) { v += __shfl_xor(v, 1); v += __shfl_xor(v, 2); v += __shfl_xor(v, 4); return v; }
DI float grp_sum16(float v) { v = grp_sum8(v); v += __shfl_xor(v, 8); return v; }
DI float rstd_of(float ss, float inv_n) { return 1.0f / sqrtf(ss * inv_n + EPS); }
DI float silu(float x) { return x / (1.0f + __expf(-x)); }
DI f32x4 silu4(f32x4 x) { return (f32x4){silu(x.x), silu(x.y), silu(x.z), silu(x.w)}; }
DI void rope8(f32x4& a, f32x4& b, int xr, bool first, const f32x4* tab) {
    f32x4 pa, pb;
    pa.x = __shfl_xor(a.x, xr); pa.y = __shfl_xor(a.y, xr); pa.z = __shfl_xor(a.z, xr); pa.w = __shfl_xor(a.w, xr);
    pb.x = __shfl_xor(b.x, xr); pb.y = __shfl_xor(b.y, xr); pb.z = __shfl_xor(b.z, xr); pb.w = __shfl_xor(b.w, xr);
    const float sg = first ? -1.f : 1.f;
    const f32x4 t0 = tab[0], t1 = tab[1], t2 = tab[2], t3 = tab[3];
    a.x = a.x * t0.x + sg * pa.x * t0.y; a.y = a.y * t0.z + sg * pa.y * t0.w; a.z = a.z * t1.x + sg * pa.z * t1.y; a.w = a.w * t1.z + sg * pa.w * t1.w;
    b.x = b.x * t2.x + sg * pb.x * t2.y; b.y = b.y * t2.z + sg * pb.y * t2.w; b.z = b.z * t3.x + sg * pb.z * t3.y; b.w = b.w * t3.z + sg * pb.w * t3.w;
}

DI void p0_transpose_item(const float* W, int K, int N, bf16_t* WT, LAS float* scr, int item, int lane) {
    const int nblk = N / 32, kb = item / nblk, nb = item % nblk, k0 = 64 * kb, n0 = 32 * nb;
#pragma unroll 8
    for (int i = 0; i < 32; ++i) { const int kk = 2 * i + (lane >> 5); scr[kk * 33 + (lane & 31)] = W[(size_t)(k0 + kk) * N + n0 + (lane & 31)]; }
    asm volatile("s_waitcnt lgkmcnt(0)" ::: "memory");
    const int c = lane & 7;
#pragma unroll
    for (int j = 0; j < 4; ++j) { const int n = (lane >> 3) + 8 * j; const LAS float* s = scr + (8 * c) * 33 + n;
        u32x4 o; o.x = pk2(s[0 * 33], s[1 * 33]); o.y = pk2(s[2 * 33], s[3 * 33]); o.z = pk2(s[4 * 33], s[5 * 33]); o.w = pk2(s[6 * 33], s[7 * 33]);
        *(u32x4*)(WT + (size_t)(n0 + n) * K + k0 + 8 * c) = o; }
    asm volatile("s_waitcnt lgkmcnt(0)" ::: "memory");
}
DI void phase0(const Params& p, LAS unsigned char* lds, int gw, int NGW, int lane, int wave) {
    unsigned char* ws = p.ws;
    LAS float* scr = (LAS float*)(lds + wave * 16384);
    constexpr int I_IN = (DM / 64) * (NC / 32), I_UQ = (768 / 64) * (QA_W / 32), I_UKV = (512 / 64) * (KVA_W / 32), I_OUT = (DM / 64) * (DM / 32);
    constexpr int NITEMS = I_IN + I_UQ + I_UKV + I_OUT;
    for (int it = gw; it < NITEMS; it += NGW) {
        int r = it;
        if (r < I_IN) { p0_transpose_item(p.in[2], DM, NC, (bf16_t*)(ws + WS_WIN), scr, r, lane); continue; } r -= I_IN;
        if (r < I_UQ) { p0_transpose_item(p.in[5], 768, QA_W, (bf16_t*)(ws + WS_WUQ), scr, r, lane); continue; } r -= I_UQ;
        if (r < I_UKV) { p0_transpose_item(p.in[6], 512, KVA_W, (bf16_t*)(ws + WS_WUKV), scr, r, lane); continue; } r -= I_UKV;
        p0_transpose_item(p.in[13], DM, DM, (bf16_t*)(ws + WS_WOUT), scr, r, lane);
    }
    const int gt = gw * 64 + lane, NGT = NGW * 64;
    {
        u32x4* z = (u32x4*)((bf16_t*)(ws + WS_WIN) + (size_t)NC * DM);
        for (int i = gt; i < (NCP - NC) * DM / 8; i += NGT) z[i] = (u32x4){0u, 0u, 0u, 0u};
    }
    for (int i = gt; i < SEQ * 96; i += NGT) {
        int s, j; float e; f32x2* dst;
        if (i < SEQ * 64) { s = i >> 6; j = i & 63; e = (float)(2 * j) * (1.0f / 128.0f); dst = (f32x2*)(ws + WS_TAB128) + i; }
        else { const int k = i - SEQ * 64; s = k >> 5; j = k & 31; e = (float)(2 * j) * (1.0f / 64.0f); dst = (f32x2*)(ws + WS_TAB64) + k; }
        const float inv = (float)exp2(-(double)e * 13.287712379549449);
        const float ang = (float)s * inv;
        const double rev = (double)ang * 0.15915494309189535;
        const float fr = (float)(rev - rint(rev));
        *dst = (f32x2){__builtin_amdgcn_cosf(fr), __builtin_amdgcn_sinf(fr)};
    }
    const f32x4* g4 = (const f32x4*)p.in[1];
    for (int m = gw; m < TOK; m += NGW) {
        const f32x4* xr = (const f32x4*)(p.in[0] + (size_t)m * DM) + lane;
        f32x4 v[8]; float ss = 0.f;
#pragma unroll
        for (int j = 0; j < 8; ++j) { v[j] = xr[64 * j]; ss += (v[j].x * v[j].x + v[j].y * v[j].y) + (v[j].z * v[j].z + v[j].w * v[j].w); }
        const float rstd = rstd_of(wave_sum(ss), 1.0f / DM);
        u32x2* o8 = (u32x2*)((bf16_t*)(ws + WS_HN) + (size_t)m * DM) + lane;
#pragma unroll
        for (int j = 0; j < 8; ++j) { const f32x4 g = g4[64 * j + lane]; const f32x4 y = v[j] * rstd * g; o8[64 * j] = (u32x2){pk2(y.x, y.y), pk2(y.z, y.w)}; }
    }
}

DI void e1_row(const Params& p, int row, int lane) {
    unsigned char* ws = p.ws;
    const int t = row & (SEQ - 1);
    u32x4* r16 = (u32x4*)((bf16_t*)(ws + WS_PROJ) + (size_t)row * NCP);
    {
        const u32x4 v0 = r16[lane]; const u32x4 v1 = lane < 32 ? r16[64 + lane] : (u32x4){0u, 0u, 0u, 0u};
        f32x4 a0, b0, a1, b1; unpack8(v0, a0, b0); unpack8(v1, a1, b1);
        const float rstd = rstd_of(wave_sum(sumsq8(a0, b0) + sumsq8(a1, b1)), 1.0f / 768.0f);
        const f32x4* g = (const f32x4*)p.in[3];
        r16[lane] = pack8(a0 * rstd * g[2 * lane], b0 * rstd * g[2 * lane + 1]);
        if (lane < 32) r16[64 + lane] = pack8(a1 * rstd * g[2 * (64 + lane)], b1 * rstd * g[2 * (64 + lane) + 1]);
    }
    {
        f32x4 a, b; unpack8(r16[96 + lane], a, b);
        const float rstd = rstd_of(wave_sum(sumsq8(a, b)), 1.0f / 512.0f);
        const f32x4* g = (const f32x4*)p.in[4];
        r16[96 + lane] = pack8(a * rstd * g[2 * lane], b * rstd * g[2 * lane + 1]);
    }
    {
        const int c = lane & 7;
        f32x4 a, b; unpack8(r16[160 + c], a, b);
        const float rstd = rstd_of(grp_sum8(sumsq8(a, b)), 1.0f / 64.0f);
        const f32x4* g = (const f32x4*)p.in[8] + 32;
        a = a * rstd * g[2 * c]; b = b * rstd * g[2 * c + 1];
        rope8(a, b, 4, c < 4, (const f32x4*)(ws + WS_TAB64) + (t * 32 + (c & 3) * 8) / 2);
        if (lane < 8) r16[160 + c] = pack8(a, b);
    }
#pragma unroll
    for (int it = 0; it < 4; ++it) {
        const int c = lane & 15;
        u32x4* ptr = r16 + (C_QB / 8) + it * 64 + lane;
        f32x4 a, b; unpack8(*ptr, a, b);
        const float rstd = rstd_of(grp_sum16(sumsq8(a, b)), 1.0f / 128.0f);
        const f32x4* g = (const f32x4*)(it < 2 ? p.in[9] : p.in[10]);
        a = a * rstd * g[2 * c]; b = b * rstd * g[2 * c + 1];
        rope8(a, b, 8, c < 8, (const f32x4*)(ws + WS_TAB128) + (t * 64 + (c & 7) * 8) / 2);
        if (it < 2) { a = a * QSCALE_DIL; b = b * QSCALE_DIL; }
        *ptr = pack8(a, b);
    }
}

DI void e2_row(const Params& p, int row, int lane) {
    unsigned char* ws = p.ws;
    const int t = row & (SEQ - 1);
    u32x4* q16 = (u32x4*)((bf16_t*)(ws + WS_QA) + (size_t)row * QA_W);
    u32x4* kv16 = (u32x4*)((bf16_t*)(ws + WS_KVA) + (size_t)row * KVA_W);
    const f32x4* gq = (const f32x4*)p.in[7];
    const f32x4* gk = (const f32x4*)p.in[8];
#pragma unroll
    for (int it = 0; it < 2; ++it) {
        const int idx = it * 64 + lane, h = idx >> 4, c = idx & 15;
        u32x4* ptr = q16 + h * 24 + c;
        f32x4 a, b; unpack8(*ptr, a, b);
        const float rstd = rstd_of(grp_sum16(sumsq8(a, b)), 1.0f / 128.0f) * QSCALE_MLA;
        *ptr = pack8(a * rstd * gq[2 * c], b * rstd * gq[2 * c + 1]);
    }
    {
        const int h = lane >> 3, c = lane & 7;
        u32x4* ptr = q16 + h * 24 + 16 + c;
        f32x4 a, b; unpack8(*ptr, a, b);
        const float rstd = rstd_of(grp_sum8(sumsq8(a, b)), 1.0f / 64.0f);
        a = a * rstd * gq[32 + 2 * c]; b = b * rstd * gq[32 + 2 * c + 1];
        rope8(a, b, 4, c < 4, (const f32x4*)(ws + WS_TAB64) + (t * 32 + (c & 3) * 8) / 2);
        *ptr = pack8(a * QSCALE_MLA, b * QSCALE_MLA);
    }
#pragma unroll
    for (int it = 0; it < 2; ++it) {
        const int idx = it * 64 + lane, h = idx >> 4, c = idx & 15;
        u32x4* ptr = kv16 + h * 32 + c;
        f32x4 a, b; unpack8(*ptr, a, b);
        const float rstd = rstd_of(grp_sum16(sumsq8(a, b)), 1.0f / 128.0f);
        *ptr = pack8(a * rstd * gk[2 * c], b * rstd * gk[2 * c + 1]);
    }
}

DI void e3_row(const Params& p, int row, int lane) {
    unsigned char* ws = p.ws;
    const u32x4* r16 = (const u32x4*)((const bf16_t*)(ws + WS_PROJ) + (size_t)row * NCP);
    u32x4* y16 = (u32x4*)((bf16_t*)(ws + WS_Y) + (size_t)row * DM);
    {
        const u32x4* o16 = (const u32x4*)((const bf16_t*)(ws + WS_OA) + (size_t)row * 1024);
        f32x4 a0, b0, a1, b1; unpack8(o16[lane], a0, b0); unpack8(o16[64 + lane], a1, b1);
        const float rstd = rstd_of(wave_sum(sumsq8(a0, b0) + sumsq8(a1, b1)), 1.0f / 1024.0f);
        const f32x4* g = (const f32x4*)p.in[11];
        f32x4 ga0, gb0, ga1, gb1; unpack8(r16[C_GA / 8 + lane], ga0, gb0); unpack8(r16[C_GA / 8 + 64 + lane], ga1, gb1);
        y16[lane] = pack8(a0 * rstd * g[2 * lane] * silu4(ga0), b0 * rstd * g[2 * lane + 1] * silu4(gb0));
        y16[64 + lane] = pack8(a1 * rstd * g[2 * (64 + lane)] * silu4(ga1), b1 * rstd * g[2 * (64 + lane) + 1] * silu4(gb1));
    }
    {
        const float* lse = (const float*)(ws + WS_LSE);
        f32x4 oa[2], ob[2]; float ss = 0.f;
#pragma unroll
        for (int j = 0; j < 2; ++j) {
            const int cidx = j * 64 + lane, h = cidx >> 4;
            const float l0 = lse[(size_t)row * 8 + h], l1 = lse[(size_t)TOK * 8 + (size_t)row * 8 + h], l2 = lse[(size_t)2 * TOK * 8 + (size_t)row * 8 + h];
            const float mx = fmaxf(l0, fmaxf(l1, l2));
            float w0 = __expf(l0 - mx), w1 = __expf(l1 - mx), w2 = __expf(l2 - mx);
            const float inv = 1.0f / (w0 + w1 + w2); w0 *= inv; w1 *= inv; w2 *= inv;
            f32x4 a, b, c, d, e, f;
            unpack8(((const u32x4*)((const bf16_t*)(ws + WS_OD1) + (size_t)row * 1024))[cidx], a, b);
            unpack8(((const u32x4*)((const bf16_t*)(ws + WS_OD2) + (size_t)row * 1024))[cidx], c, d);
            unpack8(((const u32x4*)((const bf16_t*)(ws + WS_OD3) + (size_t)row * 1024))[cidx], e, f);
            oa[j] = a * w0 + c * w1 + e * w2; ob[j] = b * w0 + d * w1 + f * w2;
            ss += sumsq8(oa[j], ob[j]);
        }
        const float rstd = rstd_of(wave_sum(ss), 1.0f / 1024.0f);
        const f32x4* g = (const f32x4*)p.in[12];
#pragma unroll
        for (int j = 0; j < 2; ++j) {
            const int cidx = j * 64 + lane;
            f32x4 ga, gb; unpack8(r16[C_GB / 8 + cidx], ga, gb);
            y16[128 + cidx] = pack8(oa[j] * rstd * g[2 * cidx] * silu4(ga), ob[j] * rstd * g[2 * cidx + 1] * silu4(gb));
        }
    }
}

DI void naive_attn_row(const bf16_t* q, const bf16_t* k1, size_t k1s, const bf16_t* k2, size_t k2s, const bf16_t* v, size_t vs,
                       int t, int d, int nkeys, bf16_t* o, float* lse, LAS float* qs, int lane) {
    const int DK = k2 ? 192 : 128;
    for (int i = lane; i < DK; i += 64) qs[i] = __uint_as_float((unsigned)q[i] << 16);
    asm volatile("s_waitcnt lgkmcnt(0)" ::: "memory");
    float m = -1e30f, l = 0.f, o0 = 0.f, o1 = 0.f;
    for (int c0 = 0; c0 < nkeys; c0 += 64) {
        const int ik = c0 + lane; const bool valid = ik < nkeys; const int j = valid ? t - d * ik : t;
        float s = 0.f;
        const u32x4* kp = (const u32x4*)(k1 + (size_t)j * k1s);
#pragma unroll 4
        for (int ch = 0; ch < 16; ++ch) { f32x4 a, b; unpack8(kp[ch], a, b); const LAS f32x4* qq = (const LAS f32x4*)(qs + ch * 8); const f32x4 qa = qq[0], qb = qq[1];
            s += (a.x * qa.x + a.y * qa.y) + (a.z * qa.z + a.w * qa.w) + (b.x * qb.x + b.y * qb.y) + (b.z * qb.z + b.w * qb.w); }
        if (k2) { const u32x4* kp2 = (const u32x4*)(k2 + (size_t)j * k2s);
#pragma unroll 4
            for (int ch = 0; ch < 8; ++ch) { f32x4 a, b; unpack8(kp2[ch], a, b); const LAS f32x4* qq = (const LAS f32x4*)(qs + 128 + ch * 8); const f32x4 qa = qq[0], qb = qq[1];
                s += (a.x * qa.x + a.y * qa.y) + (a.z * qa.z + a.w * qa.w) + (b.x * qb.x + b.y * qb.y) + (b.z * qb.z + b.w * qb.w); } }
        s = valid ? s : -1e30f;
        const float mn = fmaxf(m, wave_max(s)); const float corr = exp2f(m - mn); const float pe = valid ? exp2f(s - mn) : 0.f;
        l = l * corr + wave_sum(pe); o0 *= corr; o1 *= corr; m = mn;
        const int cnt = min(64, nkeys - c0);
        for (int i = 0; i < cnt; ++i) { const float pi = __shfl(pe, i); const int jj = t - d * (c0 + i);
            const unsigned vv = *(const unsigned*)(v + (size_t)jj * vs + 2 * lane); o0 += pi * bflo(vv); o1 += pi * bfhi(vv); }
    }
    const float il = 1.0f / l;
    *(unsigned*)(o + 2 * lane) = pk2(o0 * il, o1 * il);
    if (lse && lane == 0) *lse = (m + log2f(l)) * LN2;
    asm volatile("s_waitcnt lgkmcnt(0)" ::: "memory");
}
DI void phase5_naive(const Params& p, LAS unsigned char* lds, int gw, int NGW, int lane, int wave, int type_lo, int type_hi) {
    unsigned char* ws = p.ws;
    LAS float* qs = (LAS float*)(lds + wave * 1024);
    const bf16_t* proj = (const bf16_t*)(ws + WS_PROJ); const bf16_t* qa = (const bf16_t*)(ws + WS_QA); const bf16_t* kva = (const bf16_t*)(ws + WS_KVA);
    for (int item = type_lo * TOK * 8 + gw; item < type_hi * TOK * 8; item += NGW) {
        const int type = item / (TOK * 8), rem = item % (TOK * 8), row = rem >> 3, h = rem & 7, b = row >> 12, t = row & (SEQ - 1);
        const size_t brow = (size_t)b * SEQ;
        if (type == 0) {
            naive_attn_row(qa + (size_t)row * QA_W + h * 192, kva + brow * KVA_W + h * 256, KVA_W, proj + brow * NCP + C_KR, NCP, kva + brow * KVA_W + h * 256 + 128, KVA_W,
                           t, 1, t + 1, (bf16_t*)(ws + WS_OA) + (size_t)row * 1024 + h * 128, nullptr, qs, lane);
        } else {
            const int pidx = type - 1, d = pidx == 0 ? 1 : (pidx == 1 ? 4 : 16);
            bf16_t* od = (bf16_t*)(ws + (pidx == 0 ? WS_OD1 : (pidx == 1 ? WS_OD2 : WS_OD3)));
            naive_attn_row(proj + (size_t)row * NCP + C_QB + h * 128, proj + brow * NCP + C_KB + h * 128, NCP, nullptr, 0, proj + brow * NCP + C_VB + h * 128, NCP,
                           t, d, min(t / d, 128) + 1, od + (size_t)row * 1024 + h * 128, (float*)(ws + WS_LSE) + (size_t)pidx * TOK * 8 + (size_t)row * 8 + h, qs, lane);
        }
    }
}

namespace fa {
typedef short bf16x8 __attribute__((ext_vector_type(8)));
typedef short s16x4 __attribute__((ext_vector_type(4)));
typedef float f32x16 __attribute__((ext_vector_type(16)));
#define FA_MFMA(a, b, c) __builtin_amdgcn_mfma_f32_32x32x16_bf16((a), (b), (c), 0, 0, 0)
struct Unit {
    const bf16_t* q; unsigned qs; const bf16_t* k1; unsigned k1s; const bf16_t* k2; unsigned k2s; const bf16_t* v; unsigned vs;
    bf16_t* o; unsigned os; float* lse; unsigned lses; int l0, kt_begin, W;
};
DI unsigned v_off(int row, int ch) { return 2048u * (row >> 3) + 512u * (ch >> 2) + 64u * (row & 7) + 16u * ((ch & 3) ^ ((row >> 2) & 3)); }

template <int DK>
DI void unit_run(const Unit& u, LAS unsigned char* lds, int tid, int lane, int wave) {
    constexpr int NKS = DK / 16, KP = DK * 2 + 16, KLD = DK == 192 ? 3 : 2;
    constexpr int KBYTES = 64 * KP, VBYTES = 64 * 256, STAGE = KBYTES + VBYTES;
    const int hi = lane >> 5, l31 = lane & 31;
    const int wq0 = u.l0 + 32 * wave, W = u.W;
    bf16x8 qf[NKS];
    {   const unsigned qo = (unsigned)(wq0 + l31) * u.qs + 8u * hi;
#pragma unroll
        for (int ks = 0; ks < NKS; ++ks) qf[ks] = *(const bf16x8*)(u.q + (qo + 16u * ks)); }
    const int ntiles = (u.l0 + 256 - u.kt_begin) >> 6;
    u32x4 kr[KLD], vr[2];
#define FA_LOAD(kt) do { \
        _Pragma("unroll") for (int j = 0; j < 2; ++j) { const int c = tid + 512 * j, row = c >> 4, cc = c & 15; \
            kr[j] = *(const u32x4*)(u.k1 + ((unsigned)((kt) + row) * u.k1s + 8u * cc)); \
            vr[j] = *(const u32x4*)(u.v + ((unsigned)((kt) + row) * u.vs + 8u * cc)); } \
        if (DK == 192) { const int row = tid >> 3, cc = tid & 7; kr[KLD - 1] = *(const u32x4*)(u.k2 + ((unsigned)((kt) + row) * u.k2s + 8u * cc)); } } while (0)
#define FA_STORE(st) do { LAS unsigned char* kb_ = lds + (st) * STAGE; \
        _Pragma("unroll") for (int j = 0; j < 2; ++j) { const int c = tid + 512 * j, row = c >> 4, cc = c & 15; \
            *(LAS u32x4*)(kb_ + row * KP + cc * 16) = kr[j]; *(LAS u32x4*)(kb_ + KBYTES + v_off(row, cc)) = vr[j]; } \
        if (DK == 192) { const int row = tid >> 3, cc = tid & 7; *(LAS u32x4*)(kb_ + row * KP + 256 + cc * 16) = kr[KLD - 1]; } } while (0)
    FA_LOAD(u.kt_begin);
    FA_STORE(0);
    __syncthreads();
    f32x16 O[4];
#pragma unroll
    for (int c = 0; c < 4; ++c)
#pragma unroll
        for (int r = 0; r < 16; ++r) O[c][r] = 0.f;
    float m = -1e30f, l = 0.f;
    const unsigned ka = (unsigned)(l31 * KP + 16 * hi);
    const int q4 = (lane & 15) >> 2, p4 = lane & 3, blk = (lane >> 4) & 1;
    const unsigned va0 = (unsigned)(KBYTES + 64 * (4 * hi + q4) + 16 * ((2 * blk + (p4 >> 1)) ^ (hi)) + 8 * (p4 & 1));
    const unsigned va1 = (unsigned)(KBYTES + 64 * (4 * hi + q4) + 16 * ((2 * blk + (p4 >> 1)) ^ (2 + hi)) + 8 * (p4 & 1));
    for (int it = 0; it < ntiles; ++it) {
        const int kt0 = u.kt_begin + 64 * it, cur = it & 1;
        const bool more = it + 1 < ntiles;
        const bool relevant = (kt0 <= wq0 + 31) && (kt0 + 63 >= wq0 - W);
        if (relevant) {
            const LAS unsigned char* sb = lds + cur * STAGE;
            f32x16 S0, S1;
#pragma unroll
            for (int r = 0; r < 16; ++r) { S0[r] = 0.f; S1[r] = 0.f; }
#pragma unroll
            for (int ks = 0; ks < NKS; ++ks) {
                const bf16x8 a0 = *(const LAS bf16x8*)(sb + ka + 32 * ks);
                const bf16x8 a1 = *(const LAS bf16x8*)(sb + ka + 32 * KP + 32 * ks);
                S0 = FA_MFMA(a0, qf[ks], S0); S1 = FA_MFMA(a1, qf[ks], S1);
            }
            const bool needmask = !((kt0 + 63 <= wq0) && (kt0 >= wq0 + 31 - W));
            if (needmask) {
                const int dq = wq0 + l31 - kt0 - 4 * hi;
#pragma unroll
                for (int r = 0; r < 16; ++r) { const int d0 = dq - ((r & 3) + 8 * (r >> 2)), d1 = d0 - 32;
                    S0[r] = (d0 >= 0 && d0 <= W) ? S0[r] : -INFINITY; S1[r] = (d1 >= 0 && d1 <= W) ? S1[r] : -INFINITY; }
            }
            float mx = fmaxf(S0[0], S1[0]);
#pragma unroll
            for (int r = 1; r < 16; ++r) mx = fmaxf(mx, fmaxf(S0[r], S1[r]));
            mx = fmaxf(mx, __shfl_xor(mx, 32));
            const float mn = fmaxf(m, mx); const float corr = __builtin_amdgcn_exp2f(m - mn); m = mn;
            float ps = 0.f;
#pragma unroll
            for (int r = 0; r < 16; ++r) { S0[r] = __builtin_amdgcn_exp2f(S0[r] - mn); S1[r] = __builtin_amdgcn_exp2f(S1[r] - mn); ps += S0[r] + S1[r]; }
            l = l * corr + ps;
#pragma unroll
            for (int c = 0; c < 4; ++c)
#pragma unroll
                for (int r = 0; r < 16; ++r) O[c][r] *= corr;
            bf16x8 P[2][2];
#pragma unroll
            for (int j = 0; j < 2; ++j) {
                u32x4 w0, w1;
                w0.x = pk2(S0[8 * j + 0], S0[8 * j + 1]); w0.y = pk2(S0[8 * j + 2], S0[8 * j + 3]); w0.z = pk2(S0[8 * j + 4], S0[8 * j + 5]); w0.w = pk2(S0[8 * j + 6], S0[8 * j + 7]);
                w1.x = pk2(S1[8 * j + 0], S1[8 * j + 1]); w1.y = pk2(S1[8 * j + 2], S1[8 * j + 3]); w1.z = pk2(S1[8 * j + 4], S1[8 * j + 5]); w1.w = pk2(S1[8 * j + 6], S1[8 * j + 7]);
                P[0][j] = __builtin_bit_cast(bf16x8, w0); P[1][j] = __builtin_bit_cast(bf16x8, w1);
            }
            if (more) FA_LOAD(kt0 + 64);
#pragma unroll
            for (int kb = 0; kb < 2; ++kb)
#pragma unroll
                for (int j = 0; j < 2; ++j)
#pragma unroll
                    for (int c = 0; c < 4; ++c) {
                        const s16x4 lo = __builtin_amdgcn_ds_read_tr16_b64_v4i16((LAS s16x4*)(sb + va0 + 2048 * (4 * kb + 2 * j) + 512 * c));
                        const s16x4 hv = __builtin_amdgcn_ds_read_tr16_b64_v4i16((LAS s16x4*)(sb + va1 + 2048 * (4 * kb + 2 * j + 1) + 512 * c));
                        const bf16x8 vf = __builtin_shufflevector(lo, hv, 0, 1, 2, 3, 4, 5, 6, 7);
                        O[c] = FA_MFMA(vf, P[kb][j], O[c]);
                    }
        } else if (more) FA_LOAD(kt0 + 64);
        if (more) FA_STORE(cur ^ 1);
        __syncthreads();
    }
#undef FA_LOAD
#undef FA_STORE
    l += __shfl_xor(l, 32);
    const float il = 1.0f / l;
    bf16_t* orow = u.o + ((unsigned)(wq0 + l31) * u.os + 4u * hi);
#pragma unroll
    for (int c = 0; c < 4; ++c)
#pragma unroll
        for (int g = 0; g < 4; ++g) {
            u32x2 w; w.x = pk2(O[c][4 * g + 0] * il, O[c][4 * g + 1] * il); w.y = pk2(O[c][4 * g + 2] * il, O[c][4 * g + 3] * il);
            *(u32x2*)(orow + 32 * c + 8 * g) = w;
        }
    if (u.lse && hi == 0) u.lse[(unsigned)(wq0 + l31) * u.lses] = (m + __builtin_amdgcn_logf(l)) * LN2;
}
}

DI void phase5_fast(const Params& p, LAS unsigned char* lds, int tid, int lane, int wave) {
    unsigned char* ws = p.ws;
    const int G = gridDim.x, bid = blockIdx.x;
    const bf16_t* proj = (const bf16_t*)(ws + WS_PROJ); const bf16_t* qa = (const bf16_t*)(ws + WS_QA); const bf16_t* kva = (const bf16_t*)(ws + WS_KVA);
    if (FAST_MLA) for (int pi = bid; pi < 256; pi += G) {
        const int vv = pi >> 3, bh = (pi & 7) * 4 + (vv >> 3), j = vv & 7, b = bh >> 3, h = bh & 7;
        const size_t brow = (size_t)b * SEQ;
#pragma unroll 1
        for (int s = 0; s < 2; ++s) {
            const int qb = s == 0 ? 15 - j : j;
            fa::Unit u;
            u.q = qa + brow * QA_W + h * 192; u.qs = QA_W;
            u.k1 = kva + brow * KVA_W + h * 256; u.k1s = KVA_W; u.k2 = proj + brow * NCP + C_KR; u.k2s = NCP;
            u.v = kva + brow * KVA_W + h * 256 + 128; u.vs = KVA_W;
            u.o = (bf16_t*)(ws + WS_OA) + brow * 1024 + h * 128; u.os = 1024; u.lse = nullptr; u.lses = 0;
            u.l0 = 256 * qb; u.kt_begin = 0; u.W = 1 << 30;
            fa::unit_run<192>(u, lds, tid, lane, wave);
        }
    }
    if (FAST_DIL)
#pragma unroll 1
    for (int ui = bid; ui < 1536; ui += G) {
        const int pidx = ui >> 9, rem = ui & 511, bh = rem >> 4, sub = rem & 15, b = bh >> 3, h = bh & 7;
        const int d = pidx == 0 ? 1 : (pidx == 1 ? 4 : 16), nub = 16 / d, r = sub / nub, ub = sub % nub;
        const size_t row0 = (size_t)b * SEQ + r;
        fa::Unit u;
        u.q = proj + row0 * NCP + C_QB + h * 128; u.qs = (unsigned)d * NCP;
        u.k1 = proj + row0 * NCP + C_KB + h * 128; u.k1s = (unsigned)d * NCP; u.k2 = nullptr; u.k2s = 0;
        u.v = proj + row0 * NCP + C_VB + h * 128; u.vs = (unsigned)d * NCP;
        u.o = (bf16_t*)(ws + (pidx == 0 ? WS_OD1 : (pidx == 1 ? WS_OD2 : WS_OD3))) + row0 * 1024 + h * 128; u.os = (unsigned)d * 1024;
        u.lse = (float*)(ws + WS_LSE) + (size_t)pidx * TOK * 8 + row0 * 8 + h; u.lses = (unsigned)d * 8;
        u.l0 = 256 * ub; u.kt_begin = u.l0 >= 128 ? u.l0 - 128 : 0; u.W = 128;
        fa::unit_run<128>(u, lds, tid, lane, wave);
    }
}

__global__ void __launch_bounds__(512, 2) fwd_kernel(Params p) {
    extern __shared__ __attribute__((aligned(16))) unsigned char lds_raw[];
    LAS unsigned char* lds = (LAS unsigned char*)lds_raw;
    cg::grid_group grid = cg::this_grid();
    const int tid = threadIdx.x, lane = tid & 63, wave = __builtin_amdgcn_readfirstlane(tid >> 6);
    const int G = gridDim.x, gw = blockIdx.x * 8 + wave, NGW = G * 8;
    unsigned char* ws = p.ws;
    const int lo = p.ph_lo, hi = p.ph_hi;
#define IN(k) (lo <= (k) && (k) < hi)
#define SEAM(k) do { if (IN(k) && IN((k) + 1)) grid.sync(); } while (0)

    if (IN(0)) { phase0(p, lds, gw, NGW, lane, wave); } SEAM(0);

    if (IN(1)) {
        pg8::Gemm g{(const bf16_t*)(ws + WS_HN), (const bf16_t*)(ws + WS_WIN), TOK, NCP, DM, DM}; pg8::StaticOrder S; S.init(TOK, NCP, G, (int)blockIdx.x);
        pg8::EpiBf16<0> E{(bf16_t*)(ws + WS_PROJ), NCP, nullptr, 0, 0, 1.f};
        pg8::gemm_phase<pg8::EpiBf16<0>, pg8::StaticOrder, PG8_ALIGN, PG8_SP2>(lds, g, S, E);
    } SEAM(1);

    if (IN(2)) { for (int m = gw; m < TOK; m += NGW) e1_row(p, m, lane); } SEAM(2);

    if (IN(3)) {
        { pg8::Gemm g{(const bf16_t*)(ws + WS_PROJ) + C_CQ, (const bf16_t*)(ws + WS_WUQ), TOK, QA_W, 768, NCP}; pg8::StaticOrder S; S.init(TOK, QA_W, G, (int)blockIdx.x);
          pg8::EpiBf16<0> E{(bf16_t*)(ws + WS_QA), QA_W, nullptr, 0, 0, 1.f};
          pg8::gemm_phase<pg8::EpiBf16<0>, pg8::StaticOrder, PG8_ALIGN, PG8_SP2>(lds, g, S, E); }
        __syncthreads();
        { pg8::Gemm g{(const bf16_t*)(ws + WS_PROJ) + C_CKV, (const bf16_t*)(ws + WS_WUKV), TOK, KVA_W, 512, NCP}; pg8::StaticOrder S; S.init(TOK, KVA_W, G, (int)blockIdx.x);
          pg8::EpiBf16<0> E{(bf16_t*)(ws + WS_KVA), KVA_W, nullptr, 0, 0, 1.f};
          pg8::gemm_phase<pg8::EpiBf16<0>, pg8::StaticOrder, PG8_ALIGN, PG8_SP2>(lds, g, S, E); }
    } SEAM(3);

    if (IN(4)) { for (int m = gw; m < TOK; m += NGW) e2_row(p, m, lane); } SEAM(4);

    if (IN(5)) {
        if (!FAST_MLA) phase5_naive(p, lds, gw, NGW, lane, wave, 0, 1);
        if (!FAST_DIL) phase5_naive(p, lds, gw, NGW, lane, wave, 1, 4);
        if (FAST_MLA || FAST_DIL) { __syncthreads(); phase5_fast(p, lds, tid, lane, wave); }
    } SEAM(5);

    if (IN(6)) { for (int m = gw; m < TOK; m += NGW) e3_row(p, m, lane); } SEAM(6);

    if (IN(7)) {
        pg8::Gemm g{(const bf16_t*)(ws + WS_Y), (const bf16_t*)(ws + WS_WOUT), TOK, DM, DM, DM}; pg8::StaticOrder S; S.init(TOK, DM, G, (int)blockIdx.x);
        pg8::EpiResF32 E{p.in[0], p.out, DM};
        pg8::gemm_phase<pg8::EpiResF32, pg8::StaticOrder, PG8_ALIGN, PG8_SP2>(lds, g, S, E);
    }
#undef IN
#undef SEAM
}

extern "C" void kernel_launch(void* const* d_in, const int* in_sizes, int n_in, void* d_out, int out_size, void* d_ws, size_t ws_size, hipStream_t stream) {
    static int grid = 0;
    if (grid == 0) {
        if (n_in != 14 || in_sizes[0] != TOK * DM || out_size != TOK * DM || ws_size < WS_END) {
            fprintf(stderr, "kernel_launch: unexpected shapes: n_in %d in0 %d out %d ws %zu (need %zu)\n", n_in, n_in > 0 ? in_sizes[0] : -1, out_size, ws_size, (size_t)WS_END); grid = -1; return; }
        int dev = 0, cus = 0, per_cu = 0;
        if (hipGetDevice(&dev) != hipSuccess || hipDeviceGetAttribute(&cus, hipDeviceAttributeMultiprocessorCount, dev) != hipSuccess) { fprintf(stderr, "kernel_launch: device query failed\n"); grid = -1; return; }
        if (hipFuncSetAttribute((const void*)fwd_kernel, hipFuncAttributeMaxDynamicSharedMemorySize, LDS_BYTES) != hipSuccess) { fprintf(stderr, "kernel_launch: hipFuncSetAttribute failed\n"); grid = -1; return; }
        if (hipOccupancyMaxActiveBlocksPerMultiprocessor(&per_cu, (const void*)fwd_kernel, 512, LDS_BYTES) != hipSuccess || per_cu < 1) { fprintf(stderr, "kernel_launch: occupancy query says %d blocks per CU\n", per_cu); (void)hipGetLastError(); grid = -1; return; }
        grid = cus * 1;
        fprintf(stderr, "kernel_launch: cus %d per_cu %d grid %d\n", cus, per_cu, grid);
    }
    if (grid < 0) return;
    Params p{};
    for (int i = 0; i < 14; ++i) p.in[i] = (const float*)d_in[i];
    p.out = (float*)d_out; p.ws = (unsigned char*)d_ws;
#if MK_N_LAUNCHES == 1
    p.ph_lo = 0; p.ph_hi = NPH;
    void* args[] = {&p};
    const hipError_t e = hipLaunchCooperativeKernel((const void*)fwd_kernel, dim3(grid), dim3(512), args, LDS_BYTES, stream);
    if (e != hipSuccess) fprintf(stderr, "kernel_launch: cooperative launch failed: %s (grid %d)\n", hipGetErrorString(e), grid);
#else
    for (int ph = 0; ph < NPH; ++ph) {
        p.ph_lo = ph; p.ph_hi = ph + 1;
        hipLaunchKernelGGL(fwd_kernel, dim3(grid), dim3(512), LDS_BYTES, stream, p);
        const hipError_t e = hipPeekAtLastError();
        if (e != hipSuccess) { fprintf(stderr, "kernel_launch: launch %d failed: %s\n", ph, hipGetErrorName(e)); break; }
    }
#endif
}
```

```cpp
#include <hip/hip_runtime.h>
#include <hip/hip_cooperative_groups.h>
#include <cstdio>
#include <cstdint>
namespace cg = cooperative_groups;
namespace pg8 {
#define PG8_LAS __attribute__((address_space(3)))
typedef unsigned short bf16_t;
typedef short bf16x8 __attribute__((ext_vector_type(8)));
typedef float f32x4 __attribute__((ext_vector_type(4)));
typedef unsigned u32x4 __attribute__((ext_vector_type(4)));
constexpr int BM = 256, BK = 64, HALF = 128, HTB = HALF * BK * 2  , STAGE_BYTES = 8 * HTB, NXCD = 8, WGM = 8;

__host__ __device__ __forceinline__ int lds_byte(int r, int c) { const int st = (r >> 4) * 2 + (c >> 5), rr = r & 15, cc = c & 31, ob = rr * 64 + cc * 2; return st * 1024 + (ob ^ (((ob >> 9) & 1) << 5)); }
__host__ __device__ __forceinline__ void stage_rc(int b, int& R, int& C) { const int st = b / 1024, sb = b % 1024, swz = sb ^ (((sb >> 9) & 1) << 5); R = (st >> 1) * 16 + swz / 64; C = (st & 1) * 32 + (swz % 64) / 2; }
__host__ __device__ __forceinline__ int perm32(int rho) { const int n = rho >> 4, i = rho & 15; return 8 * (i >> 2) + 4 * n + (i & 3); }

struct Unit { int pm, pn; };
struct Gemm { const bf16_t* A; const bf16_t* Bt; int M, N, K, lda; };

struct StaticOrder {
    int nM, nN, nwg, G, c;
    __host__ __device__ void init(int M, int N, int G_, int c_) { nM = M / BM; nN = N / BM; nwg = nM * nN; G = G_; c = c_; }
    __host__ __device__ bool next(int i, Unit& u) const {
        const long L = (long)i * G + c; if (L >= nwg) return false;
        int wgid = (int)L; { const int q = nwg / NXCD, r = nwg % NXCD, xcd = wgid % NXCD, off = wgid / NXCD; wgid = (xcd < r ? xcd * (q + 1) : r * (q + 1) + (xcd - r) * q) + off; }
        const int nig = WGM * nN, gid = wgid / nig, fm = gid * WGM, gsz = (nM - fm) < WGM ? (nM - fm) : WGM;
        u.pm = fm + ((wgid % nig) % gsz); u.pn = (wgid % nig) / gsz; return true;
    }
    __device__ __forceinline__ void a_ready(const Unit&) const {}
    __device__ __forceinline__ void done(const Unit&) const {}
};

__device__ __forceinline__ unsigned cvt_pk_bf16(float lo, float hi) { unsigned r; asm volatile("v_cvt_pk_bf16_f32 %0, %1, %2" : "=v"(r) : "v"(lo), "v"(hi)); return r; }
typedef float f32x2 __attribute__((ext_vector_type(2)));
__device__ __forceinline__ f32x2 gelu_pk(f32x2 v) {
    const f32x2 av = __builtin_elementwise_abs(v), d = av * 0.2316418882f + 1.0f;
    f32x2 t; t.x = __builtin_amdgcn_rcpf(d.x); t.y = __builtin_amdgcn_rcpf(d.y);
    f32x2 q = t * 0.5307027145f + (-0.7265760135f); q = q * t + 0.7107068705f; q = q * t + (-0.142248368f); q = q * t + 0.127414796f; q = q * t;
    const f32x2 s = (v * v) * (-0.72134752044f);
    f32x2 e; e.x = __builtin_amdgcn_exp2f(s.x); e.y = __builtin_amdgcn_exp2f(s.y);
    const f32x2 m = v * (q * e), r = v - m;
    f32x2 o; o.x = v.x < 0.f ? m.x : r.x; o.y = v.y < 0.f ? m.y : r.y; return o;
}

template <int ACT  > struct EpiBf16 {
    static constexpr bool PERM = true, AFTER_DRAIN = false; static_assert(ACT == 0 || ACT == 1, "EpiBf16: ACT is 0 (none) or 1 (gelu_pk)");
    bf16_t* O; int ldc; const float* bias; int split_cols; size_t split_stride; float scale0;
    __device__ __forceinline__ void operator()(const f32x4 (&acc)[2][2][4][2], const Unit& u, int wr, int wc, int fr, int fq) const {
        const int row0 = u.pm * BM + wr * 64 + fr; int colt = u.pn * BM; bf16_t* base = O;
        float sc = 1.f; if (split_cols) { const int t = colt / split_cols; base += (size_t)t * split_stride; colt -= t * split_cols; if (t == 0) sc = scale0; }
        const int col0 = colt + wc * 32 + 8 * fq, bcol0 = u.pn * BM + wc * 32 + 8 * fq;
        f32x4 bv[2][2];
#pragma unroll
        for (int bj = 0; bj < 2; ++bj)
#pragma unroll
            for (int n = 0; n < 2; ++n) bv[bj][n] = bias ? *(const f32x4*)(bias + bcol0 + bj * HALF + 4 * n) : (f32x4){0.f, 0.f, 0.f, 0.f};
#pragma unroll
        for (int ai = 0; ai < 2; ++ai)
#pragma unroll
            for (int m = 0; m < 4; ++m) { bf16_t* rowp = base + (size_t)(row0 + ai * HALF + m * 16) * ldc + col0;
#pragma unroll
                for (int bj = 0; bj < 2; ++bj) { f32x4 v0 = acc[ai][bj][m][0] + bv[bj][0], v1 = acc[ai][bj][m][1] + bv[bj][1];
                    if (ACT == 1) { f32x2 a = gelu_pk((f32x2){v0[0], v0[1]}), b = gelu_pk((f32x2){v0[2], v0[3]}), c = gelu_pk((f32x2){v1[0], v1[1]}), d = gelu_pk((f32x2){v1[2], v1[3]});
                        v0 = (f32x4){a.x, a.y, b.x, b.y}; v1 = (f32x4){c.x, c.y, d.x, d.y}; }
                    v0 = v0 * sc; v1 = v1 * sc; u32x4 w; w.x = cvt_pk_bf16(v0[0], v0[1]); w.y = cvt_pk_bf16(v0[2], v0[3]); w.z = cvt_pk_bf16(v1[0], v1[1]); w.w = cvt_pk_bf16(v1[2], v1[3]);
                    *(u32x4*)(rowp + bj * HALF) = w; } }
    }
};

struct EpiResF32 {
    static constexpr bool PERM = true, AFTER_DRAIN = false;
    const float* base; float* out; int ldc;
    __device__ __forceinline__ void operator()(const f32x4 (&acc)[2][2][4][2], const Unit& u, int wr, int wc, int fr, int fq) const {
        const int row0 = u.pm * BM + wr * 64 + fr, col0 = u.pn * BM + wc * 32 + 8 * fq;
#pragma unroll
        for (int ai = 0; ai < 2; ++ai)
#pragma unroll
            for (int m = 0; m < 4; ++m) { const size_t off = (size_t)(row0 + ai * HALF + m * 16) * ldc + col0;
#pragma unroll
                for (int bj = 0; bj < 2; ++bj) {
                    const f32x4 b0 = *(const f32x4*)(base + off + bj * HALF), b1 = *(const f32x4*)(base + off + bj * HALF + 4);
                    *(f32x4*)(out + off + bj * HALF) = acc[ai][bj][m][0] + b0; *(f32x4*)(out + off + bj * HALF + 4) = acc[ai][bj][m][1] + b1; } }
    }
};
template <class Epi, class Sched, bool ALIGN_EPI = false, bool SP2 = false>
__device__ __forceinline__ void gemm_phase(PG8_LAS unsigned char* lds, const Gemm g, const Sched& S, const Epi& E) {
    int tid = threadIdx.x; asm volatile("" : "+v"(tid));
    const int wid = __builtin_amdgcn_readfirstlane(tid >> 6), lane = tid & 63, wr = wid >> 2, wc = wid & 3, fr = lane & 15, fq = lane >> 4;
    const int K = g.K, nt = K / BK;
    unsigned voffA[2], voffB[2];
#pragma unroll
    for (int i = 0; i < 2; ++i) { int R, C; stage_rc(tid * 16 + i * 8192, R, C); const int Rb = Epi::PERM ? ((R & ~31) + perm32(R & 31)) : R;
        voffA[i] = (unsigned)(R * g.lda + C) * 2u; voffB[i] = (unsigned)(Rb * K + C) * 2u; }
    const size_t kstep = (size_t)(BK * 2);
    const size_t hstepA = (size_t)HALF * g.lda * 2, hstepB = (size_t)HALF * K * 2;
    const size_t tstepA = 2 * hstepA, tstepB = 2 * hstepB;
    const unsigned ldsw = (unsigned)wid * 1024u;
    const int aoff = lds_byte(wr * 64 + fr, fq * 8), boff = lds_byte(wc * 32 + fr, fq * 8);
#define PG8_SA(b, h) (((b) * 2 + (h)) * HTB)
#define PG8_SB(b, h) ((4 + (b) * 2 + (h)) * HTB)
#define PG8_STAGE(bufoff, gbase, voff) do { _Pragma("unroll") for (int _i = 0; _i < 2; ++_i) \
        __builtin_amdgcn_global_load_lds((const unsigned*)((const char*)(gbase) + (voff)[_i]), (PG8_LAS unsigned*)(lds + (bufoff) + ldsw + _i * 8192), 16, 0, 0); } while (0)
#define PG8_LDA(dst, b, h) do { _Pragma("unroll") for (int m = 0; m < 4; ++m) _Pragma("unroll") for (int k = 0; k < 2; ++k) dst[m][k] = *(const PG8_LAS bf16x8*)(lds + PG8_SA(b, h) + aoff + m * 2048 + k * 1024); } while (0)
#define PG8_LDB(dst, b, h) do { _Pragma("unroll") for (int n = 0; n < 2; ++n) _Pragma("unroll") for (int k = 0; k < 2; ++k) dst[n][k] = *(const PG8_LAS bf16x8*)(lds + PG8_SB(b, h) + boff + n * 2048 + k * 1024); } while (0)
#define PG8_MMA(ai, bj, At, Bt) do { __builtin_amdgcn_s_setprio(1); _Pragma("unroll") for (int m = 0; m < 4; ++m) _Pragma("unroll") for (int n = 0; n < 2; ++n) _Pragma("unroll") for (int k = 0; k < 2; ++k) \
        acc[ai][bj][m][n] = __builtin_amdgcn_mfma_f32_16x16x32_bf16(Bt[n][k], At[m][k], acc[ai][bj][m][n], 0, 0, 0); __builtin_amdgcn_s_setprio(0); } while (0)
#define PG8_WAIT_V(n) asm volatile("s_waitcnt vmcnt(" #n ")" ::: "memory")
#define PG8_WAIT_L(n) asm volatile("s_waitcnt lgkmcnt(" #n ")" ::: "memory")
#define PG8_BAR __builtin_amdgcn_s_barrier()
#define PG8_SCHED __builtin_amdgcn_sched_barrier(0)
    Unit cur, nxt; int ui = 0;
    if (!S.next(0, cur)) return;
    f32x4 acc[2][2][4][2];
#pragma unroll
    for (int a = 0; a < 2; ++a)
#pragma unroll
        for (int b = 0; b < 2; ++b)
#pragma unroll
            for (int m = 0; m < 4; ++m)
#pragma unroll
                for (int n = 0; n < 2; ++n) acc[a][b][m][n] = (f32x4){0.f, 0.f, 0.f, 0.f};
    bf16x8 At[4][2], B0[2][2], B1[2][2];
    const char* cA = (const char*)g.A + (size_t)cur.pm * tstepA; const char* cB = (const char*)g.Bt + (size_t)cur.pn * tstepB;
    S.a_ready(cur);
    if constexpr (SP2) {
        PG8_STAGE(PG8_SB(0, 0), cB, voffB); PG8_STAGE(PG8_SB(0, 1), cB + hstepB, voffB); PG8_STAGE(PG8_SA(0, 0), cA, voffA); PG8_STAGE(PG8_SA(0, 1), cA + hstepA, voffA);
        if (wr == 1) PG8_BAR;
        PG8_WAIT_V(2); PG8_BAR;
        PG8_STAGE(PG8_SB(1, 0), cB + kstep, voffB); PG8_STAGE(PG8_SA(1, 0), cA + kstep, voffA); PG8_STAGE(PG8_SB(1, 1), cB + hstepB + kstep, voffB);
        PG8_WAIT_V(6); PG8_BAR;
    } else {
        PG8_STAGE(PG8_SB(0, 0), cB, voffB); PG8_STAGE(PG8_SA(0, 0), cA, voffA); PG8_STAGE(PG8_SB(0, 1), cB + hstepB, voffB); PG8_STAGE(PG8_SA(0, 1), cA + hstepA, voffA);
        if (wr == 1) PG8_BAR;
        PG8_WAIT_V(4); PG8_BAR;
        PG8_STAGE(PG8_SB(1, 0), cB + kstep, voffB); PG8_STAGE(PG8_SA(1, 0), cA + kstep, voffA); PG8_STAGE(PG8_SB(1, 1), cB + hstepB + kstep, voffB);
        PG8_WAIT_V(6); PG8_BAR;
    }
    for (;;) {
        const bool has_next = S.next(ui + 1, nxt);
        const char* nA = has_next ? (const char*)g.A + (size_t)nxt.pm * tstepA : cA; const char* nB = has_next ? (const char*)g.Bt + (size_t)nxt.pn * tstepB : cB;
        for (int t = 0; t < nt; t += 2) {
            const bool last = (t == nt - 2);
            const char* a1 = cA + (size_t)(t + 1) * kstep;
            const char* a2 = last ? nA : cA + (size_t)(t + 2) * kstep; const char* b2 = last ? nB : cB + (size_t)(t + 2) * kstep;
            const char* a3 = a2 + kstep; const char* b3 = b2 + kstep;
            if (last && has_next) S.a_ready(nxt);
            if constexpr (SP2) {
            PG8_LDB(B0, 0, 0); PG8_LDB(B1, 0, 1); PG8_SCHED; PG8_LDA(At, 0, 0); PG8_STAGE(PG8_SA(1, 1), a1 + hstepA, voffA);
            PG8_WAIT_V(8); PG8_WAIT_L(0); PG8_BAR; PG8_MMA(0, 0, At, B0); PG8_MMA(0, 1, At, B1); PG8_BAR; PG8_SCHED;
            PG8_LDA(At, 0, 1); PG8_STAGE(PG8_SB(0, 0), b2, voffB); PG8_STAGE(PG8_SB(0, 1), b2 + hstepB, voffB); PG8_STAGE(PG8_SA(0, 0), a2, voffA);
            PG8_WAIT_V(8); PG8_WAIT_L(0); PG8_BAR; PG8_MMA(1, 0, At, B0); PG8_MMA(1, 1, At, B1); PG8_BAR; PG8_SCHED;
            PG8_LDB(B0, 1, 0); PG8_LDB(B1, 1, 1); PG8_SCHED; PG8_LDA(At, 1, 0); PG8_STAGE(PG8_SA(0, 1), a2 + hstepA, voffA);
            PG8_WAIT_V(8); PG8_WAIT_L(0); PG8_BAR; PG8_MMA(0, 0, At, B0); PG8_MMA(0, 1, At, B1); PG8_BAR; PG8_SCHED;
            PG8_LDA(At, 1, 1); PG8_STAGE(PG8_SB(1, 0), b3, voffB); PG8_STAGE(PG8_SB(1, 1), b3 + hstepB, voffB); PG8_STAGE(PG8_SA(1, 0), a3, voffA);
            PG8_WAIT_V(8); PG8_WAIT_L(0); PG8_BAR; PG8_MMA(1, 0, At, B0); PG8_MMA(1, 1, At, B1); PG8_BAR; PG8_SCHED;
            } else {
            PG8_LDB(B0, 0, 0); PG8_SCHED; PG8_LDA(At, 0, 0); PG8_STAGE(PG8_SA(1, 1), a1 + hstepA, voffA);
            PG8_WAIT_L(8); PG8_BAR; PG8_WAIT_L(0); PG8_MMA(0, 0, At, B0); PG8_BAR; PG8_SCHED;
            PG8_LDB(B1, 0, 1); PG8_STAGE(PG8_SB(0, 0), b2, voffB);
            PG8_BAR; PG8_WAIT_L(0); PG8_MMA(0, 1, At, B1); PG8_BAR;
            PG8_LDA(At, 0, 1); PG8_STAGE(PG8_SA(0, 0), a2, voffA);
            PG8_BAR; PG8_WAIT_L(0); PG8_MMA(1, 0, At, B0); PG8_BAR; PG8_SCHED;
            PG8_STAGE(PG8_SB(0, 1), b2 + hstepB, voffB);
            PG8_WAIT_V(6); PG8_BAR; PG8_MMA(1, 1, At, B1); PG8_BAR;
            PG8_LDB(B0, 1, 0); PG8_SCHED; PG8_LDA(At, 1, 0); PG8_STAGE(PG8_SA(0, 1), a2 + hstepA, voffA);
            PG8_WAIT_L(8); PG8_BAR; PG8_WAIT_L(0); PG8_MMA(0, 0, At, B0); PG8_BAR; PG8_SCHED;
            PG8_LDB(B1, 1, 1); PG8_STAGE(PG8_SB(1, 0), b3, voffB);
            PG8_BAR; PG8_WAIT_L(0); PG8_MMA(0, 1, At, B1); PG8_BAR;
            PG8_LDA(At, 1, 1); PG8_STAGE(PG8_SA(1, 0), a3, voffA);
            PG8_BAR; PG8_WAIT_L(0); PG8_MMA(1, 0, At, B0); PG8_BAR; PG8_SCHED;
            PG8_STAGE(PG8_SB(1, 1), b3 + hstepB, voffB);
            PG8_WAIT_V(6); PG8_BAR; PG8_MMA(1, 1, At, B1); PG8_BAR;
            }
        }
        if constexpr (ALIGN_EPI) { if (wr == 0) PG8_BAR; }
        if constexpr (!Epi::AFTER_DRAIN) { E(acc, cur, wr, wc, fr, fq); S.done(cur); }
        if (!has_next) break;
#pragma unroll
        for (int a = 0; a < 2; ++a)
#pragma unroll
            for (int b = 0; b < 2; ++b)
#pragma unroll
                for (int m = 0; m < 4; ++m)
#pragma unroll
                    for (int n = 0; n < 2; ++n) acc[a][b][m][n] = (f32x4){0.f, 0.f, 0.f, 0.f};
        cur = nxt; cA = nA; cB = nB; ++ui;
        if constexpr (ALIGN_EPI) { if (wr == 1) PG8_BAR; }
    }
    PG8_WAIT_V(0);
    if constexpr (!ALIGN_EPI) { if (wr == 0) PG8_BAR; }
    PG8_BAR;
    if constexpr (Epi::AFTER_DRAIN) { E.fused(acc, cur, wr, wc, fr, fq, lds, wid, lane); S.done(cur); }
#undef PG8_SA
#undef PG8_SB
#undef PG8_STAGE
#undef PG8_LDA
#undef PG8_LDB
#undef PG8_MMA
#undef PG8_WAIT_V
#undef PG8_WAIT_L
#undef PG8_BAR
#undef PG8_SCHED
}
}
#ifndef PG8_SP2
#define PG8_SP2 true
#endif
#ifndef PG8_ALIGN
#define PG8_ALIGN true
#endif
#ifndef MK_N_LAUNCHES
#define MK_N_LAUNCHES 1
#endif
#ifndef DUP_PHASE
#define DUP_PHASE -1
#endif
#ifndef FAST_MLA
#define FAST_MLA 1
#endif
#ifndef FAST_DIL
#define FAST_DIL 1
#endif

constexpr int NBATCH = 4, SEQ = 4096, DM = 2048, TOK = NBATCH * SEQ;
constexpr int NC = 6464, NCP = 6656;
constexpr int C_CQ = 0, C_CKV = 768, C_KR = 1280, C_GA = 1344, C_QB = 2368, C_KB = 3392, C_VB = 4416, C_GB = 5440;
constexpr int QA_W = 1536, KVA_W = 2048;
constexpr float EPS = 1e-6f;
constexpr float LOG2E = 1.4426950408889634f, LN2 = 0.6931471805599453f;
constexpr float QSCALE_MLA = 0.07216878364870322f * LOG2E;
constexpr float QSCALE_DIL = 0.08838834764831845f * LOG2E;
constexpr int NPH = 8;

constexpr size_t MiB = 1u << 20;
constexpr size_t WS_TAB128 = 0, WS_TAB64 = 2 * MiB, WS_CTL = 3 * MiB, CTL_BYTES = 16384;
constexpr size_t WS_WIN = 4 * MiB, WS_WUQ = 30 * MiB, WS_WUKV = 33 * MiB, WS_WOUT = 35 * MiB;
constexpr size_t WS_PROJ = 44 * MiB;
constexpr size_t WS_HN = 252 * MiB;
constexpr size_t WS_OA = 252 * MiB, WS_OD1 = 284 * MiB;
constexpr size_t WS_QA = 316 * MiB;
constexpr size_t WS_KVA = 364 * MiB;
constexpr size_t WS_OD2 = 428 * MiB, WS_OD3 = 460 * MiB;
constexpr size_t WS_LSE = 492 * MiB;
constexpr size_t WS_Y = 316 * MiB;
constexpr size_t WS_END = 494 * MiB;
constexpr int LDS_BYTES = 139264;

#define LAS __attribute__((address_space(3)))
#define DI __device__ __forceinline__
typedef unsigned short bf16_t;
typedef unsigned u32x4 __attribute__((ext_vector_type(4)));
typedef unsigned u32x2 __attribute__((ext_vector_type(2)));
typedef float f32x4 __attribute__((ext_vector_type(4)));
typedef float f32x2 __attribute__((ext_vector_type(2)));

struct Params { const float* in[14]; float* out; unsigned char* ws; int ph_lo, ph_hi; };

DI float bflo(unsigned w) { return __uint_as_float(w << 16); }
DI float bfhi(unsigned w) { return __uint_as_float(w & 0xffff0000u); }
DI unsigned pk2(float lo, float hi) { return pg8::cvt_pk_bf16(lo, hi); }
DI void unpack8(const u32x4 v, f32x4& a, f32x4& b) { a = (f32x4){bflo(v.x), bfhi(v.x), bflo(v.y), bfhi(v.y)}; b = (f32x4){bflo(v.z), bfhi(v.z), bflo(v.w), bfhi(v.w)}; }
DI u32x4 pack8(const f32x4 a, const f32x4 b) { u32x4 r; r.x = pk2(a.x, a.y); r.y = pk2(a.z, a.w); r.z = pk2(b.x, b.y); r.w = pk2(b.z, b.w); return r; }
DI float sumsq8(const f32x4 a, const f32x4 b) { return (a.x * a.x + a.y * a.y) + (a.z * a.z + a.w * a.w) + (b.x * b.x + b.y * b.y) + (b.z * b.z + b.w * b.w); }
DI float wave_sum(float v) {
#pragma unroll
    for (int o = 1; o < 64; o <<= 1) v += __shfl_xor(v, o);
    return v; }
DI float wave_max(float v) {
#pragma unroll
    for (int o = 1; o < 64; o <<= 1) v = fmaxf(v, __shfl_xor(v, o));
    return v; }
DI float grp_sum8(float v) { v += __shfl_xor(v, 1); v += __shfl_xor(v, 2); v += __shfl_xor(v, 4); return v; }
DI float grp_sum16(float v) { v = grp_sum8(v); v += __shfl_xor(v, 8); return v; }
DI float rstd_of(float ss, float inv_n) { return 1.0f / sqrtf(ss * inv_n + EPS); }
DI float silu(float x) { return x / (1.0f + __expf(-x)); }
DI f32x4 silu4(f32x4 x) { return (f32x4){silu(x.x), silu(x.y), silu(x.z), silu(x.w)}; }
DI void rope8(f32x4& a, f32x4& b, int xr, bool first, const f32x4* tab) {
    f32x4 pa, pb;
    pa.x = __shfl_xor(a.x, xr); pa.y = __shfl_xor(a.y, xr); pa.z = __shfl_xor(a.z, xr); pa.w = __shfl_xor(a.w, xr);
    pb.x = __shfl_xor(b.x, xr); pb.y = __shfl_xor(b.y, xr); pb.z = __shfl_xor(b.z, xr); pb.w = __shfl_xor(b.w, xr);
    const float sg = first ? -1.f : 1.f;
    const f32x4 t0 = tab[0], t1 = tab[1], t2 = tab[2], t3 = tab[3];
    a.x = a.x * t0.x + sg * pa.x * t0.y; a.y = a.y * t0.z + sg * pa.y * t0.w; a.z = a.z * t1.x + sg * pa.z * t1.y; a.w = a.w * t1.z + sg * pa.w * t1.w;
    b.x = b.x * t2.x + sg * pb.x * t2.y; b.y = b.y * t2.z + sg * pb.y * t2.w; b.z = b.z * t3.x + sg * pb.z * t3.y; b.w = b.w * t3.z + sg * pb.w * t3.w;
}

DI void p0_transpose_item(const float* W, int K, int N, bf16_t* WT, LAS float* scr, int item, int lane) {
    const int nblk = N / 32, kb = item / nblk, nb = item % nblk, k0 = 64 * kb, n0 = 32 * nb;
#pragma unroll 8
    for (int i = 0; i < 32; ++i) { const int kk = 2 * i + (lane >> 5); scr[kk * 33 + (lane & 31)] = W[(size_t)(k0 + kk) * N + n0 + (lane & 31)]; }
    asm volatile("s_waitcnt lgkmcnt(0)" ::: "memory");
    const int c = lane & 7;
#pragma unroll
    for (int j = 0; j < 4; ++j) { const int n = (lane >> 3) + 8 * j; const LAS float* s = scr + (8 * c) * 33 + n;
        u32x4 o; o.x = pk2(s[0 * 33], s[1 * 33]); o.y = pk2(s[2 * 33], s[3 * 33]); o.z = pk2(s[4 * 33], s[5 * 33]); o.w = pk2(s[6 * 33], s[7 * 33]);
        *(u32x4*)(WT + (size_t)(n0 + n) * K + k0 + 8 * c) = o; }
    asm volatile("s_waitcnt lgkmcnt(0)" ::: "memory");
}
DI void phase0(const Params& p, LAS unsigned char* lds, int gw, int NGW, int lane, int wave) {
    unsigned char* ws = p.ws;
    LAS float* scr = (LAS float*)(lds + wave * 16384);
    constexpr int I_IN = (DM / 64) * (NC / 32), I_UQ = (768 / 64) * (QA_W / 32), I_UKV = (512 / 64) * (KVA_W / 32), I_OUT = (DM / 64) * (DM / 32);
    constexpr int NITEMS = I_IN + I_UQ + I_UKV + I_OUT;
    for (int it = gw; it < NITEMS; it += NGW) {
        int r = it;
        if (r < I_IN) { p0_transpose_item(p.in[2], DM, NC, (bf16_t*)(ws + WS_WIN), scr, r, lane); continue; } r -= I_IN;
        if (r < I_UQ) { p0_transpose_item(p.in[5], 768, QA_W, (bf16_t*)(ws + WS_WUQ), scr, r, lane); continue; } r -= I_UQ;
        if (r < I_UKV) { p0_transpose_item(p.in[6], 512, KVA_W, (bf16_t*)(ws + WS_WUKV), scr, r, lane); continue; } r -= I_UKV;
        p0_transpose_item(p.in[13], DM, DM, (bf16_t*)(ws + WS_WOUT), scr, r, lane);
    }
    const int gt = gw * 64 + lane, NGT = NGW * 64;
    {
        u32x4* z = (u32x4*)((bf16_t*)(ws + WS_WIN) + (size_t)NC * DM);
        for (int i = gt; i < (NCP - NC) * DM / 8; i += NGT) z[i] = (u32x4){0u, 0u, 0u, 0u};
    }
    for (int i = gt; i < SEQ * 96; i += NGT) {
        int s, j; float e; f32x2* dst;
        if (i < SEQ * 64) { s = i >> 6; j = i & 63; e = (float)(2 * j) * (1.0f / 128.0f); dst = (f32x2*)(ws + WS_TAB128) + i; }
        else { const int k = i - SEQ * 64; s = k >> 5; j = k & 31; e = (float)(2 * j) * (1.0f / 64.0f); dst = (f32x2*)(ws + WS_TAB64) + k; }
        const float inv = (float)exp2(-(double)e * 13.287712379549449);
        const float ang = (float)s * inv;
        const double rev = (double)ang * 0.15915494309189535;
        const float fr = (float)(rev - rint(rev));
        *dst = (f32x2){__builtin_amdgcn_cosf(fr), __builtin_amdgcn_sinf(fr)};
    }
    const f32x4* g4 = (const f32x4*)p.in[1];
    for (int m = gw; m < TOK; m += NGW) {
        const f32x4* xr = (const f32x4*)(p.in[0] + (size_t)m * DM) + lane;
        f32x4 v[8]; float ss = 0.f;
#pragma unroll
        for (int j = 0; j < 8; ++j) { v[j] = xr[64 * j]; ss += (v[j].x * v[j].x + v[j].y * v[j].y) + (v[j].z * v[j].z + v[j].w * v[j].w); }
        const float rstd = rstd_of(wave_sum(ss), 1.0f / DM);
        u32x2* o8 = (u32x2*)((bf16_t*)(ws + WS_HN) + (size_t)m * DM) + lane;
#pragma unroll
        for (int j = 0; j < 8; ++j) { const f32x4 g = g4[64 * j + lane]; const f32x4 y = v[j] * rstd * g; o8[64 * j] = (u32x2){pk2(y.x, y.y), pk2(y.z, y.w)}; }
    }
}

DI void e1_row(const Params& p, int row, int lane, bool dry) {
    unsigned char* ws = p.ws;
    const int t = row & (SEQ - 1);
    u32x4* r16 = (u32x4*)((bf16_t*)(ws + WS_PROJ) + (size_t)row * NCP);
    {
        const u32x4 v0 = r16[lane]; const u32x4 v1 = lane < 32 ? r16[64 + lane] : (u32x4){0u, 0u, 0u, 0u};
        f32x4 a0, b0, a1, b1; unpack8(v0, a0, b0); unpack8(v1, a1, b1);
        const float rstd = rstd_of(wave_sum(sumsq8(a0, b0) + sumsq8(a1, b1)), 1.0f / 768.0f);
        const f32x4* g = (const f32x4*)p.in[3];
        if (!dry) r16[lane] = pack8(a0 * rstd * g[2 * lane], b0 * rstd * g[2 * lane + 1]);
        if (!dry && lane < 32) r16[64 + lane] = pack8(a1 * rstd * g[2 * (64 + lane)], b1 * rstd * g[2 * (64 + lane) + 1]);
    }
    {
        f32x4 a, b; unpack8(r16[96 + lane], a, b);
        const float rstd = rstd_of(wave_sum(sumsq8(a, b)), 1.0f / 512.0f);
        const f32x4* g = (const f32x4*)p.in[4];
        if (!dry) r16[96 + lane] = pack8(a * rstd * g[2 * lane], b * rstd * g[2 * lane + 1]);
    }
    {
        const int c = lane & 7;
        f32x4 a, b; unpack8(r16[160 + c], a, b);
        const float rstd = rstd_of(grp_sum8(sumsq8(a, b)), 1.0f / 64.0f);
        const f32x4* g = (const f32x4*)p.in[8] + 32;
        a = a * rstd * g[2 * c]; b = b * rstd * g[2 * c + 1];
        rope8(a, b, 4, c < 4, (const f32x4*)(ws + WS_TAB64) + (t * 32 + (c & 3) * 8) / 2);
        if (!dry && lane < 8) r16[160 + c] = pack8(a, b);
    }
#pragma unroll
    for (int it = 0; it < 4; ++it) {
        const int c = lane & 15;
        u32x4* ptr = r16 + (C_QB / 8) + it * 64 + lane;
        f32x4 a, b; unpack8(*ptr, a, b);
        const float rstd = rstd_of(grp_sum16(sumsq8(a, b)), 1.0f / 128.0f);
        const f32x4* g = (const f32x4*)(it < 2 ? p.in[9] : p.in[10]);
        a = a * rstd * g[2 * c]; b = b * rstd * g[2 * c + 1];
        rope8(a, b, 8, c < 8, (const f32x4*)(ws + WS_TAB128) + (t * 64 + (c & 7) * 8) / 2);
        if (it < 2) { a = a * QSCALE_DIL; b = b * QSCALE_DIL; }
        if (!dry) *ptr = pack8(a, b);
    }
}

DI void e2_row(const Params& p, int row, int lane, bool dry) {
    unsigned char* ws = p.ws;
    const int t = row & (SEQ - 1);
    u32x4* q16 = (u32x4*)((bf16_t*)(ws + WS_QA) + (size_t)row * QA_W);
    u32x4* kv16 = (u32x4*)((bf16_t*)(ws + WS_KVA) + (size_t)row * KVA_W);
    const f32x4* gq = (const f32x4*)p.in[7];
    const f32x4* gk = (const f32x4*)p.in[8];
#pragma unroll
    for (int it = 0; it < 2; ++it) {
        const int idx = it * 64 + lane, h = idx >> 4, c = idx & 15;
        u32x4* ptr = q16 + h * 24 + c;
        f32x4 a, b; unpack8(*ptr, a, b);
        const float rstd = rstd_of(grp_sum16(sumsq8(a, b)), 1.0f / 128.0f) * QSCALE_MLA;
        if (!dry) *ptr = pack8(a * rstd * gq[2 * c], b * rstd * gq[2 * c + 1]);
    }
    {
        const int h = lane >> 3, c = lane & 7;
        u32x4* ptr = q16 + h * 24 + 16 + c;
        f32x4 a, b; unpack8(*ptr, a, b);
        const float rstd = rstd_of(grp_sum8(sumsq8(a, b)), 1.0f / 64.0f);
        a = a * rstd * gq[32 + 2 * c]; b = b * rstd * gq[32 + 2 * c + 1];
        rope8(a, b, 4, c < 4, (const f32x4*)(ws + WS_TAB64) + (t * 32 + (c & 3) * 8) / 2);
        if (!dry) *ptr = pack8(a * QSCALE_MLA, b * QSCALE_MLA);
    }
#pragma unroll
    for (int it = 0; it < 2; ++it) {
        const int idx = it * 64 + lane, h = idx >> 4, c = idx & 15;
        u32x4* ptr = kv16 + h * 32 + c;
        f32x4 a, b; unpack8(*ptr, a, b);
        const float rstd = rstd_of(grp_sum16(sumsq8(a, b)), 1.0f / 128.0f);
        if (!dry) *ptr = pack8(a * rstd * gk[2 * c], b * rstd * gk[2 * c + 1]);
    }
}

DI void e3_row(const Params& p, int row, int lane) {
    unsigned char* ws = p.ws;
    const u32x4* r16 = (const u32x4*)((const bf16_t*)(ws + WS_PROJ) + (size_t)row * NCP);
    u32x4* y16 = (u32x4*)((bf16_t*)(ws + WS_Y) + (size_t)row * DM);
    {
        const u32x4* o16 = (const u32x4*)((const bf16_t*)(ws + WS_OA) + (size_t)row * 1024);
        f32x4 a0, b0, a1, b1; unpack8(o16[lane], a0, b0); unpack8(o16[64 + lane], a1, b1);
        const float rstd = rstd_of(wave_sum(sumsq8(a0, b0) + sumsq8(a1, b1)), 1.0f / 1024.0f);
        const f32x4* g = (const f32x4*)p.in[11];
        f32x4 ga0, gb0, ga1, gb1; unpack8(r16[C_GA / 8 + lane], ga0, gb0); unpack8(r16[C_GA / 8 + 64 + lane], ga1, gb1);
        y16[lane] = pack8(a0 * rstd * g[2 * lane] * silu4(ga0), b0 * rstd * g[2 * lane + 1] * silu4(gb0));
        y16[64 + lane] = pack8(a1 * rstd * g[2 * (64 + lane)] * silu4(ga1), b1 * rstd * g[2 * (64 + lane) + 1] * silu4(gb1));
    }
    {
        const float* lse = (const float*)(ws + WS_LSE);
        f32x4 oa[2], ob[2]; float ss = 0.f;
#pragma unroll
        for (int j = 0; j < 2; ++j) {
            const int cidx = j * 64 + lane, h = cidx >> 4;
            const float l0 = lse[(size_t)row * 8 + h], l1 = lse[(size_t)TOK * 8 + (size_t)row * 8 + h], l2 = lse[(size_t)2 * TOK * 8 + (size_t)row * 8 + h];
            const float mx = fmaxf(l0, fmaxf(l1, l2));
            float w0 = __expf(l0 - mx), w1 = __expf(l1 - mx), w2 = __expf(l2 - mx);
            const float inv = 1.0f / (w0 + w1 + w2); w0 *= inv; w1 *= inv; w2 *= inv;
            f32x4 a, b, c, d, e, f;
            unpack8(((const u32x4*)((const bf16_t*)(ws + WS_OD1) + (size_t)row * 1024))[cidx], a, b);
            unpack8(((const u32x4*)((const bf16_t*)(ws + WS_OD2) + (size_t)row * 1024))[cidx], c, d);
            unpack8(((const u32x4*)((const bf16_t*)(ws + WS_OD3) + (size_t)row * 1024))[cidx], e, f);
            oa[j] = a * w0 + c * w1 + e * w2; ob[j] = b * w0 + d * w1 + f * w2;
            ss += sumsq8(oa[j], ob[j]);
        }
        const float rstd = rstd_of(wave_sum(ss), 1.0f / 1024.0f);
        const f32x4* g = (const f32x4*)p.in[12];
#pragma unroll
        for (int j = 0; j < 2; ++j) {
            const int cidx = j * 64 + lane;
            f32x4 ga, gb; unpack8(r16[C_GB / 8 + cidx], ga, gb);
            y16[128 + cidx] = pack8(oa[j] * rstd * g[2 * cidx] * silu4(ga), ob[j] * rstd * g[2 * cidx + 1] * silu4(gb));
        }
    }
}

DI void naive_attn_row(const bf16_t* q, const bf16_t* k1, size_t k1s, const bf16_t* k2, size_t k2s, const bf16_t* v, size_t vs,
                       int t, int d, int nkeys, bf16_t* o, float* lse, LAS float* qs, int lane) {
    const int DK = k2 ? 192 : 128;
    for (int i = lane; i < DK; i += 64) qs[i] = __uint_as_float((unsigned)q[i] << 16);
    asm volatile("s_waitcnt lgkmcnt(0)" ::: "memory");
    float m = -1e30f, l = 0.f, o0 = 0.f, o1 = 0.f;
    for (int c0 = 0; c0 < nkeys; c0 += 64) {
        const int ik = c0 + lane; const bool valid = ik < nkeys; const int j = valid ? t - d * ik : t;
        float s = 0.f;
        const u32x4* kp = (const u32x4*)(k1 + (size_t)j * k1s);
#pragma unroll 4
        for (int ch = 0; ch < 16; ++ch) { f32x4 a, b; unpack8(kp[ch], a, b); const LAS f32x4* qq = (const LAS f32x4*)(qs + ch * 8); const f32x4 qa = qq[0], qb = qq[1];
            s += (a.x * qa.x + a.y * qa.y) + (a.z * qa.z + a.w * qa.w) + (b.x * qb.x + b.y * qb.y) + (b.z * qb.z + b.w * qb.w); }
        if (k2) { const u32x4* kp2 = (const u32x4*)(k2 + (size_t)j * k2s);
#pragma unroll 4
            for (int ch = 0; ch < 8; ++ch) { f32x4 a, b; unpack8(kp2[ch], a, b); const LAS f32x4* qq = (const LAS f32x4*)(qs + 128 + ch * 8); const f32x4 qa = qq[0], qb = qq[1];
                s += (a.x * qa.x + a.y * qa.y) + (a.z * qa.z + a.w * qa.w) + (b.x * qb.x + b.y * qb.y) + (b.z * qb.z + b.w * qb.w); } }
        s = valid ? s : -1e30f;
        const float mn = fmaxf(m, wave_max(s)); const float corr = exp2f(m - mn); const float pe = valid ? exp2f(s - mn) : 0.f;
        l = l * corr + wave_sum(pe); o0 *= corr; o1 *= corr; m = mn;
        const int cnt = min(64, nkeys - c0);
        for (int i = 0; i < cnt; ++i) { const float pi = __shfl(pe, i); const int jj = t - d * (c0 + i);
            const unsigned vv = *(const unsigned*)(v + (size_t)jj * vs + 2 * lane); o0 += pi * bflo(vv); o1 += pi * bfhi(vv); }
    }
    const float il = 1.0f / l;
    *(unsigned*)(o + 2 * lane) = pk2(o0 * il, o1 * il);
    if (lse && lane == 0) *lse = (m + log2f(l)) * LN2;
    asm volatile("s_waitcnt lgkmcnt(0)" ::: "memory");
}
DI void phase5_naive(const Params& p, LAS unsigned char* lds, int gw, int NGW, int lane, int wave, int type_lo, int type_hi) {
    unsigned char* ws = p.ws;
    LAS float* qs = (LAS float*)(lds + wave * 1024);
    const bf16_t* proj = (const bf16_t*)(ws + WS_PROJ); const bf16_t* qa = (const bf16_t*)(ws + WS_QA); const bf16_t* kva = (const bf16_t*)(ws + WS_KVA);
    for (int item = type_lo * TOK * 8 + gw; item < type_hi * TOK * 8; item += NGW) {
        const int type = item / (TOK * 8), rem = item % (TOK * 8), row = rem >> 3, h = rem & 7, b = row >> 12, t = row & (SEQ - 1);
        const size_t brow = (size_t)b * SEQ;
        if (type == 0) {
            naive_attn_row(qa + (size_t)row * QA_W + h * 192, kva + brow * KVA_W + h * 256, KVA_W, proj + brow * NCP + C_KR, NCP, kva + brow * KVA_W + h * 256 + 128, KVA_W,
                           t, 1, t + 1, (bf16_t*)(ws + WS_OA) + (size_t)row * 1024 + h * 128, nullptr, qs, lane);
        } else {
            const int pidx = type - 1, d = pidx == 0 ? 1 : (pidx == 1 ? 4 : 16);
            bf16_t* od = (bf16_t*)(ws + (pidx == 0 ? WS_OD1 : (pidx == 1 ? WS_OD2 : WS_OD3)));
            naive_attn_row(proj + (size_t)row * NCP + C_QB + h * 128, proj + brow * NCP + C_KB + h * 128, NCP, nullptr, 0, proj + brow * NCP + C_VB + h * 128, NCP,
                           t, d, min(t / d, 128) + 1, od + (size_t)row * 1024 + h * 128, (float*)(ws + WS_LSE) + (size_t)pidx * TOK * 8 + (size_t)row * 8 + h, qs, lane);
        }
    }
}

namespace fa {
typedef short bf16x8 __attribute__((ext_vector_type(8)));
typedef short s16x4 __attribute__((ext_vector_type(4)));
typedef float f32x16 __attribute__((ext_vector_type(16)));
#define FA_MFMA(a, b, c) __builtin_amdgcn_mfma_f32_32x32x16_bf16((a), (b), (c), 0, 0, 0)
struct Unit {
    const bf16_t* q; unsigned qs; const bf16_t* k1; unsigned k1s; const bf16_t* k2; unsigned k2s; const bf16_t* v; unsigned vs;
    bf16_t* o; unsigned os; float* lse; unsigned lses; int l0, kt_begin, W;
};
DI unsigned v_off(int row, int ch) { return 2048u * (row >> 3) + 512u * (ch >> 2) + 64u * (row & 7) + 16u * ((ch & 3) ^ ((row >> 2) & 3)); }

template <int DK>
DI void unit_run(const Unit& u, LAS unsigned char* lds, int tid, int lane, int wave) {
    constexpr int NKS = DK / 16;
    constexpr int K1BYTES = 64 * 256, K2BYTES = (DK == 192) ? 64 * 128 : 0, KBYTES = K1BYTES + K2BYTES, VBYTES = 64 * 256, STAGE = KBYTES + VBYTES;
    const int hi = lane >> 5, l31 = lane & 31;
    const int wq0 = u.l0 + 32 * wave, W = u.W;
    bf16x8 qf[NKS];
    {   const unsigned qo = (unsigned)(wq0 + l31) * u.qs + 8u * hi;
#pragma unroll
        for (int ks = 0; ks < NKS; ++ks) qf[ks] = *(const bf16x8*)(u.q + (qo + 16u * ks)); }
    const int ntiles = (u.l0 + 256 - u.kt_begin) >> 6;
#define FA_DMA(kt, st) do { LAS unsigned char* sb_ = lds + (st) * STAGE; \
        _Pragma("unroll") for (int n = 0; n < 2; ++n) { \
            { const int s = (2 * wave + n) * 64 + lane, row = s >> 4, cc = (s & 15) ^ (row & 15); \
              __builtin_amdgcn_global_load_lds((const unsigned*)(u.k1 + ((unsigned)((kt) + row) * u.k1s + 8u * cc)), (LAS unsigned*)(sb_ + (2 * wave + n) * 1024), 16, 0, 0); } \
            { const int s = (2 * wave + n) * 64 + lane, row = 8 * (s >> 7) + ((s >> 2) & 7), ch = 4 * ((s >> 5) & 3) + ((s & 3) ^ ((row >> 2) & 3)); \
              __builtin_amdgcn_global_load_lds((const unsigned*)(u.v + ((unsigned)((kt) + row) * u.vs + 8u * ch)), (LAS unsigned*)(sb_ + KBYTES + (2 * wave + n) * 1024), 16, 0, 0); } } \
        if (DK == 192) { const int s = wave * 64 + lane, row = s >> 3, cc = (s & 7) ^ ((row >> 1) & 7); \
            __builtin_amdgcn_global_load_lds((const unsigned*)(u.k2 + ((unsigned)((kt) + row) * u.k2s + 8u * cc)), (LAS unsigned*)(sb_ + K1BYTES + wave * 1024), 16, 0, 0); } } while (0)
    FA_DMA(u.kt_begin, 0);
    __syncthreads();
    f32x16 O[4];
#pragma unroll
    for (int c = 0; c < 4; ++c)
#pragma unroll
        for (int r = 0; r < 16; ++r) O[c][r] = 0.f;
    float m = -1e30f, l = 0.f;
    const unsigned x1 = (unsigned)(l31 & 15), x2 = (unsigned)((l31 >> 1) & 7);
    const unsigned ka1 = (unsigned)(l31 * 256) + 16u * ((hi ^ x1) & 1u), kx1 = 16u * (x1 & 14u);
    const unsigned ka2 = (unsigned)(K1BYTES + l31 * 128) + 16u * ((hi ^ x2) & 1u), kx2 = 16u * (x2 & 6u);
    const int q4 = (lane & 15) >> 2, p4 = lane & 3, blk = (lane >> 4) & 1;
    const unsigned va0 = (unsigned)(KBYTES + 64 * (4 * hi + q4) + 16 * ((2 * blk + (p4 >> 1)) ^ (hi)) + 8 * (p4 & 1));
    const unsigned va1 = (unsigned)(KBYTES + 64 * (4 * hi + q4) + 16 * ((2 * blk + (p4 >> 1)) ^ (2 + hi)) + 8 * (p4 & 1));
    for (int it = 0; it < ntiles; ++it) {
        const int kt0 = u.kt_begin + 64 * it, cur = it & 1;
        if (it + 1 < ntiles) FA_DMA(kt0 + 64, cur ^ 1);
        const bool relevant = (kt0 <= wq0 + 31) && (kt0 + 63 >= wq0 - W);
        if (relevant) {
            const LAS unsigned char* sb = lds + cur * STAGE;
            f32x16 S0, S1;
#pragma unroll
            for (int r = 0; r < 16; ++r) { S0[r] = 0.f; S1[r] = 0.f; }
#pragma unroll
            for (int ks = 0; ks < NKS; ++ks) {
                const unsigned ko = ks < 8 ? ka1 + ((32u * ks) ^ kx1) : ka2 + ((32u * (ks - 8)) ^ kx2);
                const bf16x8 a0 = *(const LAS bf16x8*)(sb + ko);
                const bf16x8 a1 = *(const LAS bf16x8*)(sb + ko + (ks < 8 ? 32 * 256 : 32 * 128));
                S0 = FA_MFMA(a0, qf[ks], S0); S1 = FA_MFMA(a1, qf[ks], S1);
                if ((ks & 3) == 3) __builtin_amdgcn_sched_barrier(0);
            }
            const bool needmask = !((kt0 + 63 <= wq0) && (kt0 >= wq0 + 31 - W));
            if (needmask) {
                const int dq = wq0 + l31 - kt0 - 4 * hi;
#pragma unroll
                for (int r = 0; r < 16; ++r) { const int d0 = dq - ((r & 3) + 8 * (r >> 2)), d1 = d0 - 32;
                    S0[r] = (d0 >= 0 && d0 <= W) ? S0[r] : -INFINITY; S1[r] = (d1 >= 0 && d1 <= W) ? S1[r] : -INFINITY; }
            }
            float mx = fmaxf(S0[0], S1[0]);
#pragma unroll
            for (int r = 1; r < 16; ++r) mx = fmaxf(mx, fmaxf(S0[r], S1[r]));
            mx = fmaxf(mx, __shfl_xor(mx, 32));
            const float mn = fmaxf(m, mx); const float corr = __builtin_amdgcn_exp2f(m - mn); m = mn;
            float ps = 0.f;
#pragma unroll
            for (int r = 0; r < 16; ++r) { S0[r] = __builtin_amdgcn_exp2f(S0[r] - mn); S1[r] = __builtin_amdgcn_exp2f(S1[r] - mn); ps += S0[r] + S1[r]; }
            l = l * corr + ps;
#pragma unroll
            for (int c = 0; c < 4; ++c)
#pragma unroll
                for (int r = 0; r < 16; ++r) O[c][r] *= corr;
            bf16x8 P[2][2];
#pragma unroll
            for (int j = 0; j < 2; ++j) {
                u32x4 w0, w1;
                w0.x = pk2(S0[8 * j + 0], S0[8 * j + 1]); w0.y = pk2(S0[8 * j + 2], S0[8 * j + 3]); w0.z = pk2(S0[8 * j + 4], S0[8 * j + 5]); w0.w = pk2(S0[8 * j + 6], S0[8 * j + 7]);
                w1.x = pk2(S1[8 * j + 0], S1[8 * j + 1]); w1.y = pk2(S1[8 * j + 2], S1[8 * j + 3]); w1.z = pk2(S1[8 * j + 4], S1[8 * j + 5]); w1.w = pk2(S1[8 * j + 6], S1[8 * j + 7]);
                P[0][j] = __builtin_bit_cast(bf16x8, w0); P[1][j] = __builtin_bit_cast(bf16x8, w1);
            }
#pragma unroll
            for (int kb = 0; kb < 2; ++kb)
#pragma unroll
                for (int j = 0; j < 2; ++j)
#pragma unroll
                    for (int c = 0; c < 4; ++c) {
                        const s16x4 lo = __builtin_amdgcn_ds_read_tr16_b64_v4i16((LAS s16x4*)(sb + va0 + 2048 * (4 * kb + 2 * j) + 512 * c));
                        const s16x4 hv = __builtin_amdgcn_ds_read_tr16_b64_v4i16((LAS s16x4*)(sb + va1 + 2048 * (4 * kb + 2 * j + 1) + 512 * c));
                        const bf16x8 vf = __builtin_shufflevector(lo, hv, 0, 1, 2, 3, 4, 5, 6, 7);
                        O[c] = FA_MFMA(vf, P[kb][j], O[c]);
                        if (c == 3) __builtin_amdgcn_sched_barrier(0);
                    }
        }
        __syncthreads();
    }
#undef FA_DMA
    l += __shfl_xor(l, 32);
    const float il = 1.0f / l;
    bf16_t* orow = u.o + ((unsigned)(wq0 + l31) * u.os + 4u * hi);
#pragma unroll
    for (int c = 0; c < 4; ++c)
#pragma unroll
        for (int g = 0; g < 4; ++g) {
            u32x2 w; w.x = pk2(O[c][4 * g + 0] * il, O[c][4 * g + 1] * il); w.y = pk2(O[c][4 * g + 2] * il, O[c][4 * g + 3] * il);
            *(u32x2*)(orow + 32 * c + 8 * g) = w;
        }
    if (u.lse && hi == 0) u.lse[(unsigned)(wq0 + l31) * u.lses] = (m + __builtin_amdgcn_logf(l)) * LN2;
}
}

DI void phase5_fast(const Params& p, LAS unsigned char* lds) {
    int tid = threadIdx.x; asm volatile("" : "+v"(tid));
    const int lane = tid & 63, wave = __builtin_amdgcn_readfirstlane(tid >> 6);
    unsigned char* ws = p.ws;
    const int G = gridDim.x, bid = blockIdx.x;
    const bf16_t* proj = (const bf16_t*)(ws + WS_PROJ); const bf16_t* qa = (const bf16_t*)(ws + WS_QA); const bf16_t* kva = (const bf16_t*)(ws + WS_KVA);
    if (FAST_MLA) for (int pi = bid; pi < 256; pi += G) {
        const int vv = pi >> 3, bh = (pi & 7) * 4 + (vv >> 3), j = vv & 7, b = bh >> 3, h = bh & 7;
        const size_t brow = (size_t)b * SEQ;
#pragma unroll 1
        for (int s = 0; s < 2; ++s) {
            const int qb = s == 0 ? 15 - j : j;
            fa::Unit u;
            u.q = qa + brow * QA_W + h * 192; u.qs = QA_W;
            u.k1 = kva + brow * KVA_W + h * 256; u.k1s = KVA_W; u.k2 = proj + brow * NCP + C_KR; u.k2s = NCP;
            u.v = kva + brow * KVA_W + h * 256 + 128; u.vs = KVA_W;
            u.o = (bf16_t*)(ws + WS_OA) + brow * 1024 + h * 128; u.os = 1024; u.lse = nullptr; u.lses = 0;
            u.l0 = 256 * qb; u.kt_begin = 0; u.W = 1 << 30;
            fa::unit_run<192>(u, lds, tid, lane, wave);
        }
    }
    if (FAST_DIL)
#pragma unroll 1
    for (int ui = bid; ui < 1536; ui += G) {
        const int pidx = ui >> 9, rem = ui & 511, bh = rem >> 4, sub = rem & 15, b = bh >> 3, h = bh & 7;
        const int d = pidx == 0 ? 1 : (pidx == 1 ? 4 : 16), nub = 16 / d, r = sub / nub, ub = sub % nub;
        const size_t row0 = (size_t)b * SEQ + r;
        fa::Unit u;
        u.q = proj + row0 * NCP + C_QB + h * 128; u.qs = (unsigned)d * NCP;
        u.k1 = proj + row0 * NCP + C_KB + h * 128; u.k1s = (unsigned)d * NCP; u.k2 = nullptr; u.k2s = 0;
        u.v = proj + row0 * NCP + C_VB + h * 128; u.vs = (unsigned)d * NCP;
        u.o = (bf16_t*)(ws + (pidx == 0 ? WS_OD1 : (pidx == 1 ? WS_OD2 : WS_OD3))) + row0 * 1024 + h * 128; u.os = (unsigned)d * 1024;
        u.lse = (float*)(ws + WS_LSE) + (size_t)pidx * TOK * 8 + row0 * 8 + h; u.lses = (unsigned)d * 8;
        u.l0 = 256 * ub; u.kt_begin = u.l0 >= 128 ? u.l0 - 128 : 0; u.W = 128;
        fa::unit_run<128>(u, lds, tid, lane, wave);
    }
}

#define XB_TMO      128
#define XB_XCNT(j)  (256  + 64 * (j))
#define XB_XSUB(j)  (1280 + 64 * (j))
#define XB_XGEN(j)  (2304 + 64 * (j))
#define XB_TOP      3328
#define XB_TOPGEN   3392
#define XCD_BAR_WORDS 3456
#define XB_SPIN_CAP (1u << 18)

__device__ __forceinline__ unsigned xb_ld(unsigned* p)              { return __hip_atomic_load(p, __ATOMIC_RELAXED, __HIP_MEMORY_SCOPE_AGENT); }
__device__ __forceinline__ unsigned xb_add(unsigned* p, unsigned v) { return __hip_atomic_fetch_add(p, v, __ATOMIC_RELAXED, __HIP_MEMORY_SCOPE_AGENT); }
__device__ __forceinline__ unsigned xb_xcc_id() { return (unsigned)__builtin_amdgcn_s_getreg((3 << 11) | 20) & 0xFu; }
#define XB_SPIN(cond, bar) do { unsigned _sp = 0; while (cond) { __builtin_amdgcn_s_sleep(1); \
    if ((++_sp & 255u) == 0u) { if (xb_ld(&(bar)[XB_TMO])) break; if (_sp > XB_SPIN_CAP) { atomicAdd(&(bar)[XB_TMO], 1u); break; } } } } while (0)

struct XcdBarrier {
    unsigned* bar; unsigned x;
    volatile LAS unsigned* st;
};

__device__ __forceinline__ XcdBarrier xcd_barrier_post(unsigned* bar, volatile LAS unsigned* st) {
    XcdBarrier b; b.bar = bar; b.x = xb_xcc_id(); b.st = st;
    if (threadIdx.x == 0) (void)xb_add(&bar[XB_XCNT(b.x)], 1u);
    return b;
}
__device__ __forceinline__ void xcd_barrier_complete(unsigned* bar, unsigned x, unsigned& nloc, unsigned& nx) {
    const unsigned G = gridDim.x * gridDim.y * gridDim.z;
    unsigned sum, cnt, mine, sp = 0u;
    for (;;) {
        sum = 0u; cnt = 0u; mine = 0u;
#pragma unroll
        for (unsigned j = 0; j < 16; ++j) { const unsigned c = xb_ld(&bar[XB_XCNT(j)]); sum += c; cnt += (c > 0u) ? 1u : 0u; mine = (j == x) ? c : mine; }
        if (sum == G) break;
        __builtin_amdgcn_s_sleep(1);
        if ((++sp & 255u) == 0u) { if (xb_ld(&bar[XB_TMO])) break; if (sp > XB_SPIN_CAP) { atomicAdd(&bar[XB_TMO], 1u); break; } }
    }
    nloc = mine > 0u ? mine : 1u; nx = cnt > 0u ? cnt : 1u;
}

__device__ __forceinline__ void xcd_barrier(const XcdBarrier& b) {
    asm volatile("s_waitcnt vmcnt(0)" ::: "memory");
    __syncthreads();
    if (threadIdx.x == 0) {
        unsigned* bar = b.bar;
        __builtin_amdgcn_s_waitcnt(0);
        unsigned nloc = b.st[0], nx = b.st[1];
        if (nloc == 0u) { xcd_barrier_complete(bar, b.x, nloc, nx); b.st[0] = nloc; b.st[1] = nx; }
        const unsigned old = xb_add(&bar[XB_XSUB(b.x)], 1u);
        const unsigned gen = old / nloc;
        if (old + 1u == (gen + 1u) * nloc) {
            __builtin_amdgcn_fence(__ATOMIC_RELEASE, "agent");
            asm volatile("s_waitcnt vmcnt(0)" ::: "memory");
            const unsigned og = xb_add(&bar[XB_TOP], 1u);
            const unsigned tg = og / nx;
            if (og + 1u == (tg + 1u) * nx) xb_add(&bar[XB_TOPGEN], 1u);
            else XB_SPIN(xb_ld(&bar[XB_TOPGEN]) == tg, bar);
            __builtin_amdgcn_fence(__ATOMIC_ACQUIRE, "agent");
            xb_add(&bar[XB_XGEN(b.x)], 1u);
            asm volatile("s_waitcnt vmcnt(0)" ::: "memory");
        } else {
            XB_SPIN(xb_ld(&bar[XB_XGEN(b.x)]) == gen, bar);
            __builtin_amdgcn_fence(__ATOMIC_ACQUIRE, "agent");
            asm volatile("s_waitcnt vmcnt(0)" ::: "memory");
        }
    }
    __syncthreads();
}

__global__ void __launch_bounds__(512, 2) fwd_kernel(Params p) {
    extern __shared__ __attribute__((aligned(16))) unsigned char lds_raw[];
    LAS unsigned char* lds = (LAS unsigned char*)lds_raw;
    cg::grid_group grid = cg::this_grid();
    const int tid = threadIdx.x, lane = tid & 63, wave = __builtin_amdgcn_readfirstlane(tid >> 6);
    const int G = gridDim.x, gw = blockIdx.x * 8 + wave, NGW = G * 8;
    unsigned char* ws = p.ws;
    const int lo = p.ph_lo, hi = p.ph_hi;
#define IN(k) (lo <= (k) && (k) < hi)
#ifndef COOP_SEAM
#define COOP_SEAM 0
#endif
    volatile LAS unsigned* bst = (volatile LAS unsigned*)(lds + LDS_BYTES - 64);
    if (tid == 0) { bst[0] = 0u; bst[1] = 0u; }
    __syncthreads();
    XcdBarrier bar = xcd_barrier_post((unsigned*)(ws + WS_CTL), bst);
#define SEAM(k) do { if (IN(k) && IN((k) + 1)) { if ((k) == COOP_SEAM) grid.sync(); else xcd_barrier(bar); } } while (0)

    for (int rep_ = 0; rep_ < (DUP_PHASE == 0 ? 2 : 1); ++rep_) if (IN(0)) { phase0(p, lds, gw, NGW, lane, wave); } SEAM(0);

    for (int rep_ = 0; rep_ < (DUP_PHASE == 1 ? 2 : 1); ++rep_) if (IN(1)) {
        pg8::Gemm g{(const bf16_t*)(ws + WS_HN), (const bf16_t*)(ws + WS_WIN), TOK, NCP, DM, DM}; pg8::StaticOrder S; S.init(TOK, NCP, G, (int)blockIdx.x);
        pg8::EpiBf16<0> E{(bf16_t*)(ws + WS_PROJ), NCP, nullptr, 0, 0, 1.f};
        pg8::gemm_phase<pg8::EpiBf16<0>, pg8::StaticOrder, PG8_ALIGN, PG8_SP2>(lds, g, S, E);
    } SEAM(1);

    for (int rep_ = 0; rep_ < (DUP_PHASE == 2 ? 2 : 1); ++rep_) if (IN(2)) { for (int m = gw; m < TOK; m += NGW) e1_row(p, m, lane, DUP_PHASE == 2 && rep_ == 0); } SEAM(2);

    for (int rep_ = 0; rep_ < (DUP_PHASE == 3 ? 2 : 1); ++rep_) if (IN(3)) {
        { pg8::Gemm g{(const bf16_t*)(ws + WS_PROJ) + C_CQ, (const bf16_t*)(ws + WS_WUQ), TOK, QA_W, 768, NCP}; pg8::StaticOrder S; S.init(TOK, QA_W, G, (int)blockIdx.x);
          pg8::EpiBf16<0> E{(bf16_t*)(ws + WS_QA), QA_W, nullptr, 0, 0, 1.f};
          pg8::gemm_phase<pg8::EpiBf16<0>, pg8::StaticOrder, PG8_ALIGN, PG8_SP2>(lds, g, S, E); }
        __syncthreads();
        { pg8::Gemm g{(const bf16_t*)(ws + WS_PROJ) + C_CKV, (const bf16_t*)(ws + WS_WUKV), TOK, KVA_W, 512, NCP}; pg8::StaticOrder S; S.init(TOK, KVA_W, G, (int)blockIdx.x);
          pg8::EpiBf16<0> E{(bf16_t*)(ws + WS_KVA), KVA_W, nullptr, 0, 0, 1.f};
          pg8::gemm_phase<pg8::EpiBf16<0>, pg8::StaticOrder, PG8_ALIGN, PG8_SP2>(lds, g, S, E); }
    } SEAM(3);

    for (int rep_ = 0; rep_ < (DUP_PHASE == 4 ? 2 : 1); ++rep_) if (IN(4)) { for (int m = gw; m < TOK; m += NGW) e2_row(p, m, lane, DUP_PHASE == 4 && rep_ == 0); } SEAM(4);

    for (int rep_ = 0; rep_ < (DUP_PHASE == 5 ? 2 : 1); ++rep_) if (IN(5)) {
        if (!FAST_MLA) phase5_naive(p, lds, gw, NGW, lane, wave, 0, 1);
        if (!FAST_DIL) phase5_naive(p, lds, gw, NGW, lane, wave, 1, 4);
        if (FAST_MLA || FAST_DIL) { __syncthreads(); phase5_fast(p, lds); }
    } SEAM(5);

    for (int rep_ = 0; rep_ < (DUP_PHASE == 6 ? 2 : 1); ++rep_) if (IN(6)) { for (int m = gw; m < TOK; m += NGW) e3_row(p, m, lane); } SEAM(6);

    for (int rep_ = 0; rep_ < (DUP_PHASE == 7 ? 2 : 1); ++rep_) if (IN(7)) {
        pg8::Gemm g{(const bf16_t*)(ws + WS_Y), (const bf16_t*)(ws + WS_WOUT), TOK, DM, DM, DM}; pg8::StaticOrder S; S.init(TOK, DM, G, (int)blockIdx.x);
        pg8::EpiResF32 E{p.in[0], p.out, DM};
        pg8::gemm_phase<pg8::EpiResF32, pg8::StaticOrder, PG8_ALIGN, PG8_SP2>(lds, g, S, E);
    }
#if defined(EXTRA_SYNCS)
    if (hi - lo > 1) for (int i = 0; i < EXTRA_SYNCS; ++i) grid.sync();
#endif
#undef IN
#undef SEAM
}

extern "C" void kernel_launch(void* const* d_in, const int* in_sizes, int n_in, void* d_out, int out_size, void* d_ws, size_t ws_size, hipStream_t stream) {
    static int grid = 0;
    if (grid == 0) {
        if (n_in != 14 || in_sizes[0] != TOK * DM || out_size != TOK * DM || ws_size < WS_END) {
            fprintf(stderr, "kernel_launch: unexpected shapes: n_in %d in0 %d out %d ws %zu (need %zu)\n", n_in, n_in > 0 ? in_sizes[0] : -1, out_size, ws_size, (size_t)WS_END); grid = -1; return; }
        int dev = 0, cus = 0, per_cu = 0;
        if (hipGetDevice(&dev) != hipSuccess || hipDeviceGetAttribute(&cus, hipDeviceAttributeMultiprocessorCount, dev) != hipSuccess) { fprintf(stderr, "kernel_launch: device query failed\n"); grid = -1; return; }
        if (hipFuncSetAttribute((const void*)fwd_kernel, hipFuncAttributeMaxDynamicSharedMemorySize, LDS_BYTES) != hipSuccess) { fprintf(stderr, "kernel_launch: hipFuncSetAttribute failed\n"); grid = -1; return; }
        if (hipOccupancyMaxActiveBlocksPerMultiprocessor(&per_cu, (const void*)fwd_kernel, 512, LDS_BYTES) != hipSuccess || per_cu < 1) { fprintf(stderr, "kernel_launch: occupancy query says %d blocks per CU\n", per_cu); (void)hipGetLastError(); grid = -1; return; }
        grid = cus * 1;
        fprintf(stderr, "kernel_launch: cus %d per_cu %d grid %d\n", cus, per_cu, grid);
    }
    if (grid < 0) return;
    if (hipMemsetAsync((char*)d_ws + WS_CTL, 0, CTL_BYTES, stream) != hipSuccess) { fprintf(stderr, "kernel_launch: memset of the barrier words failed\n"); return; }
    Params p{};
    for (int i = 0; i < 14; ++i) p.in[i] = (const float*)d_in[i];
    p.out = (float*)d_out; p.ws = (unsigned char*)d_ws;
#if MK_N_LAUNCHES == 1
    p.ph_lo = 0; p.ph_hi = NPH;
    void* args[] = {&p};
    const hipError_t e = hipLaunchCooperativeKernel((const void*)fwd_kernel, dim3(grid), dim3(512), args, LDS_BYTES, stream);
    if (e != hipSuccess) fprintf(stderr, "kernel_launch: cooperative launch failed: %s (grid %d)\n", hipGetErrorString(e), grid);
#else
    for (int ph = 0; ph < NPH; ++ph) {
        p.ph_lo = ph; p.ph_hi = ph + 1;
        hipLaunchKernelGGL(fwd_kernel, dim3(grid), dim3(512), LDS_BYTES, stream, p);
        const hipError_t e = hipPeekAtLastError();
        if (e != hipSuccess) { fprintf(stderr, "kernel_launch: launch %d failed: %s\n", ph, hipGetErrorName(e)); break; }
    }
#endif
}
```

```cpp
#include <hip/hip_runtime.h>
#include <hip/hip_cooperative_groups.h>
#include <cstdio>
#include <cstdint>
namespace cg = cooperative_groups;
namespace pg8 {
#define PG8_LAS __attribute__((address_space(3)))
typedef unsigned short bf16_t;
typedef short bf16x8 __attribute__((ext_vector_type(8)));
typedef float f32x4 __attribute__((ext_vector_type(4)));
typedef unsigned u32x4 __attribute__((ext_vector_type(4)));
constexpr int BM = 256, BK = 64, HALF = 128, HTB = HALF * BK * 2  , STAGE_BYTES = 8 * HTB, NXCD = 8, WGM = 8;

__host__ __device__ __forceinline__ int lds_byte(int r, int c) { const int st = (r >> 4) * 2 + (c >> 5), rr = r & 15, cc = c & 31, ob = rr * 64 + cc * 2; return st * 1024 + (ob ^ (((ob >> 9) & 1) << 5)); }
__host__ __device__ __forceinline__ void stage_rc(int b, int& R, int& C) { const int st = b / 1024, sb = b % 1024, swz = sb ^ (((sb >> 9) & 1) << 5); R = (st >> 1) * 16 + swz / 64; C = (st & 1) * 32 + (swz % 64) / 2; }
__host__ __device__ __forceinline__ int perm32(int rho) { const int n = rho >> 4, i = rho & 15; return 8 * (i >> 2) + 4 * n + (i & 3); }

struct Unit { int pm, pn; };
struct Gemm { const bf16_t* A; const bf16_t* Bt; int M, N, K, lda; };

struct StaticOrder {
    int nM, nN, nwg, G, c;
    __host__ __device__ void init(int M, int N, int G_, int c_) { nM = M / BM; nN = N / BM; nwg = nM * nN; G = G_; c = c_; }
    __host__ __device__ bool next(int i, Unit& u) const {
        const long L = (long)i * G + c; if (L >= nwg) return false;
        int wgid = (int)L; { const int q = nwg / NXCD, r = nwg % NXCD, xcd = wgid % NXCD, off = wgid / NXCD; wgid = (xcd < r ? xcd * (q + 1) : r * (q + 1) + (xcd - r) * q) + off; }
        const int nig = WGM * nN, gid = wgid / nig, fm = gid * WGM, gsz = (nM - fm) < WGM ? (nM - fm) : WGM;
        u.pm = fm + ((wgid % nig) % gsz); u.pn = (wgid % nig) / gsz; return true;
    }
    __device__ __forceinline__ void a_ready(const Unit&) const {}
    __device__ __forceinline__ void done(const Unit&) const {}
};

__device__ __forceinline__ unsigned cvt_pk_bf16(float lo, float hi) { unsigned r; asm volatile("v_cvt_pk_bf16_f32 %0, %1, %2" : "=v"(r) : "v"(lo), "v"(hi)); return r; }
typedef float f32x2 __attribute__((ext_vector_type(2)));
__device__ __forceinline__ f32x2 gelu_pk(f32x2 v) {
    const f32x2 av = __builtin_elementwise_abs(v), d = av * 0.2316418882f + 1.0f;
    f32x2 t; t.x = __builtin_amdgcn_rcpf(d.x); t.y = __builtin_amdgcn_rcpf(d.y);
    f32x2 q = t * 0.5307027145f + (-0.7265760135f); q = q * t + 0.7107068705f; q = q * t + (-0.142248368f); q = q * t + 0.127414796f; q = q * t;
    const f32x2 s = (v * v) * (-0.72134752044f);
    f32x2 e; e.x = __builtin_amdgcn_exp2f(s.x); e.y = __builtin_amdgcn_exp2f(s.y);
    const f32x2 m = v * (q * e), r = v - m;
    f32x2 o; o.x = v.x < 0.f ? m.x : r.x; o.y = v.y < 0.f ? m.y : r.y; return o;
}

template <int ACT  > struct EpiBf16 {
    static constexpr bool PERM = true, AFTER_DRAIN = false; static_assert(ACT == 0 || ACT == 1, "EpiBf16: ACT is 0 (none) or 1 (gelu_pk)");
    bf16_t* O; int ldc; const float* bias; int split_cols; size_t split_stride; float scale0;
    __device__ __forceinline__ void operator()(const f32x4 (&acc)[2][2][4][2], const Unit& u, int wr, int wc, int fr, int fq) const {
        const int row0 = u.pm * BM + wr * 64 + fr; int colt = u.pn * BM; bf16_t* base = O;
        float sc = 1.f; if (split_cols) { const int t = colt / split_cols; base += (size_t)t * split_stride; colt -= t * split_cols; if (t == 0) sc = scale0; }
        const int col0 = colt + wc * 32 + 8 * fq, bcol0 = u.pn * BM + wc * 32 + 8 * fq;
        f32x4 bv[2][2];
#pragma unroll
        for (int bj = 0; bj < 2; ++bj)
#pragma unroll
            for (int n = 0; n < 2; ++n) bv[bj][n] = bias ? *(const f32x4*)(bias + bcol0 + bj * HALF + 4 * n) : (f32x4){0.f, 0.f, 0.f, 0.f};
#pragma unroll
        for (int ai = 0; ai < 2; ++ai)
#pragma unroll
            for (int m = 0; m < 4; ++m) { bf16_t* rowp = base + (size_t)(row0 + ai * HALF + m * 16) * ldc + col0;
#pragma unroll
                for (int bj = 0; bj < 2; ++bj) { f32x4 v0 = acc[ai][bj][m][0] + bv[bj][0], v1 = acc[ai][bj][m][1] + bv[bj][1];
                    if (ACT == 1) { f32x2 a = gelu_pk((f32x2){v0[0], v0[1]}), b = gelu_pk((f32x2){v0[2], v0[3]}), c = gelu_pk((f32x2){v1[0], v1[1]}), d = gelu_pk((f32x2){v1[2], v1[3]});
                        v0 = (f32x4){a.x, a.y, b.x, b.y}; v1 = (f32x4){c.x, c.y, d.x, d.y}; }
                    v0 = v0 * sc; v1 = v1 * sc; u32x4 w; w.x = cvt_pk_bf16(v0[0], v0[1]); w.y = cvt_pk_bf16(v0[2], v0[3]); w.z = cvt_pk_bf16(v1[0], v1[1]); w.w = cvt_pk_bf16(v1[2], v1[3]);
                    *(u32x4*)(rowp + bj * HALF) = w; } }
    }
};

struct EpiResF32 {
    static constexpr bool PERM = true, AFTER_DRAIN = false;
    const float* base; float* out; int ldc;
    __device__ __forceinline__ void operator()(const f32x4 (&acc)[2][2][4][2], const Unit& u, int wr, int wc, int fr, int fq) const {
        const int row0 = u.pm * BM + wr * 64 + fr, col0 = u.pn * BM + wc * 32 + 8 * fq;
#pragma unroll
        for (int ai = 0; ai < 2; ++ai) {
            f32x4 pre[4][2][2];
#pragma unroll
            for (int m = 0; m < 4; ++m) { const size_t off = (size_t)(row0 + ai * HALF + m * 16) * ldc + col0;
#pragma unroll
                for (int bj = 0; bj < 2; ++bj) { pre[m][bj][0] = __builtin_nontemporal_load((const f32x4*)(base + off + bj * HALF)); pre[m][bj][1] = __builtin_nontemporal_load((const f32x4*)(base + off + bj * HALF + 4)); } }
#pragma unroll
            for (int m = 0; m < 4; ++m) { const size_t off = (size_t)(row0 + ai * HALF + m * 16) * ldc + col0;
#pragma unroll
                for (int bj = 0; bj < 2; ++bj) { __builtin_nontemporal_store(acc[ai][bj][m][0] + pre[m][bj][0], (f32x4*)(out + off + bj * HALF)); __builtin_nontemporal_store(acc[ai][bj][m][1] + pre[m][bj][1], (f32x4*)(out + off + bj * HALF + 4)); } }
        }
    }
};
template <class Epi, class Sched, bool ALIGN_EPI = false, bool SP2 = false>
__device__ __forceinline__ void gemm_phase(PG8_LAS unsigned char* lds, const Gemm g, const Sched& S, const Epi& E) {
    int tid = threadIdx.x; asm volatile("" : "+v"(tid));
    const int wid = __builtin_amdgcn_readfirstlane(tid >> 6), lane = tid & 63, wr = wid >> 2, wc = wid & 3, fr = lane & 15, fq = lane >> 4;
    const int K = g.K, nt = K / BK;
    unsigned voffA[2], voffB[2];
#pragma unroll
    for (int i = 0; i < 2; ++i) { int R, C; stage_rc(tid * 16 + i * 8192, R, C); const int Rb = Epi::PERM ? ((R & ~31) + perm32(R & 31)) : R;
        voffA[i] = (unsigned)(R * g.lda + C) * 2u; voffB[i] = (unsigned)(Rb * K + C) * 2u; }
    const size_t kstep = (size_t)(BK * 2);
    const size_t hstepA = (size_t)HALF * g.lda * 2, hstepB = (size_t)HALF * K * 2;
    const size_t tstepA = 2 * hstepA, tstepB = 2 * hstepB;
    const unsigned ldsw = (unsigned)wid * 1024u;
    const int aoff = lds_byte(wr * 64 + fr, fq * 8), boff = lds_byte(wc * 32 + fr, fq * 8);
#define PG8_SA(b, h) (((b) * 2 + (h)) * HTB)
#define PG8_SB(b, h) ((4 + (b) * 2 + (h)) * HTB)
#define PG8_STAGE(bufoff, gbase, voff) do { _Pragma("unroll") for (int _i = 0; _i < 2; ++_i) \
        __builtin_amdgcn_global_load_lds((const unsigned*)((const char*)(gbase) + (voff)[_i]), (PG8_LAS unsigned*)(lds + (bufoff) + ldsw + _i * 8192), 16, 0, 0); } while (0)
#define PG8_LDA(dst, b, h) do { _Pragma("unroll") for (int m = 0; m < 4; ++m) _Pragma("unroll") for (int k = 0; k < 2; ++k) dst[m][k] = *(const PG8_LAS bf16x8*)(lds + PG8_SA(b, h) + aoff + m * 2048 + k * 1024); } while (0)
#define PG8_LDB(dst, b, h) do { _Pragma("unroll") for (int n = 0; n < 2; ++n) _Pragma("unroll") for (int k = 0; k < 2; ++k) dst[n][k] = *(const PG8_LAS bf16x8*)(lds + PG8_SB(b, h) + boff + n * 2048 + k * 1024); } while (0)
#define PG8_MMA(ai, bj, At, Bt) do { __builtin_amdgcn_s_setprio(1); _Pragma("unroll") for (int m = 0; m < 4; ++m) _Pragma("unroll") for (int n = 0; n < 2; ++n) _Pragma("unroll") for (int k = 0; k < 2; ++k) \
        acc[ai][bj][m][n] = __builtin_amdgcn_mfma_f32_16x16x32_bf16(Bt[n][k], At[m][k], acc[ai][bj][m][n], 0, 0, 0); __builtin_amdgcn_s_setprio(0); } while (0)
#define PG8_WAIT_V(n) asm volatile("s_waitcnt vmcnt(" #n ")" ::: "memory")
#define PG8_WAIT_L(n) asm volatile("s_waitcnt lgkmcnt(" #n ")" ::: "memory")
#define PG8_BAR __builtin_amdgcn_s_barrier()
#define PG8_SCHED __builtin_amdgcn_sched_barrier(0)
    Unit cur, nxt; int ui = 0;
    if (!S.next(0, cur)) return;
    f32x4 acc[2][2][4][2];
#pragma unroll
    for (int a = 0; a < 2; ++a)
#pragma unroll
        for (int b = 0; b < 2; ++b)
#pragma unroll
            for (int m = 0; m < 4; ++m)
#pragma unroll
                for (int n = 0; n < 2; ++n) acc[a][b][m][n] = (f32x4){0.f, 0.f, 0.f, 0.f};
    bf16x8 At[4][2], B0[2][2], B1[2][2];
    const char* cA = (const char*)g.A + (size_t)cur.pm * tstepA; const char* cB = (const char*)g.Bt + (size_t)cur.pn * tstepB;
    S.a_ready(cur);
    if constexpr (SP2) {
        PG8_STAGE(PG8_SB(0, 0), cB, voffB); PG8_STAGE(PG8_SB(0, 1), cB + hstepB, voffB); PG8_STAGE(PG8_SA(0, 0), cA, voffA); PG8_STAGE(PG8_SA(0, 1), cA + hstepA, voffA);
        if (wr == 1) PG8_BAR;
        PG8_WAIT_V(2); PG8_BAR;
        PG8_STAGE(PG8_SB(1, 0), cB + kstep, voffB); PG8_STAGE(PG8_SA(1, 0), cA + kstep, voffA); PG8_STAGE(PG8_SB(1, 1), cB + hstepB + kstep, voffB);
        PG8_WAIT_V(6); PG8_BAR;
    } else {
        PG8_STAGE(PG8_SB(0, 0), cB, voffB); PG8_STAGE(PG8_SA(0, 0), cA, voffA); PG8_STAGE(PG8_SB(0, 1), cB + hstepB, voffB); PG8_STAGE(PG8_SA(0, 1), cA + hstepA, voffA);
        if (wr == 1) PG8_BAR;
        PG8_WAIT_V(4); PG8_BAR;
        PG8_STAGE(PG8_SB(1, 0), cB + kstep, voffB); PG8_STAGE(PG8_SA(1, 0), cA + kstep, voffA); PG8_STAGE(PG8_SB(1, 1), cB + hstepB + kstep, voffB);
        PG8_WAIT_V(6); PG8_BAR;
    }
    for (;;) {
        const bool has_next = S.next(ui + 1, nxt);
        const char* nA = has_next ? (const char*)g.A + (size_t)nxt.pm * tstepA : cA; const char* nB = has_next ? (const char*)g.Bt + (size_t)nxt.pn * tstepB : cB;
        for (int t = 0; t < nt; t += 2) {
            const bool last = (t == nt - 2);
            const char* a1 = cA + (size_t)(t + 1) * kstep;
            const char* a2 = last ? nA : cA + (size_t)(t + 2) * kstep; const char* b2 = last ? nB : cB + (size_t)(t + 2) * kstep;
            const char* a3 = a2 + kstep; const char* b3 = b2 + kstep;
            if (last && has_next) S.a_ready(nxt);
            if constexpr (SP2) {
            PG8_LDB(B0, 0, 0); PG8_LDB(B1, 0, 1); PG8_SCHED; PG8_LDA(At, 0, 0); PG8_STAGE(PG8_SA(1, 1), a1 + hstepA, voffA);
            PG8_WAIT_V(8); PG8_WAIT_L(0); PG8_BAR; PG8_MMA(0, 0, At, B0); PG8_MMA(0, 1, At, B1); PG8_BAR; PG8_SCHED;
            PG8_LDA(At, 0, 1); PG8_STAGE(PG8_SB(0, 0), b2, voffB); PG8_STAGE(PG8_SB(0, 1), b2 + hstepB, voffB); PG8_STAGE(PG8_SA(0, 0), a2, voffA);
            PG8_WAIT_V(8); PG8_WAIT_L(0); PG8_BAR; PG8_MMA(1, 0, At, B0); PG8_MMA(1, 1, At, B1); PG8_BAR; PG8_SCHED;
            PG8_LDB(B0, 1, 0); PG8_LDB(B1, 1, 1); PG8_SCHED; PG8_LDA(At, 1, 0); PG8_STAGE(PG8_SA(0, 1), a2 + hstepA, voffA);
            PG8_WAIT_V(8); PG8_WAIT_L(0); PG8_BAR; PG8_MMA(0, 0, At, B0); PG8_MMA(0, 1, At, B1); PG8_BAR; PG8_SCHED;
            PG8_LDA(At, 1, 1); PG8_STAGE(PG8_SB(1, 0), b3, voffB); PG8_STAGE(PG8_SB(1, 1), b3 + hstepB, voffB); PG8_STAGE(PG8_SA(1, 0), a3, voffA);
            PG8_WAIT_V(8); PG8_WAIT_L(0); PG8_BAR; PG8_MMA(1, 0, At, B0); PG8_MMA(1, 1, At, B1); PG8_BAR; PG8_SCHED;
            } else {
            PG8_LDB(B0, 0, 0); PG8_SCHED; PG8_LDA(At, 0, 0); PG8_STAGE(PG8_SA(1, 1), a1 + hstepA, voffA);
            PG8_WAIT_L(8); PG8_BAR; PG8_WAIT_L(0); PG8_MMA(0, 0, At, B0); PG8_BAR; PG8_SCHED;
            PG8_LDB(B1, 0, 1); PG8_STAGE(PG8_SB(0, 0), b2, voffB);
            PG8_BAR; PG8_WAIT_L(0); PG8_MMA(0, 1, At, B1); PG8_BAR;
            PG8_LDA(At, 0, 1); PG8_STAGE(PG8_SA(0, 0), a2, voffA);
            PG8_BAR; PG8_WAIT_L(0); PG8_MMA(1, 0, At, B0); PG8_BAR; PG8_SCHED;
            PG8_STAGE(PG8_SB(0, 1), b2 + hstepB, voffB);
            PG8_WAIT_V(6); PG8_BAR; PG8_MMA(1, 1, At, B1); PG8_BAR;
            PG8_LDB(B0, 1, 0); PG8_SCHED; PG8_LDA(At, 1, 0); PG8_STAGE(PG8_SA(0, 1), a2 + hstepA, voffA);
            PG8_WAIT_L(8); PG8_BAR; PG8_WAIT_L(0); PG8_MMA(0, 0, At, B0); PG8_BAR; PG8_SCHED;
            PG8_LDB(B1, 1, 1); PG8_STAGE(PG8_SB(1, 0), b3, voffB);
            PG8_BAR; PG8_WAIT_L(0); PG8_MMA(0, 1, At, B1); PG8_BAR;
            PG8_LDA(At, 1, 1); PG8_STAGE(PG8_SA(1, 0), a3, voffA);
            PG8_BAR; PG8_WAIT_L(0); PG8_MMA(1, 0, At, B0); PG8_BAR; PG8_SCHED;
            PG8_STAGE(PG8_SB(1, 1), b3 + hstepB, voffB);
            PG8_WAIT_V(6); PG8_BAR; PG8_MMA(1, 1, At, B1); PG8_BAR;
            }
        }
        if constexpr (ALIGN_EPI) { if (wr == 0) PG8_BAR; }
        if constexpr (!Epi::AFTER_DRAIN) { E(acc, cur, wr, wc, fr, fq); S.done(cur); }
        if (!has_next) break;
#pragma unroll
        for (int a = 0; a < 2; ++a)
#pragma unroll
            for (int b = 0; b < 2; ++b)
#pragma unroll
                for (int m = 0; m < 4; ++m)
#pragma unroll
                    for (int n = 0; n < 2; ++n) acc[a][b][m][n] = (f32x4){0.f, 0.f, 0.f, 0.f};
        cur = nxt; cA = nA; cB = nB; ++ui;
        if constexpr (ALIGN_EPI) { if (wr == 1) PG8_BAR; }
    }
    PG8_WAIT_V(0);
    if constexpr (!ALIGN_EPI) { if (wr == 0) PG8_BAR; }
    PG8_BAR;
    if constexpr (Epi::AFTER_DRAIN) { E.fused(acc, cur, wr, wc, fr, fq, lds, wid, lane); S.done(cur); }
#undef PG8_SA
#undef PG8_SB
#undef PG8_STAGE
#undef PG8_LDA
#undef PG8_LDB
#undef PG8_MMA
#undef PG8_WAIT_V
#undef PG8_WAIT_L
#undef PG8_BAR
#undef PG8_SCHED
}
}
#ifndef PG8_SP2
#define PG8_SP2 true
#endif
#ifndef PG8_ALIGN
#define PG8_ALIGN true
#endif
#ifndef MK_N_LAUNCHES
#define MK_N_LAUNCHES 1
#endif
#ifndef PROBE_PHASE
#define PROBE_PHASE -1
#endif
#ifndef DUP_PHASE
#define DUP_PHASE -1
#endif
#ifndef FAST_MLA
#define FAST_MLA 1
#endif
#ifndef FAST_DIL
#define FAST_DIL 1
#endif

constexpr int NBATCH = 4, SEQ = 4096, DM = 2048, TOK = NBATCH * SEQ;
constexpr int NC = 6464, NCP = 6656;
constexpr int C_CQ = 0, C_CKV = 768, C_QB = 1280, C_KB = 2304, C_VB = 3328, C_GA = 4352, C_GB = 5376, C_KR = 6400;
constexpr int QA_W = 1536, KVA_W = 2048;
constexpr float EPS = 1e-6f;
constexpr float LOG2E = 1.4426950408889634f, LN2 = 0.6931471805599453f;
constexpr float QSCALE_MLA = 0.07216878364870322f * LOG2E;
constexpr float QSCALE_DIL = 0.08838834764831845f * LOG2E;
constexpr int NPH = 8;

constexpr size_t MiB = 1u << 20;
constexpr size_t WS_GAINS = 3 * MiB + 196608;
constexpr size_t WS_SSQ = 3 * MiB + 65536;
constexpr size_t WS_TAB128 = 0, WS_TAB64 = 2 * MiB, WS_CTL = 3 * MiB, CTL_BYTES = 16384;
constexpr size_t WS_WIN = 4 * MiB, WS_WUQ = 30 * MiB, WS_WUKV = 33 * MiB, WS_WOUT = 35 * MiB;
constexpr size_t WS_PROJ = 44 * MiB;
constexpr size_t WS_HN = 252 * MiB;
constexpr size_t WS_OA = 252 * MiB, WS_OD1 = 284 * MiB;
constexpr size_t WS_QA = 316 * MiB;
constexpr size_t WS_KVA = 364 * MiB;
constexpr size_t WS_OD2 = 428 * MiB, WS_OD3 = 460 * MiB;
constexpr size_t WS_LSE = 492 * MiB;
constexpr size_t WS_Y = 316 * MiB;
constexpr size_t WS_END = 494 * MiB;
constexpr int LDS_BYTES = 143360, XCH_OFF = 131072;

#define LAS __attribute__((address_space(3)))
#define DI __device__ __forceinline__
typedef unsigned short bf16_t;
typedef unsigned u32x4 __attribute__((ext_vector_type(4)));
typedef unsigned u32x2 __attribute__((ext_vector_type(2)));
typedef float f32x4 __attribute__((ext_vector_type(4)));
typedef float f32x2 __attribute__((ext_vector_type(2)));

struct Params { const float* in[14]; float* out; unsigned char* ws; int ph_lo, ph_hi; };

DI float bflo(unsigned w) { return __uint_as_float(w << 16); }
DI float bfhi(unsigned w) { return __uint_as_float(w & 0xffff0000u); }
DI unsigned pk2(float lo, float hi) { return pg8::cvt_pk_bf16(lo, hi); }
DI void unpack8(const u32x4 v, f32x4& a, f32x4& b) { a = (f32x4){bflo(v.x), bfhi(v.x), bflo(v.y), bfhi(v.y)}; b = (f32x4){bflo(v.z), bfhi(v.z), bflo(v.w), bfhi(v.w)}; }
DI u32x4 pack8(const f32x4 a, const f32x4 b) { u32x4 r; r.x = pk2(a.x, a.y); r.y = pk2(a.z, a.w); r.z = pk2(b.x, b.y); r.w = pk2(b.z, b.w); return r; }
DI float sumsq8(const f32x4 a, const f32x4 b) { return (a.x * a.x + a.y * a.y) + (a.z * a.z + a.w * a.w) + (b.x * b.x + b.y * b.y) + (b.z * b.z + b.w * b.w); }
DI float wave_sum(float v) {
#pragma unroll
    for (int o = 1; o < 64; o <<= 1) v += __shfl_xor(v, o);
    return v; }
DI float wave_max(float v) {
#pragma unroll
    for (int o = 1; o < 64; o <<= 1) v = fmaxf(v, __shfl_xor(v, o));
    return v; }
DI float grp_sum8(float v) { v += __shfl_xor(v, 1); v += __shfl_xor(v, 2); v += __shfl_xor(v, 4); return v; }
DI float grp_sum16(float v) { v = grp_sum8(v); v += __shfl_xor(v, 8); return v; }
DI float rstd_of(float ss, float inv_n) { return 1.0f / sqrtf(ss * inv_n + EPS); }
DI float silu(float x) { return x / (1.0f + __expf(-x)); }
DI f32x4 silu4(f32x4 x) { return (f32x4){silu(x.x), silu(x.y), silu(x.z), silu(x.w)}; }
DI void rope8(f32x4& a, f32x4& b, int xr, bool first, const f32x4* tab) {
    f32x4 pa, pb;
    pa.x = __shfl_xor(a.x, xr); pa.y = __shfl_xor(a.y, xr); pa.z = __shfl_xor(a.z, xr); pa.w = __shfl_xor(a.w, xr);
    pb.x = __shfl_xor(b.x, xr); pb.y = __shfl_xor(b.y, xr); pb.z = __shfl_xor(b.z, xr); pb.w = __shfl_xor(b.w, xr);
    const float sg = first ? -1.f : 1.f;
    const f32x4 t0 = tab[0], t1 = tab[1], t2 = tab[2], t3 = tab[3];
    a.x = a.x * t0.x + sg * pa.x * t0.y; a.y = a.y * t0.z + sg * pa.y * t0.w; a.z = a.z * t1.x + sg * pa.z * t1.y; a.w = a.w * t1.z + sg * pa.w * t1.w;
    b.x = b.x * t2.x + sg * pb.x * t2.y; b.y = b.y * t2.z + sg * pb.y * t2.w; b.z = b.z * t3.x + sg * pb.z * t3.y; b.w = b.w * t3.z + sg * pb.w * t3.w;
}

namespace pg8 {
struct EpiProj {
    static constexpr bool PERM = true, AFTER_DRAIN = false;
    bf16_t* O; float* ssq; const float* gains; const f32x4* tab; LAS float* xch;
    __device__ __forceinline__ void operator()(const f32x4 (&acc)[2][2][4][2], const Unit& u, int wr, int wc, int fr, int fq) const {
        const int pn = u.pn, row0 = u.pm * BM + wr * 64 + fr, col0 = pn * BM + wc * 32 + 8 * fq;
        const bool kr = pn == 25;
        if ((pn >= 5 && pn < 13) || kr) {
#pragma unroll
            for (int ai = 0; ai < 2; ++ai)
#pragma unroll
                for (int m = 0; m < 4; ++m)
#pragma unroll
                    for (int bj = 0; bj < 2; ++bj) {
                        const f32x4 a = acc[ai][bj][m][0], c = acc[ai][bj][m][1];
                        float s = (a.x * a.x + a.y * a.y) + (a.z * a.z + a.w * a.w) + (c.x * c.x + c.y * c.y) + (c.z * c.z + c.w * c.w);
                        s += __shfl_xor(s, 16); s += __shfl_xor(s, 32);
                        if (fq == 0) xch[((ai * HALF + wr * 64 + m * 16 + fr) * 2 + bj) * 4 + wc] = s;
                    }
            asm volatile("s_waitcnt lgkmcnt(0)" ::: "memory"); __builtin_amdgcn_s_barrier(); asm volatile("" ::: "memory");
            const int lg = kr ? 4 * (wc & 1) + fq : 4 * wc + fq;
            const int goff = kr ? 256 : (pn < 9 ? 0 : 128);
            const f32x4 g0 = *(const f32x4*)(gains + goff + 4 * lg), g1 = *(const f32x4*)(gains + goff + (kr ? 32 : 64) + 4 * lg);
            const float scale = (pn < 9) ? QSCALE_DIL : 1.0f, inv_n = kr ? (1.0f / 64.0f) : (1.0f / 128.0f);
            if (!kr || wc < 2) {
#pragma unroll
            for (int ai = 0; ai < 2; ++ai)
#pragma unroll
                for (int m = 0; m < 4; ++m) {
                    const int row = row0 + ai * HALF + m * 16, t = row & (SEQ - 1);
                    const int ti = kr ? (int)(WS_TAB64 / 16) + (t * 32 + 4 * lg) / 2 : (t * 64 + 4 * lg) / 2;
                    const f32x4 tA = tab[ti], tB = tab[ti + 1];
#pragma unroll
                    for (int bj = 0; bj < 2; ++bj) {
                        if (kr && bj == 1) continue;
                        const f32x4 ps = *(const LAS f32x4*)(xch + ((ai * HALF + wr * 64 + m * 16 + fr) * 2 + bj) * 4);
                        const float tot = kr ? ps.x + ps.y : (ps.x + ps.y) + (ps.z + ps.w);
                        const float rstd = 1.0f / sqrtf(tot * inv_n + EPS);
                        const f32x4 x1 = acc[ai][bj][m][0] * rstd * g0, x2 = acc[ai][bj][m][1] * rstd * g1;
                        f32x4 o1, o2;
                        o1.x = x1.x * tA.x - x2.x * tA.y; o2.x = x2.x * tA.x + x1.x * tA.y;
                        o1.y = x1.y * tA.z - x2.y * tA.w; o2.y = x2.y * tA.z + x1.y * tA.w;
                        o1.z = x1.z * tB.x - x2.z * tB.y; o2.z = x2.z * tB.x + x1.z * tB.y;
                        o1.w = x1.w * tB.z - x2.w * tB.w; o2.w = x2.w * tB.z + x1.w * tB.w;
                        o1 = o1 * scale; o2 = o2 * scale;
                        u32x4 w; w.x = cvt_pk_bf16(o1.x, o1.y); w.y = cvt_pk_bf16(o1.z, o1.w); w.z = cvt_pk_bf16(o2.x, o2.y); w.w = cvt_pk_bf16(o2.z, o2.w);
                        *(u32x4*)(O + (size_t)row * NCP + col0 + bj * HALF) = w;
                    }
                }
            }
        } else {
            float* sq = ssq + (pn < 3 ? 0 : TOK);
#pragma unroll
            for (int ai = 0; ai < 2; ++ai)
#pragma unroll
                for (int m = 0; m < 4; ++m) {
                    const int row = row0 + ai * HALF + m * 16;
                    bf16_t* rowp = O + (size_t)row * NCP + col0;
                    float s = 0.f;
#pragma unroll
                    for (int bj = 0; bj < 2; ++bj) {
                        const f32x4 v0 = acc[ai][bj][m][0], v1 = acc[ai][bj][m][1];
                        s += (v0.x * v0.x + v0.y * v0.y) + (v0.z * v0.z + v0.w * v0.w) + (v1.x * v1.x + v1.y * v1.y) + (v1.z * v1.z + v1.w * v1.w);
                        u32x4 w; w.x = cvt_pk_bf16(v0.x, v0.y); w.y = cvt_pk_bf16(v0.z, v0.w); w.z = cvt_pk_bf16(v1.x, v1.y); w.w = cvt_pk_bf16(v1.z, v1.w);
                        *(u32x4*)(rowp + bj * HALF) = w;
                    }
                    if (pn < 5) { s += __shfl_xor(s, 16); s += __shfl_xor(s, 32); if (fq == 0) atomicAdd(sq + row, s); }
                }
        }
    }
};
struct EpiRowScale {
    static constexpr bool PERM = true, AFTER_DRAIN = false;
    bf16_t* O; int ldc; const float* ssq; float inv_n;
    __device__ __forceinline__ void operator()(const f32x4 (&acc)[2][2][4][2], const Unit& u, int wr, int wc, int fr, int fq) const {
        const int row0 = u.pm * BM + wr * 64 + fr, col0 = u.pn * BM + wc * 32 + 8 * fq;
#pragma unroll
        for (int ai = 0; ai < 2; ++ai)
#pragma unroll
            for (int m = 0; m < 4; ++m) {
                const int row = row0 + ai * HALF + m * 16;
                const float rstd = 1.0f / sqrtf(ssq[row] * inv_n + EPS);
                bf16_t* rowp = O + (size_t)row * ldc + col0;
#pragma unroll
                for (int bj = 0; bj < 2; ++bj) {
                    const f32x4 v0 = acc[ai][bj][m][0] * rstd, v1 = acc[ai][bj][m][1] * rstd;
                    u32x4 w; w.x = cvt_pk_bf16(v0.x, v0.y); w.y = cvt_pk_bf16(v0.z, v0.w); w.z = cvt_pk_bf16(v1.x, v1.y); w.w = cvt_pk_bf16(v1.z, v1.w);
                    *(u32x4*)(rowp + bj * HALF) = w;
                }
            }
    }
};
template <int MODE> struct EpiUp {
    static constexpr bool PERM = true, AFTER_DRAIN = false;
    bf16_t* O; int ldc; const float* ssq; float inv_k; const float* gain; const f32x4* tab64; LAS float* xch;
    __device__ __forceinline__ void operator()(const f32x4 (&acc)[2][2][4][2], const Unit& u, int wr, int wc, int fr, int fq) const {
        const int pn = u.pn, row0 = u.pm * BM + wr * 64 + fr, col0 = pn * BM + wc * 32 + 8 * fq;
        const bool ropet = (MODE == 0) && pn >= 4;
        float rs[2][4];
#pragma unroll
        for (int ai = 0; ai < 2; ++ai)
#pragma unroll
            for (int m = 0; m < 4; ++m) rs[ai][m] = 1.0f / sqrtf(ssq[row0 + ai * HALF + m * 16] * inv_k + EPS);
#pragma unroll
        for (int ai = 0; ai < 2; ++ai)
#pragma unroll
            for (int m = 0; m < 4; ++m)
#pragma unroll
                for (int bj = 0; bj < (MODE == 1 ? 1 : 2); ++bj) {
                    const f32x4 a = acc[ai][bj][m][0] * rs[ai][m], c = acc[ai][bj][m][1] * rs[ai][m];
                    float s = (a.x * a.x + a.y * a.y) + (a.z * a.z + a.w * a.w) + (c.x * c.x + c.y * c.y) + (c.z * c.z + c.w * c.w);
                    s += __shfl_xor(s, 16); s += __shfl_xor(s, 32);
                    if (fq == 0) xch[((ai * HALF + wr * 64 + m * 16 + fr) * 2 + bj) * 4 + wc] = s;
                }
        asm volatile("s_waitcnt lgkmcnt(0)" ::: "memory"); __builtin_amdgcn_s_barrier(); asm volatile("" ::: "memory");
        const int lg = 4 * (wc & 1) + fq;
        const int goff = ropet ? 128 + 4 * lg : 32 * wc + 8 * fq;
        const f32x4 g0 = *(const f32x4*)(gain + goff), g1 = *(const f32x4*)(gain + goff + (ropet ? 32 : 4));
        const float osc = MODE == 0 ? QSCALE_MLA : 1.0f, inv_n = ropet ? (1.0f / 64.0f) : (1.0f / 128.0f);
#pragma unroll
        for (int ai = 0; ai < 2; ++ai)
#pragma unroll
            for (int m = 0; m < 4; ++m) {
                const int row = row0 + ai * HALF + m * 16, t = row & (SEQ - 1);
                f32x4 tA = (f32x4){1.f, 0.f, 1.f, 0.f}, tB = tA;
                if (ropet) { const int ti = (t * 32 + 4 * lg) / 2; tA = tab64[ti]; tB = tab64[ti + 1]; }
                bf16_t* rowp = O + (size_t)row * ldc + col0;
#pragma unroll
                for (int bj = 0; bj < 2; ++bj) {
                    f32x4 o1, o2;
                    if (MODE == 1 && bj == 1) { o1 = acc[ai][bj][m][0] * rs[ai][m]; o2 = acc[ai][bj][m][1] * rs[ai][m]; }
                    else {
                        const f32x4 ps = *(const LAS f32x4*)(xch + ((ai * HALF + wr * 64 + m * 16 + fr) * 2 + bj) * 4);
                        const float tot = ropet ? ((wc & 2) ? ps.z + ps.w : ps.x + ps.y) : (ps.x + ps.y) + (ps.z + ps.w);
                        const float sc = rs[ai][m] * (1.0f / sqrtf(tot * inv_n + EPS)) * osc;
                        const f32x4 x1 = acc[ai][bj][m][0] * sc * g0, x2 = acc[ai][bj][m][1] * sc * g1;
                        if (ropet) {
                            o1.x = x1.x * tA.x - x2.x * tA.y; o2.x = x2.x * tA.x + x1.x * tA.y;
                            o1.y = x1.y * tA.z - x2.y * tA.w; o2.y = x2.y * tA.z + x1.y * tA.w;
                            o1.z = x1.z * tB.x - x2.z * tB.y; o2.z = x2.z * tB.x + x1.z * tB.y;
                            o1.w = x1.w * tB.z - x2.w * tB.w; o2.w = x2.w * tB.z + x1.w * tB.w;
                        } else { o1 = x1; o2 = x2; }
                    }
                    u32x4 w; w.x = cvt_pk_bf16(o1.x, o1.y); w.y = cvt_pk_bf16(o1.z, o1.w); w.z = cvt_pk_bf16(o2.x, o2.y); w.w = cvt_pk_bf16(o2.z, o2.w);
                    *(u32x4*)(rowp + bj * HALF) = w;
                }
            }
    }
};
}

DI int perm_half(int i, int half) { return i < half ? 8 * (i >> 2) + (i & 3) : 8 * ((i - half) >> 2) + 4 + (i & 3); }
DI int phys_in(int c) {
    if (c < 1280) return c;
    if (c < 1344) return C_KR + perm_half(c - 1280, 32);
    if (c < 2368) return C_GA + (c - 1344);
    if (c < 4416) { const int i0 = c - 2368; return C_QB + (i0 & ~127) + perm_half(i0 & 127, 64); }
    if (c < 5440) return C_VB + (c - 4416);
    return C_GB + (c - 5440);
}
DI int phys_uq(int c) { const int h = c / 192, i = c - 192 * h; return i < 128 ? 128 * h + i : 1024 + 64 * h + perm_half(i - 128, 32); }
template <int MODE>
DI void p0_transpose_item(const float* W, int K, int N, bf16_t* WT, LAS float* scr, int item, int lane, const float* gain) {
    const int nblk = N / 32, kb = item / nblk, nb = item % nblk, k0 = 64 * kb, n0 = 32 * nb;
    f32x4 wv[8];
#pragma unroll
    for (int i = 0; i < 8; ++i) wv[i] = *(const f32x4*)(W + (size_t)(k0 + 8 * i + (lane >> 3)) * N + n0 + 4 * (lane & 7));
#pragma unroll
    for (int i = 0; i < 8; ++i) { LAS float* d = scr + (8 * i + (lane >> 3)) * 33 + 4 * (lane & 7); d[0] = wv[i].x; d[1] = wv[i].y; d[2] = wv[i].z; d[3] = wv[i].w; }
    asm volatile("s_waitcnt lgkmcnt(0)" ::: "memory");
    const int c = lane & 7;
#pragma unroll
    for (int j = 0; j < 4; ++j) { const int n = (lane >> 3) + 8 * j; const LAS float* s = scr + (8 * c) * 33 + n;
        f32x4 ga = (f32x4){1.f, 1.f, 1.f, 1.f}, gb = ga;
        if (gain) { ga = *(const f32x4*)(gain + k0 + 8 * c); gb = *(const f32x4*)(gain + k0 + 8 * c + 4); }
        u32x4 o; o.x = pk2(s[0 * 33] * ga.x, s[1 * 33] * ga.y); o.y = pk2(s[2 * 33] * ga.z, s[3 * 33] * ga.w); o.z = pk2(s[4 * 33] * gb.x, s[5 * 33] * gb.y); o.w = pk2(s[6 * 33] * gb.z, s[7 * 33] * gb.w);
        const int nr = MODE == 1 ? phys_in(n0 + n) : (MODE == 2 ? phys_uq(n0 + n) : n0 + n);
        *(u32x4*)(WT + (size_t)nr * K + k0 + 8 * c) = o; }
    asm volatile("s_waitcnt lgkmcnt(0)" ::: "memory");
}
DI void phase0(const Params& p, LAS unsigned char* lds, int gw, int NGW, int lane, int wave, int part) {
    unsigned char* ws = p.ws;
    LAS float* scr = (LAS float*)(lds + wave * 16384);
    constexpr int I_IN = (DM / 64) * (NC / 32), I_UQ = (768 / 64) * (QA_W / 32), I_UKV = (512 / 64) * (KVA_W / 32), I_OUT = (DM / 64) * (DM / 32);
    constexpr int NITEMS = I_IN + I_UQ + I_UKV + I_OUT;
    const int it_lo = part == 0 ? 0 : I_IN, it_hi = part == 0 ? I_IN : NITEMS;
    for (int it = it_lo + gw; it < it_hi; it += NGW) {
        int r = it;
        if (r < I_IN) { p0_transpose_item<1>(p.in[2], DM, NC, (bf16_t*)(ws + WS_WIN), scr, r, lane, nullptr); continue; } r -= I_IN;
        if (r < I_UQ) { p0_transpose_item<2>(p.in[5], 768, QA_W, (bf16_t*)(ws + WS_WUQ), scr, r, lane, p.in[3]); continue; } r -= I_UQ;
        if (r < I_UKV) { p0_transpose_item<0>(p.in[6], 512, KVA_W, (bf16_t*)(ws + WS_WUKV), scr, r, lane, p.in[4]); continue; } r -= I_UKV;
        p0_transpose_item<0>(p.in[13], DM, DM, (bf16_t*)(ws + WS_WOUT), scr, r, lane, nullptr);
    }
    if (part == 1) return;
    const int gt = gw * 64 + lane, NGT = NGW * 64;
    for (int i = gt; i < 2 * TOK; i += NGT) ((float*)(ws + WS_SSQ))[i] = 0.f;
    if (gt < 320) ((float*)(ws + WS_GAINS))[gt] = gt < 128 ? p.in[9][gt] : (gt < 256 ? p.in[10][gt - 128] : p.in[8][128 + gt - 256]);
    {
        u32x4* z = (u32x4*)((bf16_t*)(ws + WS_WIN) + (size_t)NC * DM);
        for (int i = gt; i < (NCP - NC) * DM / 8; i += NGT) z[i] = (u32x4){0u, 0u, 0u, 0u};
    }
    for (int i = gt; i < SEQ * 96; i += NGT) {
        int s, j; float e; f32x2* dst;
        if (i < SEQ * 64) { s = i >> 6; j = i & 63; e = (float)(2 * j) * (1.0f / 128.0f); dst = (f32x2*)(ws + WS_TAB128) + i; }
        else { const int k = i - SEQ * 64; s = k >> 5; j = k & 31; e = (float)(2 * j) * (1.0f / 64.0f); dst = (f32x2*)(ws + WS_TAB64) + k; }
        const float inv = __builtin_amdgcn_exp2f(-e * 13.287712379549449f);
        const float ang = (float)s * inv;
        const double rev = (double)ang * 0.15915494309189535;
        const float fr = (float)(rev - rint(rev));
        *dst = (f32x2){__builtin_amdgcn_cosf(fr), __builtin_amdgcn_sinf(fr)};
    }
    const f32x4* g4 = (const f32x4*)p.in[1];
    for (int m = gw; m < TOK; m += NGW) {
        const f32x4* xr = (const f32x4*)(p.in[0] + (size_t)m * DM) + lane;
        f32x4 v[8]; float ss = 0.f;
#pragma unroll
        for (int j = 0; j < 8; ++j) { v[j] = __builtin_nontemporal_load(xr + 64 * j); ss += (v[j].x * v[j].x + v[j].y * v[j].y) + (v[j].z * v[j].z + v[j].w * v[j].w); }
        const float rstd = rstd_of(wave_sum(ss), 1.0f / DM);
        u32x2* o8 = (u32x2*)((bf16_t*)(ws + WS_HN) + (size_t)m * DM) + lane;
#pragma unroll
        for (int j = 0; j < 8; ++j) { const f32x4 g = g4[64 * j + lane]; const f32x4 y = v[j] * rstd * g; o8[64 * j] = (u32x2){pk2(y.x, y.y), pk2(y.z, y.w)}; }
    }
}

DI void e1_row(const Params& p, int row, int lane, bool dry) {
    unsigned char* ws = p.ws;
    const int t = row & (SEQ - 1);
    u32x4* r16 = (u32x4*)((bf16_t*)(ws + WS_PROJ) + (size_t)row * NCP);
    const int c8 = lane & 7, c16 = lane & 15;
    const u32x4 vq0 = r16[lane], vq1 = lane < 32 ? r16[64 + lane] : (u32x4){0u, 0u, 0u, 0u};
    const u32x4 vkv = r16[96 + lane], vkr = r16[160 + c8];
    u32x4 vh[4];
#pragma unroll
    for (int it = 0; it < 4; ++it) vh[it] = r16[(C_QB / 8) + it * 64 + lane];
    const f32x4* tb64 = (const f32x4*)(ws + WS_TAB64) + (t * 32 + (c8 & 3) * 8) / 2;
    const f32x4* tb128 = (const f32x4*)(ws + WS_TAB128) + (t * 64 + (c16 & 7) * 8) / 2;
    if (dry) return;
    {
        f32x4 a0, b0, a1, b1; unpack8(vq0, a0, b0); unpack8(vq1, a1, b1);
        const float rstd = rstd_of(wave_sum(sumsq8(a0, b0) + sumsq8(a1, b1)), 1.0f / 768.0f);
        const f32x4* g = (const f32x4*)p.in[3];
        r16[lane] = pack8(a0 * rstd * g[2 * lane], b0 * rstd * g[2 * lane + 1]);
        if (lane < 32) r16[64 + lane] = pack8(a1 * rstd * g[2 * (64 + lane)], b1 * rstd * g[2 * (64 + lane) + 1]);
    }
    {
        f32x4 a, b; unpack8(vkv, a, b);
        const float rstd = rstd_of(wave_sum(sumsq8(a, b)), 1.0f / 512.0f);
        const f32x4* g = (const f32x4*)p.in[4];
        r16[96 + lane] = pack8(a * rstd * g[2 * lane], b * rstd * g[2 * lane + 1]);
    }
    {
        f32x4 a, b; unpack8(vkr, a, b);
        const float rstd = rstd_of(grp_sum8(sumsq8(a, b)), 1.0f / 64.0f);
        const f32x4* g = (const f32x4*)p.in[8] + 32;
        a = a * rstd * g[2 * c8]; b = b * rstd * g[2 * c8 + 1];
        rope8(a, b, 4, c8 < 4, tb64);
        if (lane < 8) r16[160 + c8] = pack8(a, b);
    }
#pragma unroll
    for (int it = 0; it < 4; ++it) {
        f32x4 a, b; unpack8(vh[it], a, b);
        const float rstd = rstd_of(grp_sum16(sumsq8(a, b)), 1.0f / 128.0f);
        const f32x4* g = (const f32x4*)(it < 2 ? p.in[9] : p.in[10]);
        a = a * rstd * g[2 * c16]; b = b * rstd * g[2 * c16 + 1];
        rope8(a, b, 8, c16 < 8, tb128);
        if (it < 2) { a = a * QSCALE_DIL; b = b * QSCALE_DIL; }
        r16[(C_QB / 8) + it * 64 + lane] = pack8(a, b);
    }
}

DI void e2_row(const Params& p, int row, int lane, bool dry) {
    unsigned char* ws = p.ws;
    const int t = row & (SEQ - 1);
    u32x4* q16 = (u32x4*)((bf16_t*)(ws + WS_QA) + (size_t)row * QA_W);
    u32x4* kv16 = (u32x4*)((bf16_t*)(ws + WS_KVA) + (size_t)row * KVA_W);
    const f32x4* gq = (const f32x4*)p.in[7];
    const f32x4* gk = (const f32x4*)p.in[8];
    u32x4* pq[2]; u32x4* pk[2]; u32x4 vq[2], vk[2];
#pragma unroll
    for (int it = 0; it < 2; ++it) { const int idx = it * 64 + lane, h = idx >> 4, c = idx & 15; pq[it] = q16 + h * 24 + c; pk[it] = kv16 + h * 32 + c; vq[it] = *pq[it]; vk[it] = *pk[it]; }
    const int hr = lane >> 3, cr = lane & 7;
    u32x4* pr = q16 + hr * 24 + 16 + cr; const u32x4 vr = *pr;
    const f32x4* tb64 = (const f32x4*)(ws + WS_TAB64) + (t * 32 + (cr & 3) * 8) / 2;
    if (dry) return;
#pragma unroll
    for (int it = 0; it < 2; ++it) {
        const int c = lane & 15;
        f32x4 a, b; unpack8(vq[it], a, b);
        const float rstd = rstd_of(grp_sum16(sumsq8(a, b)), 1.0f / 128.0f) * QSCALE_MLA;
        *pq[it] = pack8(a * rstd * gq[2 * c], b * rstd * gq[2 * c + 1]);
    }
    {
        f32x4 a, b; unpack8(vr, a, b);
        const float rstd = rstd_of(grp_sum8(sumsq8(a, b)), 1.0f / 64.0f);
        a = a * rstd * gq[32 + 2 * cr]; b = b * rstd * gq[32 + 2 * cr + 1];
        rope8(a, b, 4, cr < 4, tb64);
        f32x4 xa, xb;
        xa.x = __shfl_xor(a.x, 4); xa.y = __shfl_xor(a.y, 4); xa.z = __shfl_xor(a.z, 4); xa.w = __shfl_xor(a.w, 4);
        xb.x = __shfl_xor(b.x, 4); xb.y = __shfl_xor(b.y, 4); xb.z = __shfl_xor(b.z, 4); xb.w = __shfl_xor(b.w, 4);
        u32x4* prp = q16 + hr * 24 + 16 + (cr < 4 ? 2 * cr : 2 * (cr - 4) + 1);
        *prp = cr < 4 ? pack8(a * QSCALE_MLA, xa * QSCALE_MLA) : pack8(xb * QSCALE_MLA, b * QSCALE_MLA);
    }
#pragma unroll
    for (int it = 0; it < 2; ++it) {
        const int c = lane & 15;
        f32x4 a, b; unpack8(vk[it], a, b);
        const float rstd = rstd_of(grp_sum16(sumsq8(a, b)), 1.0f / 128.0f);
        *pk[it] = pack8(a * rstd * gk[2 * c], b * rstd * gk[2 * c + 1]);
    }
}

DI void e3_row(const Params& p, int row, int lane) {
    unsigned char* ws = p.ws;
    const u32x4* r16 = (const u32x4*)((const bf16_t*)(ws + WS_PROJ) + (size_t)row * NCP);
    u32x4* y16 = (u32x4*)((bf16_t*)(ws + WS_Y) + (size_t)row * DM);
    {
        const u32x4* o16 = (const u32x4*)((const bf16_t*)(ws + WS_OA) + (size_t)row * 1024);
        f32x4 a0, b0, a1, b1; unpack8(o16[lane], a0, b0); unpack8(o16[64 + lane], a1, b1);
        const float rstd = rstd_of(wave_sum(sumsq8(a0, b0) + sumsq8(a1, b1)), 1.0f / 1024.0f);
        const f32x4* g = (const f32x4*)p.in[11];
        f32x4 ga0, gb0, ga1, gb1; unpack8(r16[C_GA / 8 + lane], ga0, gb0); unpack8(r16[C_GA / 8 + 64 + lane], ga1, gb1);
        y16[lane] = pack8(a0 * rstd * g[2 * lane] * silu4(ga0), b0 * rstd * g[2 * lane + 1] * silu4(gb0));
        y16[64 + lane] = pack8(a1 * rstd * g[2 * (64 + lane)] * silu4(ga1), b1 * rstd * g[2 * (64 + lane) + 1] * silu4(gb1));
    }
    {
        const float* lse = (const float*)(ws + WS_LSE);
        f32x4 oa[2], ob[2]; float ss = 0.f;
#pragma unroll
        for (int j = 0; j < 2; ++j) {
            const int cidx = j * 64 + lane, h = cidx >> 4;
            const float l0 = lse[(size_t)row * 8 + h], l1 = lse[(size_t)TOK * 8 + (size_t)row * 8 + h], l2 = lse[(size_t)2 * TOK * 8 + (size_t)row * 8 + h];
            const float mx = fmaxf(l0, fmaxf(l1, l2));
            float w0 = __expf(l0 - mx), w1 = __expf(l1 - mx), w2 = __expf(l2 - mx);
            const float inv = 1.0f / (w0 + w1 + w2); w0 *= inv; w1 *= inv; w2 *= inv;
            f32x4 a, b, c, d, e, f;
            unpack8(((const u32x4*)((const bf16_t*)(ws + WS_OD1) + (size_t)row * 1024))[cidx], a, b);
            unpack8(((const u32x4*)((const bf16_t*)(ws + WS_OD2) + (size_t)row * 1024))[cidx], c, d);
            unpack8(((const u32x4*)((const bf16_t*)(ws + WS_OD3) + (size_t)row * 1024))[cidx], e, f);
            oa[j] = a * w0 + c * w1 + e * w2; ob[j] = b * w0 + d * w1 + f * w2;
            ss += sumsq8(oa[j], ob[j]);
        }
        const float rstd = rstd_of(wave_sum(ss), 1.0f / 1024.0f);
        const f32x4* g = (const f32x4*)p.in[12];
#pragma unroll
        for (int j = 0; j < 2; ++j) {
            const int cidx = j * 64 + lane;
            f32x4 ga, gb; unpack8(r16[C_GB / 8 + cidx], ga, gb);
            y16[128 + cidx] = pack8(oa[j] * rstd * g[2 * cidx] * silu4(ga), ob[j] * rstd * g[2 * cidx + 1] * silu4(gb));
        }
    }
}

DI void naive_attn_row(const bf16_t* q, const bf16_t* k1, size_t k1s, const bf16_t* k2, size_t k2s, const bf16_t* v, size_t vs,
                       int t, int d, int nkeys, bf16_t* o, float* lse, LAS float* qs, int lane) {
    const int DK = k2 ? 192 : 128;
    for (int i = lane; i < DK; i += 64) qs[i] = __uint_as_float((unsigned)q[i] << 16);
    asm volatile("s_waitcnt lgkmcnt(0)" ::: "memory");
    float m = -1e30f, l = 0.f, o0 = 0.f, o1 = 0.f;
    for (int c0 = 0; c0 < nkeys; c0 += 64) {
        const int ik = c0 + lane; const bool valid = ik < nkeys; const int j = valid ? t - d * ik : t;
        float s = 0.f;
        const u32x4* kp = (const u32x4*)(k1 + (size_t)j * k1s);
#pragma unroll 4
        for (int ch = 0; ch < 16; ++ch) { f32x4 a, b; unpack8(kp[ch], a, b); const LAS f32x4* qq = (const LAS f32x4*)(qs + ch * 8); const f32x4 qa = qq[0], qb = qq[1];
            s += (a.x * qa.x + a.y * qa.y) + (a.z * qa.z + a.w * qa.w) + (b.x * qb.x + b.y * qb.y) + (b.z * qb.z + b.w * qb.w); }
        if (k2) { const u32x4* kp2 = (const u32x4*)(k2 + (size_t)j * k2s);
#pragma unroll 4
            for (int ch = 0; ch < 8; ++ch) { f32x4 a, b; unpack8(kp2[ch], a, b); const LAS f32x4* qq = (const LAS f32x4*)(qs + 128 + ch * 8); const f32x4 qa = qq[0], qb = qq[1];
                s += (a.x * qa.x + a.y * qa.y) + (a.z * qa.z + a.w * qa.w) + (b.x * qb.x + b.y * qb.y) + (b.z * qb.z + b.w * qb.w); } }
        s = valid ? s : -1e30f;
        const float mn = fmaxf(m, wave_max(s)); const float corr = exp2f(m - mn); const float pe = valid ? exp2f(s - mn) : 0.f;
        l = l * corr + wave_sum(pe); o0 *= corr; o1 *= corr; m = mn;
        const int cnt = min(64, nkeys - c0);
        for (int i = 0; i < cnt; ++i) { const float pi = __shfl(pe, i); const int jj = t - d * (c0 + i);
            const unsigned vv = *(const unsigned*)(v + (size_t)jj * vs + 2 * lane); o0 += pi * bflo(vv); o1 += pi * bfhi(vv); }
    }
    const float il = 1.0f / l;
    *(unsigned*)(o + 2 * lane) = pk2(o0 * il, o1 * il);
    if (lse && lane == 0) *lse = (m + log2f(l)) * LN2;
    asm volatile("s_waitcnt lgkmcnt(0)" ::: "memory");
}
DI void phase5_naive(const Params& p, LAS unsigned char* lds, int gw, int NGW, int lane, int wave, int type_lo, int type_hi) {
    unsigned char* ws = p.ws;
    LAS float* qs = (LAS float*)(lds + wave * 1024);
    const bf16_t* proj = (const bf16_t*)(ws + WS_PROJ); const bf16_t* qa = (const bf16_t*)(ws + WS_QA); const bf16_t* kva = (const bf16_t*)(ws + WS_KVA);
    for (int item = type_lo * TOK * 8 + gw; item < type_hi * TOK * 8; item += NGW) {
        const int type = item / (TOK * 8), rem = item % (TOK * 8), row = rem >> 3, h = rem & 7, b = row >> 12, t = row & (SEQ - 1);
        const size_t brow = (size_t)b * SEQ;
        if (type == 0) {
            naive_attn_row(qa + (size_t)row * QA_W + h * 192, kva + brow * KVA_W + h * 256, KVA_W, proj + brow * NCP + C_KR, NCP, kva + brow * KVA_W + h * 256 + 128, KVA_W,
                           t, 1, t + 1, (bf16_t*)(ws + WS_OA) + (size_t)row * 1024 + h * 128, nullptr, qs, lane);
        } else {
            const int pidx = type - 1, d = pidx == 0 ? 1 : (pidx == 1 ? 4 : 16);
            bf16_t* od = (bf16_t*)(ws + (pidx == 0 ? WS_OD1 : (pidx == 1 ? WS_OD2 : WS_OD3)));
            naive_attn_row(proj + (size_t)row * NCP + C_QB + h * 128, proj + brow * NCP + C_KB + h * 128, NCP, nullptr, 0, proj + brow * NCP + C_VB + h * 128, NCP,
                           t, d, min(t / d, 128) + 1, od + (size_t)row * 1024 + h * 128, (float*)(ws + WS_LSE) + (size_t)pidx * TOK * 8 + (size_t)row * 8 + h, qs, lane);
        }
    }
}

namespace fa {
typedef short bf16x8 __attribute__((ext_vector_type(8)));
typedef short s16x4 __attribute__((ext_vector_type(4)));
typedef float f32x16 __attribute__((ext_vector_type(16)));
#define FA_MFMA(a, b, c) __builtin_amdgcn_mfma_f32_32x32x16_bf16((a), (b), (c), 0, 0, 0)
struct Unit {
    const bf16_t* q; const bf16_t* q2; unsigned qs; const bf16_t* k1; unsigned k1s; const bf16_t* k2; unsigned k2s; const bf16_t* v; unsigned vs;
    bf16_t* o; unsigned os; float* lse; unsigned lses; int l0, kt_begin, W;
};
DI unsigned v_off(int row, int ch) { return 2048u * (row >> 3) + 512u * (ch >> 2) + 64u * (row & 7) + 16u * ((ch & 3) ^ ((row >> 2) & 3)); }

template <int DK>
DI void unit_run(const Unit& u, LAS unsigned char* lds, int tid, int lane, int wave) {
    constexpr int NKS = DK / 16;
    constexpr int K1BYTES = 64 * 256, K2BYTES = (DK == 192) ? 64 * 128 : 0, KBYTES = K1BYTES + K2BYTES, VBYTES = 64 * 256, STAGE = KBYTES + VBYTES;
    const int hi = lane >> 5, l31 = lane & 31;
    const int wq0 = u.l0 + 32 * wave, W = u.W;
    bf16x8 qf[NKS];
    {   const unsigned qo = (unsigned)(wq0 + l31) * u.qs + 8u * hi;
#pragma unroll
        for (int ks = 0; ks < NKS; ++ks) qf[ks] = ks < 8 ? *(const bf16x8*)(u.q + (qo + 16u * ks)) : *(const bf16x8*)(u.q2 + (qo + 16u * (ks - 8))); }
    const int ntiles = (u.l0 + 256 - u.kt_begin) >> 6;
#define FA_DMA(kt, st) do { LAS unsigned char* sb_ = lds + (st) * STAGE; \
        _Pragma("unroll") for (int n = 0; n < 2; ++n) { \
            { const int s = (2 * wave + n) * 64 + lane, row = s >> 4, cc = (s & 15) ^ (row & 15); \
              __builtin_amdgcn_global_load_lds((const unsigned*)(u.k1 + ((unsigned)((kt) + row) * u.k1s + 8u * cc)), (LAS unsigned*)(sb_ + (2 * wave + n) * 1024), 16, 0, 0); } \
            { const int s = (2 * wave + n) * 64 + lane, row = 8 * (s >> 7) + ((s >> 2) & 7), ch = 4 * ((s >> 5) & 3) + ((s & 3) ^ ((row >> 2) & 3)); \
              __builtin_amdgcn_global_load_lds((const unsigned*)(u.v + ((unsigned)((kt) + row) * u.vs + 8u * ch)), (LAS unsigned*)(sb_ + KBYTES + (2 * wave + n) * 1024), 16, 0, 0); } } \
        if (DK == 192) { const int s = wave * 64 + lane, row = s >> 3, cc = (s & 7) ^ ((row >> 1) & 7); \
            __builtin_amdgcn_global_load_lds((const unsigned*)(u.k2 + ((unsigned)((kt) + row) * u.k2s + 8u * cc)), (LAS unsigned*)(sb_ + K1BYTES + wave * 1024), 16, 0, 0); } } while (0)
    FA_DMA(u.kt_begin, 0);
    __syncthreads();
    f32x16 O[4];
#pragma unroll
    for (int c = 0; c < 4; ++c)
#pragma unroll
        for (int r = 0; r < 16; ++r) O[c][r] = 0.f;
    float m = -1e30f, l = 0.f;
    const unsigned x1 = (unsigned)(l31 & 15), x2 = (unsigned)((l31 >> 1) & 7);
    const unsigned ka1 = (unsigned)(l31 * 256) + 16u * ((hi ^ x1) & 1u), kx1 = 16u * (x1 & 14u);
    const unsigned ka2 = (unsigned)(K1BYTES + l31 * 128) + 16u * ((hi ^ x2) & 1u), kx2 = 16u * (x2 & 6u);
    const int q4 = (lane & 15) >> 2, p4 = lane & 3, blk = (lane >> 4) & 1;
    const unsigned va0 = (unsigned)(KBYTES + 64 * (4 * hi + q4) + 16 * ((2 * blk + (p4 >> 1)) ^ (hi)) + 8 * (p4 & 1));
    const unsigned va1 = (unsigned)(KBYTES + 64 * (4 * hi + q4) + 16 * ((2 * blk + (p4 >> 1)) ^ (2 + hi)) + 8 * (p4 & 1));
    for (int it = 0; it < ntiles; ++it) {
        const int kt0 = u.kt_begin + 64 * it, cur = it & 1;
        if (it + 1 < ntiles) FA_DMA(kt0 + 64, cur ^ 1);
        const bool relevant = (kt0 <= wq0 + 31) && (kt0 + 63 >= wq0 - W);
        if (relevant) {
            const LAS unsigned char* sb = lds + cur * STAGE;
            f32x16 S0, S1;
#pragma unroll
            for (int r = 0; r < 16; ++r) { S0[r] = 0.f; S1[r] = 0.f; }
#pragma unroll
            for (int ks = 0; ks < NKS; ++ks) {
                const unsigned ko = ks < 8 ? ka1 + ((32u * ks) ^ kx1) : ka2 + ((32u * (ks - 8)) ^ kx2);
                S0 = FA_MFMA(*(const LAS bf16x8*)(sb + ko), qf[ks], S0);
            }
#pragma unroll
            for (int ks = 0; ks < NKS; ++ks) {
                const unsigned ko = ks < 8 ? ka1 + ((32u * ks) ^ kx1) : ka2 + ((32u * (ks - 8)) ^ kx2);
                S1 = FA_MFMA(*(const LAS bf16x8*)(sb + ko + (ks < 8 ? 32 * 256 : 32 * 128)), qf[ks], S1);
            }
            const bool needmask = !((kt0 + 63 <= wq0) && (kt0 >= wq0 + 31 - W));
            const int dq = wq0 + l31 - kt0 - 4 * hi;
#define FA_HALF(S, KB) do { \
            if (needmask) { _Pragma("unroll") for (int r = 0; r < 16; ++r) { const int d0 = dq - 32 * (KB) - ((r & 3) + 8 * (r >> 2)); S[r] = (d0 >= 0 && d0 <= W) ? S[r] : -INFINITY; } } \
            float mx = fmaxf(S[0], S[1]); \
            _Pragma("unroll") for (int r = 2; r < 16; ++r) mx = fmaxf(mx, S[r]); \
            mx = fmaxf(mx, __shfl_xor(mx, 32)); \
            if (__builtin_amdgcn_ballot_w64(mx > m + 8.0f) != 0ull) {         \
                const float mn = fmaxf(m, mx); const float corr = __builtin_amdgcn_exp2f(m - mn); m = mn; l *= corr; \
                _Pragma("unroll") for (int c = 0; c < 4; ++c) _Pragma("unroll") for (int r = 0; r < 16; ++r) O[c][r] *= corr; } \
            float ps = 0.f; \
            _Pragma("unroll") for (int r = 0; r < 16; ++r) { S[r] = __builtin_amdgcn_exp2f(S[r] - m); ps += S[r]; } \
            l += ps; \
            bf16x8 P[2]; \
            _Pragma("unroll") for (int j = 0; j < 2; ++j) { u32x4 w; w.x = pk2(S[8 * j + 0], S[8 * j + 1]); w.y = pk2(S[8 * j + 2], S[8 * j + 3]); w.z = pk2(S[8 * j + 4], S[8 * j + 5]); w.w = pk2(S[8 * j + 6], S[8 * j + 7]); \
                P[j] = __builtin_bit_cast(bf16x8, w); } \
            _Pragma("unroll") for (int j = 0; j < 2; ++j) _Pragma("unroll") for (int c = 0; c < 4; ++c) { \
                const s16x4 lo = __builtin_amdgcn_ds_read_tr16_b64_v4i16((LAS s16x4*)(sb + va0 + 2048 * (4 * (KB) + 2 * j) + 512 * c)); \
                const s16x4 hv = __builtin_amdgcn_ds_read_tr16_b64_v4i16((LAS s16x4*)(sb + va1 + 2048 * (4 * (KB) + 2 * j + 1) + 512 * c)); \
                O[c] = FA_MFMA(__builtin_shufflevector(lo, hv, 0, 1, 2, 3, 4, 5, 6, 7), P[j], O[c]); } } while (0)
            FA_HALF(S0, 0);
            FA_HALF(S1, 1);
#undef FA_HALF
        }
        __syncthreads();
    }
#undef FA_DMA
    l += __shfl_xor(l, 32);
    const float il = 1.0f / l;
    bf16_t* orow = u.o + ((unsigned)(wq0 + l31) * u.os + 4u * hi);
#pragma unroll
    for (int c = 0; c < 4; ++c)
#pragma unroll
        for (int g = 0; g < 4; ++g) {
            u32x2 w; w.x = pk2(O[c][4 * g + 0] * il, O[c][4 * g + 1] * il); w.y = pk2(O[c][4 * g + 2] * il, O[c][4 * g + 3] * il);
            *(u32x2*)(orow + 32 * c + 8 * g) = w;
        }
    if (u.lse && hi == 0) u.lse[(unsigned)(wq0 + l31) * u.lses] = (m + __builtin_amdgcn_logf(l)) * LN2;
}
}

DI void phase5_fast(const Params& p, LAS unsigned char* lds) {
    int tid = threadIdx.x; asm volatile("" : "+v"(tid));
    const int lane = tid & 63, wave = __builtin_amdgcn_readfirstlane(tid >> 6);
    unsigned char* ws = p.ws;
    const int G = gridDim.x, bid = blockIdx.x;
    const bf16_t* proj = (const bf16_t*)(ws + WS_PROJ); const bf16_t* qa = (const bf16_t*)(ws + WS_QA); const bf16_t* kva = (const bf16_t*)(ws + WS_KVA);
    if (FAST_MLA) for (int pi = bid; pi < 256; pi += G) {
        const int vv = pi >> 3, bh = (pi & 7) * 4 + (vv >> 3), j = vv & 7, b = bh >> 3, h = bh & 7;
        const size_t brow = (size_t)b * SEQ;
#pragma unroll 1
        for (int s = 0; s < 2; ++s) {
            const int qb = s == 0 ? 15 - j : j;
            fa::Unit u;
            u.q = qa + brow * QA_W + h * 128; u.q2 = qa + brow * QA_W + 1024 + h * 64; u.qs = QA_W;
            u.k1 = kva + brow * KVA_W + h * 256; u.k1s = KVA_W; u.k2 = proj + brow * NCP + C_KR; u.k2s = NCP;
            u.v = kva + brow * KVA_W + h * 256 + 128; u.vs = KVA_W;
            u.o = (bf16_t*)(ws + WS_OA) + brow * 1024 + h * 128; u.os = 1024; u.lse = nullptr; u.lses = 0;
            u.l0 = 256 * qb; u.kt_begin = 0; u.W = 1 << 30;
            fa::unit_run<192>(u, lds, tid, lane, wave);
        }
    }
    if (FAST_DIL)
#pragma unroll 1
    for (int ui = bid; ui < 1536; ui += G) {
        int pidx, b, h, sub;
        if (G == 256) { const int i6 = ui >> 8, x8 = ui & 7, k32 = (ui >> 3) & 31, bh = 4 * x8 + 2 * (i6 / 3) + (k32 >> 4); pidx = i6 % 3; b = bh >> 3; h = bh & 7; sub = k32 & 15; }
        else { const int xq = ui & 7, yq = (ui >> 3) & 31, grp = (ui >> 8) * 32 + (yq >> 3) * 8 + xq; h = yq & 7; pidx = grp >> 6; b = (grp >> 4) & 3; sub = grp & 15; }
        const int d = pidx == 0 ? 1 : (pidx == 1 ? 4 : 16), nub = 16 / d, r = sub / nub, ub = sub % nub;
        const size_t row0 = (size_t)b * SEQ + r;
        fa::Unit u;
        u.q = proj + row0 * NCP + C_QB + h * 128; u.q2 = nullptr; u.qs = (unsigned)d * NCP;
        u.k1 = proj + row0 * NCP + C_KB + h * 128; u.k1s = (unsigned)d * NCP; u.k2 = nullptr; u.k2s = 0;
        u.v = proj + row0 * NCP + C_VB + h * 128; u.vs = (unsigned)d * NCP;
        u.o = (bf16_t*)(ws + (pidx == 0 ? WS_OD1 : (pidx == 1 ? WS_OD2 : WS_OD3))) + row0 * 1024 + h * 128; u.os = (unsigned)d * 1024;
        u.lse = (float*)(ws + WS_LSE) + (size_t)pidx * TOK * 8 + row0 * 8 + h; u.lses = (unsigned)d * 8;
        u.l0 = 256 * ub; u.kt_begin = u.l0 >= 128 ? u.l0 - 128 : 0; u.W = 128;
        fa::unit_run<128>(u, lds, tid, lane, wave);
    }
}

#define XB_TMO      128
#define XB_XCNT(j)  (256  + 64 * (j))
#define XB_XSUB(j)  (1280 + 64 * (j))
#define XB_XGEN(j)  (2304 + 64 * (j))
#define XB_TOP      3328
#define XB_TOPGEN   3392
#define XCD_BAR_WORDS 3456
#define XB_SPIN_CAP (1u << 18)

__device__ __forceinline__ unsigned xb_ld(unsigned* p)              { return __hip_atomic_load(p, __ATOMIC_RELAXED, __HIP_MEMORY_SCOPE_AGENT); }
__device__ __forceinline__ unsigned xb_add(unsigned* p, unsigned v) { return __hip_atomic_fetch_add(p, v, __ATOMIC_RELAXED, __HIP_MEMORY_SCOPE_AGENT); }
__device__ __forceinline__ unsigned xb_xcc_id() { return (unsigned)__builtin_amdgcn_s_getreg((3 << 11) | 20) & 0xFu; }
#define XB_SPIN(cond, bar) do { unsigned _sp = 0; while (cond) { __builtin_amdgcn_s_sleep(1); \
    if ((++_sp & 255u) == 0u) { if (xb_ld(&(bar)[XB_TMO])) break; if (_sp > XB_SPIN_CAP) { atomicAdd(&(bar)[XB_TMO], 1u); break; } } } } while (0)

struct XcdBarrier {
    unsigned* bar; unsigned x;
    volatile LAS unsigned* st;
};

__device__ __forceinline__ XcdBarrier xcd_barrier_post(unsigned* bar, volatile LAS unsigned* st) {
    XcdBarrier b; b.bar = bar; b.x = xb_xcc_id(); b.st = st;
    if (threadIdx.x == 0) (void)xb_add(&bar[XB_XCNT(b.x)], 1u);
    return b;
}
__device__ __forceinline__ void xcd_barrier_complete(unsigned* bar, unsigned x, unsigned& nloc, unsigned& nx) {
    const unsigned G = gridDim.x * gridDim.y * gridDim.z;
    unsigned sum, cnt, mine, sp = 0u;
    for (;;) {
        sum = 0u; cnt = 0u; mine = 0u;
#pragma unroll
        for (unsigned j = 0; j < 16; ++j) { const unsigned c = xb_ld(&bar[XB_XCNT(j)]); sum += c; cnt += (c > 0u) ? 1u : 0u; mine = (j == x) ? c : mine; }
        if (sum == G) break;
        __builtin_amdgcn_s_sleep(1);
        if ((++sp & 255u) == 0u) { if (xb_ld(&bar[XB_TMO])) break; if (sp > XB_SPIN_CAP) { atomicAdd(&bar[XB_TMO], 1u); break; } }
    }
    nloc = mine > 0u ? mine : 1u; nx = cnt > 0u ? cnt : 1u;
}

__device__ __forceinline__ void xcd_barrier(const XcdBarrier& b) {
    asm volatile("s_waitcnt vmcnt(0)" ::: "memory");
    __syncthreads();
    if (threadIdx.x == 0) {
        unsigned* bar = b.bar;
        __builtin_amdgcn_s_waitcnt(0);
        unsigned nloc = b.st[0], nx = b.st[1];
        if (nloc == 0u) { xcd_barrier_complete(bar, b.x, nloc, nx); b.st[0] = nloc; b.st[1] = nx; }
        const unsigned old = xb_add(&bar[XB_XSUB(b.x)], 1u);
        const unsigned gen = old / nloc;
        if (old + 1u == (gen + 1u) * nloc) {
            __builtin_amdgcn_fence(__ATOMIC_RELEASE, "agent");
            asm volatile("s_waitcnt vmcnt(0)" ::: "memory");
            const unsigned og = xb_add(&bar[XB_TOP], 1u);
            const unsigned tg = og / nx;
            if (og + 1u == (tg + 1u) * nx) xb_add(&bar[XB_TOPGEN], 1u);
            else XB_SPIN(xb_ld(&bar[XB_TOPGEN]) == tg, bar);
            __builtin_amdgcn_fence(__ATOMIC_ACQUIRE, "agent");
            xb_add(&bar[XB_XGEN(b.x)], 1u);
            asm volatile("s_waitcnt vmcnt(0)" ::: "memory");
        } else {
            XB_SPIN(xb_ld(&bar[XB_XGEN(b.x)]) == gen, bar);
            __builtin_amdgcn_fence(__ATOMIC_ACQUIRE, "agent");
            asm volatile("s_waitcnt vmcnt(0)" ::: "memory");
        }
    }
    __syncthreads();
}

__global__ void __launch_bounds__(512, 2) fwd_kernel(Params p) {
    extern __shared__ __attribute__((aligned(16))) unsigned char lds_raw[];
    LAS unsigned char* lds = (LAS unsigned char*)lds_raw;
    cg::grid_group grid = cg::this_grid();
    const int tid = threadIdx.x, lane = tid & 63, wave = __builtin_amdgcn_readfirstlane(tid >> 6);
    const int G = gridDim.x, gw = blockIdx.x * 8 + wave, NGW = G * 8;
    unsigned char* ws = p.ws;
    const int lo = p.ph_lo, hi = p.ph_hi;
#define IN(k) (lo <= (k) && (k) < hi)
#ifndef COOP_SEAM
#define COOP_SEAM -1
#endif
    volatile LAS unsigned* bst = (volatile LAS unsigned*)(lds + LDS_BYTES - 64);
    if (tid == 0) { bst[0] = 0u; bst[1] = 0u; }
    __syncthreads();
    XcdBarrier bar = xcd_barrier_post((unsigned*)(ws + WS_CTL), bst);
    if (p.ph_lo < 0) grid.sync();
    unsigned long long t0_ = 0, t1_ = 0;
#define PB0(k) do { if (PROBE_PHASE == (k)) t0_ = __builtin_amdgcn_s_memrealtime(); } while (0)
#define PB1(k) do { if (PROBE_PHASE == (k)) t1_ = __builtin_amdgcn_s_memrealtime(); } while (0)
#define SEAM(k) do { if (IN(k) && IN((k) + 1)) { if ((k) == COOP_SEAM) grid.sync(); else xcd_barrier(bar); } } while (0)

    PB0(0);
    for (int rep_ = 0; rep_ < (DUP_PHASE == 0 ? 2 : 1); ++rep_) if (IN(0)) { phase0(p, lds, gw, NGW, lane, wave, 0); } SEAM(0); PB1(0);

    PB0(1);
    for (int rep_ = 0; rep_ < (DUP_PHASE == 1 ? 2 : 1); ++rep_) if (IN(1)) {
        pg8::Gemm g{(const bf16_t*)(ws + WS_HN), (const bf16_t*)(ws + WS_WIN), TOK, NCP, DM, DM}; pg8::StaticOrder S; S.init(TOK, NCP, G, (int)blockIdx.x);
        pg8::EpiProj E{(bf16_t*)(ws + WS_PROJ), (float*)(ws + WS_SSQ), (const float*)(ws + WS_GAINS), (const f32x4*)(ws + WS_TAB128), (LAS float*)(lds + XCH_OFF)};
        pg8::gemm_phase<pg8::EpiProj, pg8::StaticOrder, PG8_ALIGN, PG8_SP2>(lds, g, S, E);
        const int nfull = (TOK / 256) * (NCP / 256) % G, nidle = nfull == 0 ? G : G - nfull;
        if (nfull == 0 || (int)blockIdx.x >= nfull) phase0(p, lds, ((int)blockIdx.x - (nfull == 0 ? 0 : nfull)) * 8 + wave, nidle * 8, lane, wave, 1);
    } SEAM(1); PB1(1);


    PB0(3);
    for (int rep_ = 0; rep_ < (DUP_PHASE == 3 ? 2 : 1); ++rep_) if (IN(3)) {
        { pg8::Gemm g{(const bf16_t*)(ws + WS_PROJ) + C_CQ, (const bf16_t*)(ws + WS_WUQ), TOK, QA_W, 768, NCP}; pg8::StaticOrder S; S.init(TOK, QA_W, G, (int)blockIdx.x);
          pg8::EpiUp<0> E{(bf16_t*)(ws + WS_QA), QA_W, (const float*)(ws + WS_SSQ), 1.0f / 768.0f, p.in[7], (const f32x4*)(ws + WS_TAB64), (LAS float*)(lds + XCH_OFF)};
          pg8::gemm_phase<pg8::EpiUp<0>, pg8::StaticOrder, PG8_ALIGN, PG8_SP2>(lds, g, S, E); }
        __syncthreads();
        { pg8::Gemm g{(const bf16_t*)(ws + WS_PROJ) + C_CKV, (const bf16_t*)(ws + WS_WUKV), TOK, KVA_W, 512, NCP}; pg8::StaticOrder S; S.init(TOK, KVA_W, G, (int)blockIdx.x);
          pg8::EpiUp<1> E{(bf16_t*)(ws + WS_KVA), KVA_W, (const float*)(ws + WS_SSQ) + TOK, 1.0f / 512.0f, p.in[8], (const f32x4*)(ws + WS_TAB64), (LAS float*)(lds + XCH_OFF)};
          pg8::gemm_phase<pg8::EpiUp<1>, pg8::StaticOrder, PG8_ALIGN, PG8_SP2>(lds, g, S, E); }
    } SEAM(3); PB1(3);


    PB0(5);
    for (int rep_ = 0; rep_ < (DUP_PHASE == 5 ? 2 : 1); ++rep_) if (IN(5)) {
        if (!FAST_MLA) phase5_naive(p, lds, gw, NGW, lane, wave, 0, 1);
        if (!FAST_DIL) phase5_naive(p, lds, gw, NGW, lane, wave, 1, 4);
        if (FAST_MLA || FAST_DIL) { __syncthreads(); phase5_fast(p, lds); }
    } SEAM(5); PB1(5);

    PB0(6);
    for (int rep_ = 0; rep_ < (DUP_PHASE == 6 ? 2 : 1); ++rep_) if (IN(6)) { for (int m = gw; m < TOK; m += NGW) e3_row(p, m, lane); } SEAM(6); PB1(6);

    PB0(7);
    for (int rep_ = 0; rep_ < (DUP_PHASE == 7 ? 2 : 1); ++rep_) if (IN(7)) {
        pg8::Gemm g{(const bf16_t*)(ws + WS_Y), (const bf16_t*)(ws + WS_WOUT), TOK, DM, DM, DM}; pg8::StaticOrder S; S.init(TOK, DM, G, (int)blockIdx.x);
        pg8::EpiResF32 E{p.in[0], p.out, DM};
        pg8::gemm_phase<pg8::EpiResF32, pg8::StaticOrder, PG8_ALIGN, PG8_SP2>(lds, g, S, E);
    }
    if (PROBE_PHASE >= 0 && hi - lo > 1) {
        xcd_barrier(bar); PB1(7);
        if (blockIdx.x == 0 && tid == 0) p.out[0] += (float)(t1_ - t0_) * 0.01f;
    }
#if defined(EXTRA_SYNCS)
    if (hi - lo > 1) for (int i = 0; i < EXTRA_SYNCS; ++i) xcd_barrier(bar);
#endif
#undef IN
#undef SEAM
}

extern "C" void kernel_launch(void* const* d_in, const int* in_sizes, int n_in, void* d_out, int out_size, void* d_ws, size_t ws_size, hipStream_t stream) {
    static int grid = 0;
    if (grid == 0) {
        if (n_in != 14 || in_sizes[0] != TOK * DM || out_size != TOK * DM || ws_size < WS_END) {
            fprintf(stderr, "kernel_launch: unexpected shapes: n_in %d in0 %d out %d ws %zu (need %zu)\n", n_in, n_in > 0 ? in_sizes[0] : -1, out_size, ws_size, (size_t)WS_END); grid = -1; return; }
        int dev = 0, cus = 0, per_cu = 0;
        if (hipGetDevice(&dev) != hipSuccess || hipDeviceGetAttribute(&cus, hipDeviceAttributeMultiprocessorCount, dev) != hipSuccess) { fprintf(stderr, "kernel_launch: device query failed\n"); grid = -1; return; }
        if (hipFuncSetAttribute((const void*)fwd_kernel, hipFuncAttributeMaxDynamicSharedMemorySize, LDS_BYTES) != hipSuccess) { fprintf(stderr, "kernel_launch: hipFuncSetAttribute failed\n"); grid = -1; return; }
        if (hipOccupancyMaxActiveBlocksPerMultiprocessor(&per_cu, (const void*)fwd_kernel, 512, LDS_BYTES) != hipSuccess || per_cu < 1) { fprintf(stderr, "kernel_launch: occupancy query says %d blocks per CU\n", per_cu); (void)hipGetLastError(); grid = -1; return; }
        grid = cus * 1;
        fprintf(stderr, "kernel_launch: cus %d per_cu %d grid %d\n", cus, per_cu, grid);
    }
    if (grid < 0) return;
    if (hipMemsetAsync((char*)d_ws + WS_CTL, 0, CTL_BYTES, stream) != hipSuccess) { fprintf(stderr, "kernel_launch: memset of the barrier words failed\n"); return; }
    Params p{};
    for (int i = 0; i < 14; ++i) p.in[i] = (const float*)d_in[i];
    p.out = (float*)d_out; p.ws = (unsigned char*)d_ws;
#if MK_N_LAUNCHES == 1
    p.ph_lo = 0; p.ph_hi = NPH;
    void* args[] = {&p};
#if defined(PLAIN_LAUNCH)
    (void)args; hipLaunchKernelGGL(fwd_kernel, dim3(grid), dim3(512), LDS_BYTES, stream, p); const hipError_t e = hipPeekAtLastError();
#else
    const hipError_t e = hipLaunchCooperativeKernel((const void*)fwd_kernel, dim3(grid), dim3(512), args, LDS_BYTES, stream);
#endif
    if (e != hipSuccess) fprintf(stderr, "kernel_launch: cooperative launch failed: %s (grid %d)\n", hipGetErrorString(e), grid);
#else
    for (int ph = 0; ph < NPH; ++ph) {
        p.ph_lo = ph; p.ph_hi = ph + 1;
        hipLaunchKernelGGL(fwd_kernel, dim3(grid), dim3(512), LDS_BYTES, stream, p);
        const hipError_t e = hipPeekAtLastError();
        if (e != hipSuccess) { fprintf(stderr, "kernel_launch: launch %d failed: %s\n", ph, hipGetErrorName(e)); break; }
    }
#endif
}
```

```cpp
#include <hip/hip_runtime.h>
#include <hip/hip_cooperative_groups.h>
#include <cstdio>
#include <cstdint>
namespace cg = cooperative_groups;
namespace pg8 {
#define PG8_LAS __attribute__((address_space(3)))
typedef unsigned short bf16_t;
typedef short bf16x8 __attribute__((ext_vector_type(8)));
typedef float f32x4 __attribute__((ext_vector_type(4)));
typedef unsigned u32x4 __attribute__((ext_vector_type(4)));
constexpr int BM = 256, BK = 64, HALF = 128, HTB = HALF * BK * 2  , STAGE_BYTES = 8 * HTB, NXCD = 8, WGM = 8;

__host__ __device__ __forceinline__ int lds_byte(int r, int c) { const int st = (r >> 4) * 2 + (c >> 5), rr = r & 15, cc = c & 31, ob = rr * 64 + cc * 2; return st * 1024 + (ob ^ (((ob >> 9) & 1) << 5)); }
__host__ __device__ __forceinline__ void stage_rc(int b, int& R, int& C) { const int st = b / 1024, sb = b % 1024, swz = sb ^ (((sb >> 9) & 1) << 5); R = (st >> 1) * 16 + swz / 64; C = (st & 1) * 32 + (swz % 64) / 2; }
__host__ __device__ __forceinline__ int perm32(int rho) { const int n = rho >> 4, i = rho & 15; return 8 * (i >> 2) + 4 * n + (i & 3); }

struct Unit { int pm, pn; };
struct Gemm { const bf16_t* A; const bf16_t* Bt; int M, N, K, lda; };

struct StaticOrder {
    int nM, nN, nwg, G, c;
    __host__ __device__ void init(int M, int N, int G_, int c_) { nM = M / BM; nN = N / BM; nwg = nM * nN; G = G_; c = c_; }
    __host__ __device__ bool next(int i, Unit& u) const {
        const long L = (long)i * G + c; if (L >= nwg) return false;
        int wgid = (int)L; { const int q = nwg / NXCD, r = nwg % NXCD, xcd = wgid % NXCD, off = wgid / NXCD; wgid = (xcd < r ? xcd * (q + 1) : r * (q + 1) + (xcd - r) * q) + off; }
        const int nig = WGM * nN, gid = wgid / nig, fm = gid * WGM, gsz = (nM - fm) < WGM ? (nM - fm) : WGM;
        u.pm = fm + ((wgid % nig) % gsz); u.pn = (wgid % nig) / gsz; return true;
    }
    __device__ __forceinline__ void a_ready(const Unit&) const {}
    __device__ __forceinline__ void done(const Unit&) const {}
};

__device__ __forceinline__ unsigned cvt_pk_bf16(float lo, float hi) { unsigned r; asm volatile("v_cvt_pk_bf16_f32 %0, %1, %2" : "=v"(r) : "v"(lo), "v"(hi)); return r; }
typedef float f32x2 __attribute__((ext_vector_type(2)));
__device__ __forceinline__ f32x2 gelu_pk(f32x2 v) {
    const f32x2 av = __builtin_elementwise_abs(v), d = av * 0.2316418882f + 1.0f;
    f32x2 t; t.x = __builtin_amdgcn_rcpf(d.x); t.y = __builtin_amdgcn_rcpf(d.y);
    f32x2 q = t * 0.5307027145f + (-0.7265760135f); q = q * t + 0.7107068705f; q = q * t + (-0.142248368f); q = q * t + 0.127414796f; q = q * t;
    const f32x2 s = (v * v) * (-0.72134752044f);
    f32x2 e; e.x = __builtin_amdgcn_exp2f(s.x); e.y = __builtin_amdgcn_exp2f(s.y);
    const f32x2 m = v * (q * e), r = v - m;
    f32x2 o; o.x = v.x < 0.f ? m.x : r.x; o.y = v.y < 0.f ? m.y : r.y; return o;
}

template <int ACT  > struct EpiBf16 {
    static constexpr bool PERM = true, AFTER_DRAIN = false; static_assert(ACT == 0 || ACT == 1, "EpiBf16: ACT is 0 (none) or 1 (gelu_pk)");
    bf16_t* O; int ldc; const float* bias; int split_cols; size_t split_stride; float scale0;
    __device__ __forceinline__ void operator()(const f32x4 (&acc)[2][2][4][2], const Unit& u, int wr, int wc, int fr, int fq) const {
        const int row0 = u.pm * BM + wr * 64 + fr; int colt = u.pn * BM; bf16_t* base = O;
        float sc = 1.f; if (split_cols) { const int t = colt / split_cols; base += (size_t)t * split_stride; colt -= t * split_cols; if (t == 0) sc = scale0; }
        const int col0 = colt + wc * 32 + 8 * fq, bcol0 = u.pn * BM + wc * 32 + 8 * fq;
        f32x4 bv[2][2];
#pragma unroll
        for (int bj = 0; bj < 2; ++bj)
#pragma unroll
            for (int n = 0; n < 2; ++n) bv[bj][n] = bias ? *(const f32x4*)(bias + bcol0 + bj * HALF + 4 * n) : (f32x4){0.f, 0.f, 0.f, 0.f};
#pragma unroll
        for (int ai = 0; ai < 2; ++ai)
#pragma unroll
            for (int m = 0; m < 4; ++m) { bf16_t* rowp = base + (size_t)(row0 + ai * HALF + m * 16) * ldc + col0;
#pragma unroll
                for (int bj = 0; bj < 2; ++bj) { f32x4 v0 = acc[ai][bj][m][0] + bv[bj][0], v1 = acc[ai][bj][m][1] + bv[bj][1];
                    if (ACT == 1) { f32x2 a = gelu_pk((f32x2){v0[0], v0[1]}), b = gelu_pk((f32x2){v0[2], v0[3]}), c = gelu_pk((f32x2){v1[0], v1[1]}), d = gelu_pk((f32x2){v1[2], v1[3]});
                        v0 = (f32x4){a.x, a.y, b.x, b.y}; v1 = (f32x4){c.x, c.y, d.x, d.y}; }
                    v0 = v0 * sc; v1 = v1 * sc; u32x4 w; w.x = cvt_pk_bf16(v0[0], v0[1]); w.y = cvt_pk_bf16(v0[2], v0[3]); w.z = cvt_pk_bf16(v1[0], v1[1]); w.w = cvt_pk_bf16(v1[2], v1[3]);
                    *(u32x4*)(rowp + bj * HALF) = w; } }
    }
};

struct EpiResF32 {
    static constexpr bool PERM = true, AFTER_DRAIN = false;
    const float* base; float* out; int ldc;
    __device__ __forceinline__ void operator()(const f32x4 (&acc)[2][2][4][2], const Unit& u, int wr, int wc, int fr, int fq) const {
        const int row0 = u.pm * BM + wr * 64 + fr, col0 = u.pn * BM + wc * 32 + 8 * fq;
#pragma unroll
        for (int ai = 0; ai < 2; ++ai) {
            f32x4 pre[4][2][2];
#pragma unroll
            for (int m = 0; m < 4; ++m) { const size_t off = (size_t)(row0 + ai * HALF + m * 16) * ldc + col0;
#pragma unroll
                for (int bj = 0; bj < 2; ++bj) { pre[m][bj][0] = __builtin_nontemporal_load((const f32x4*)(base + off + bj * HALF)); pre[m][bj][1] = __builtin_nontemporal_load((const f32x4*)(base + off + bj * HALF + 4)); } }
#pragma unroll
            for (int m = 0; m < 4; ++m) { const size_t off = (size_t)(row0 + ai * HALF + m * 16) * ldc + col0;
#pragma unroll
                for (int bj = 0; bj < 2; ++bj) { __builtin_nontemporal_store(acc[ai][bj][m][0] + pre[m][bj][0], (f32x4*)(out + off + bj * HALF)); __builtin_nontemporal_store(acc[ai][bj][m][1] + pre[m][bj][1], (f32x4*)(out + off + bj * HALF + 4)); } }
        }
    }
};
template <class Epi, class Sched, bool ALIGN_EPI = false, bool SP2 = false>
__device__ __forceinline__ void gemm_phase(PG8_LAS unsigned char* lds, const Gemm g, const Sched& S, const Epi& E) {
    int tid = threadIdx.x; asm volatile("" : "+v"(tid));
    const int wid = __builtin_amdgcn_readfirstlane(tid >> 6), lane = tid & 63, wr = wid >> 2, wc = wid & 3, fr = lane & 15, fq = lane >> 4;
    const int K = g.K, nt = K / BK;
    unsigned voffA[2], voffB[2];
#pragma unroll
    for (int i = 0; i < 2; ++i) { int R, C; stage_rc(tid * 16 + i * 8192, R, C); const int Rb = Epi::PERM ? ((R & ~31) + perm32(R & 31)) : R;
        voffA[i] = (unsigned)(R * g.lda + C) * 2u; voffB[i] = (unsigned)(Rb * K + C) * 2u; }
    const size_t kstep = (size_t)(BK * 2);
    const size_t hstepA = (size_t)HALF * g.lda * 2, hstepB = (size_t)HALF * K * 2;
    const size_t tstepA = 2 * hstepA, tstepB = 2 * hstepB;
    const unsigned ldsw = (unsigned)wid * 1024u;
    const int aoff = lds_byte(wr * 64 + fr, fq * 8), boff = lds_byte(wc * 32 + fr, fq * 8);
#define PG8_SA(b, h) (((b) * 2 + (h)) * HTB)
#define PG8_SB(b, h) ((4 + (b) * 2 + (h)) * HTB)
#define PG8_STAGE(bufoff, gbase, voff) do { _Pragma("unroll") for (int _i = 0; _i < 2; ++_i) \
        __builtin_amdgcn_global_load_lds((const unsigned*)((const char*)(gbase) + (voff)[_i]), (PG8_LAS unsigned*)(lds + (bufoff) + ldsw + _i * 8192), 16, 0, 0); } while (0)
#define PG8_LDA(dst, b, h) do { _Pragma("unroll") for (int m = 0; m < 4; ++m) _Pragma("unroll") for (int k = 0; k < 2; ++k) dst[m][k] = *(const PG8_LAS bf16x8*)(lds + PG8_SA(b, h) + aoff + m * 2048 + k * 1024); } while (0)
#define PG8_LDB(dst, b, h) do { _Pragma("unroll") for (int n = 0; n < 2; ++n) _Pragma("unroll") for (int k = 0; k < 2; ++k) dst[n][k] = *(const PG8_LAS bf16x8*)(lds + PG8_SB(b, h) + boff + n * 2048 + k * 1024); } while (0)
#define PG8_MMA(ai, bj, At, Bt) do { __builtin_amdgcn_s_setprio(1); _Pragma("unroll") for (int m = 0; m < 4; ++m) _Pragma("unroll") for (int n = 0; n < 2; ++n) _Pragma("unroll") for (int k = 0; k < 2; ++k) \
        acc[ai][bj][m][n] = __builtin_amdgcn_mfma_f32_16x16x32_bf16(Bt[n][k], At[m][k], acc[ai][bj][m][n], 0, 0, 0); __builtin_amdgcn_s_setprio(0); } while (0)
#define PG8_WAIT_V(n) asm volatile("s_waitcnt vmcnt(" #n ")" ::: "memory")
#define PG8_WAIT_L(n) asm volatile("s_waitcnt lgkmcnt(" #n ")" ::: "memory")
#define PG8_BAR __builtin_amdgcn_s_barrier()
#define PG8_SCHED __builtin_amdgcn_sched_barrier(0)
    Unit cur, nxt; int ui = 0;
    if (!S.next(0, cur)) return;
    f32x4 acc[2][2][4][2];
#pragma unroll
    for (int a = 0; a < 2; ++a)
#pragma unroll
        for (int b = 0; b < 2; ++b)
#pragma unroll
            for (int m = 0; m < 4; ++m)
#pragma unroll
                for (int n = 0; n < 2; ++n) acc[a][b][m][n] = (f32x4){0.f, 0.f, 0.f, 0.f};
    bf16x8 At[4][2], B0[2][2], B1[2][2];
    const char* cA = (const char*)g.A + (size_t)cur.pm * tstepA; const char* cB = (const char*)g.Bt + (size_t)cur.pn * tstepB;
    S.a_ready(cur);
    if constexpr (SP2) {
        PG8_STAGE(PG8_SB(0, 0), cB, voffB); PG8_STAGE(PG8_SB(0, 1), cB + hstepB, voffB); PG8_STAGE(PG8_SA(0, 0), cA, voffA); PG8_STAGE(PG8_SA(0, 1), cA + hstepA, voffA);
        if (wr == 1) PG8_BAR;
        PG8_WAIT_V(2); PG8_BAR;
        PG8_STAGE(PG8_SB(1, 0), cB + kstep, voffB); PG8_STAGE(PG8_SA(1, 0), cA + kstep, voffA); PG8_STAGE(PG8_SB(1, 1), cB + hstepB + kstep, voffB);
        PG8_WAIT_V(6); PG8_BAR;
    } else {
        PG8_STAGE(PG8_SB(0, 0), cB, voffB); PG8_STAGE(PG8_SA(0, 0), cA, voffA); PG8_STAGE(PG8_SB(0, 1), cB + hstepB, voffB); PG8_STAGE(PG8_SA(0, 1), cA + hstepA, voffA);
        if (wr == 1) PG8_BAR;
        PG8_WAIT_V(4); PG8_BAR;
        PG8_STAGE(PG8_SB(1, 0), cB + kstep, voffB); PG8_STAGE(PG8_SA(1, 0), cA + kstep, voffA); PG8_STAGE(PG8_SB(1, 1), cB + hstepB + kstep, voffB);
        PG8_WAIT_V(6); PG8_BAR;
    }
    for (;;) {
        const bool has_next = S.next(ui + 1, nxt);
        const char* nA = has_next ? (const char*)g.A + (size_t)nxt.pm * tstepA : cA; const char* nB = has_next ? (const char*)g.Bt + (size_t)nxt.pn * tstepB : cB;
        for (int t = 0; t < nt; t += 2) {
            const bool last = (t == nt - 2);
            const char* a1 = cA + (size_t)(t + 1) * kstep;
            const char* a2 = last ? nA : cA + (size_t)(t + 2) * kstep; const char* b2 = last ? nB : cB + (size_t)(t + 2) * kstep;
            const char* a3 = a2 + kstep; const char* b3 = b2 + kstep;
            if (last && has_next) S.a_ready(nxt);
            if constexpr (SP2) {
            PG8_LDB(B0, 0, 0); PG8_LDB(B1, 0, 1); PG8_SCHED; PG8_LDA(At, 0, 0); PG8_STAGE(PG8_SA(1, 1), a1 + hstepA, voffA);
            PG8_WAIT_V(8); PG8_WAIT_L(0); PG8_BAR; PG8_MMA(0, 0, At, B0); PG8_MMA(0, 1, At, B1); PG8_BAR; PG8_SCHED;
            PG8_LDA(At, 0, 1); PG8_STAGE(PG8_SB(0, 0), b2, voffB); PG8_STAGE(PG8_SB(0, 1), b2 + hstepB, voffB); PG8_STAGE(PG8_SA(0, 0), a2, voffA);
            PG8_WAIT_V(8); PG8_WAIT_L(0); PG8_BAR; PG8_MMA(1, 0, At, B0); PG8_MMA(1, 1, At, B1); PG8_BAR; PG8_SCHED;
            PG8_LDB(B0, 1, 0); PG8_LDB(B1, 1, 1); PG8_SCHED; PG8_LDA(At, 1, 0); PG8_STAGE(PG8_SA(0, 1), a2 + hstepA, voffA);
            PG8_WAIT_V(8); PG8_WAIT_L(0); PG8_BAR; PG8_MMA(0, 0, At, B0); PG8_MMA(0, 1, At, B1); PG8_BAR; PG8_SCHED;
            PG8_LDA(At, 1, 1); PG8_STAGE(PG8_SB(1, 0), b3, voffB); PG8_STAGE(PG8_SB(1, 1), b3 + hstepB, voffB); PG8_STAGE(PG8_SA(1, 0), a3, voffA);
            PG8_WAIT_V(8); PG8_WAIT_L(0); PG8_BAR; PG8_MMA(1, 0, At, B0); PG8_MMA(1, 1, At, B1); PG8_BAR; PG8_SCHED;
            } else {
            PG8_LDB(B0, 0, 0); PG8_SCHED; PG8_LDA(At, 0, 0); PG8_STAGE(PG8_SA(1, 1), a1 + hstepA, voffA);
            PG8_WAIT_L(8); PG8_BAR; PG8_WAIT_L(0); PG8_MMA(0, 0, At, B0); PG8_BAR; PG8_SCHED;
            PG8_LDB(B1, 0, 1); PG8_STAGE(PG8_SB(0, 0), b2, voffB);
            PG8_BAR; PG8_WAIT_L(0); PG8_MMA(0, 1, At, B1); PG8_BAR;
            PG8_LDA(At, 0, 1); PG8_STAGE(PG8_SA(0, 0), a2, voffA);
            PG8_BAR; PG8_WAIT_L(0); PG8_MMA(1, 0, At, B0); PG8_BAR; PG8_SCHED;
            PG8_STAGE(PG8_SB(0, 1), b2 + hstepB, voffB);
            PG8_WAIT_V(6); PG8_BAR; PG8_MMA(1, 1, At, B1); PG8_BAR;
            PG8_LDB(B0, 1, 0); PG8_SCHED; PG8_LDA(At, 1, 0); PG8_STAGE(PG8_SA(0, 1), a2 + hstepA, voffA);
            PG8_WAIT_L(8); PG8_BAR; PG8_WAIT_L(0); PG8_MMA(0, 0, At, B0); PG8_BAR; PG8_SCHED;
            PG8_LDB(B1, 1, 1); PG8_STAGE(PG8_SB(1, 0), b3, voffB);
            PG8_BAR; PG8_WAIT_L(0); PG8_MMA(0, 1, At, B1); PG8_BAR;
            PG8_LDA(At, 1, 1); PG8_STAGE(PG8_SA(1, 0), a3, voffA);
            PG8_BAR; PG8_WAIT_L(0); PG8_MMA(1, 0, At, B0); PG8_BAR; PG8_SCHED;
            PG8_STAGE(PG8_SB(1, 1), b3 + hstepB, voffB);
            PG8_WAIT_V(6); PG8_BAR; PG8_MMA(1, 1, At, B1); PG8_BAR;
            }
        }
        if constexpr (ALIGN_EPI) { if (wr == 0) PG8_BAR; }
        if constexpr (!Epi::AFTER_DRAIN) { E(acc, cur, wr, wc, fr, fq); S.done(cur); }
        if (!has_next) break;
#pragma unroll
        for (int a = 0; a < 2; ++a)
#pragma unroll
            for (int b = 0; b < 2; ++b)
#pragma unroll
                for (int m = 0; m < 4; ++m)
#pragma unroll
                    for (int n = 0; n < 2; ++n) acc[a][b][m][n] = (f32x4){0.f, 0.f, 0.f, 0.f};
        cur = nxt; cA = nA; cB = nB; ++ui;
        if constexpr (ALIGN_EPI) { if (wr == 1) PG8_BAR; }
    }
    PG8_WAIT_V(0);
    if constexpr (!ALIGN_EPI) { if (wr == 0) PG8_BAR; }
    PG8_BAR;
    if constexpr (Epi::AFTER_DRAIN) { E.fused(acc, cur, wr, wc, fr, fq, lds, wid, lane); S.done(cur); }
#undef PG8_SA
#undef PG8_SB
#undef PG8_STAGE
#undef PG8_LDA
#undef PG8_LDB
#undef PG8_MMA
#undef PG8_WAIT_V
#undef PG8_WAIT_L
#undef PG8_BAR
#undef PG8_SCHED
}
}
#ifndef PG8_SP2
#define PG8_SP2 true
#endif
#ifndef PG8_ALIGN
#define PG8_ALIGN true
#endif
#ifndef MK_N_LAUNCHES
#define MK_N_LAUNCHES 1
#endif
#ifndef PROBE_PHASE
#define PROBE_PHASE -1
#endif
#ifndef DUP_PHASE
#define DUP_PHASE -1
#endif
#ifndef FAST_MLA
#define FAST_MLA 1
#endif
#ifndef FAST_DIL
#define FAST_DIL 1
#endif

constexpr int NBATCH = 4, SEQ = 4096, DM = 2048, TOK = NBATCH * SEQ;
constexpr int NC = 6464, NCP = 6656;
constexpr int C_CQ = 0, C_CKV = 768, C_QB = 1280, C_KB = 2304, C_VB = 3328, C_GA = 4352, C_GB = 5376, C_KR = 6400;
constexpr int QA_W = 1536, KVA_W = 2048;
constexpr float EPS = 1e-6f;
constexpr float LOG2E = 1.4426950408889634f, LN2 = 0.6931471805599453f;
constexpr float QSCALE_MLA = 0.07216878364870322f * LOG2E;
constexpr float QSCALE_DIL = 0.08838834764831845f * LOG2E;
constexpr int NPH = 8;

constexpr size_t MiB = 1u << 20;
constexpr size_t WS_GAINS = 3 * MiB + 196608;
constexpr size_t WS_SSQ = 3 * MiB + 65536;
constexpr size_t WS_TAB128 = 0, WS_TAB64 = 2 * MiB, WS_CTL = 3 * MiB, CTL_BYTES = 16384;
constexpr size_t WS_WIN = 4 * MiB, WS_WUQ = 30 * MiB, WS_WUKV = 33 * MiB, WS_WOUT = 35 * MiB;
constexpr size_t WS_PROJ = 44 * MiB;
constexpr size_t WS_HN = 252 * MiB;
constexpr size_t WS_OA = 252 * MiB, WS_OD1 = 284 * MiB;
constexpr size_t WS_QA = 316 * MiB;
constexpr size_t WS_KVA = 364 * MiB;
constexpr size_t WS_OD2 = 428 * MiB, WS_OD3 = 460 * MiB;
constexpr size_t WS_LSE = 492 * MiB;
constexpr size_t WS_Y = 316 * MiB;
constexpr size_t WS_END = 494 * MiB;
constexpr int LDS_BYTES = 143360, XCH_OFF = 131072;

#define LAS __attribute__((address_space(3)))
#define DI __device__ __forceinline__
typedef unsigned short bf16_t;
typedef unsigned u32x4 __attribute__((ext_vector_type(4)));
typedef unsigned u32x2 __attribute__((ext_vector_type(2)));
typedef float f32x4 __attribute__((ext_vector_type(4)));
typedef float f32x2 __attribute__((ext_vector_type(2)));

struct Params { const float* in[14]; float* out; unsigned char* ws; int ph_lo, ph_hi; };

DI float bflo(unsigned w) { return __uint_as_float(w << 16); }
DI float bfhi(unsigned w) { return __uint_as_float(w & 0xffff0000u); }
DI unsigned pk2(float lo, float hi) { return pg8::cvt_pk_bf16(lo, hi); }
DI void unpack8(const u32x4 v, f32x4& a, f32x4& b) { a = (f32x4){bflo(v.x), bfhi(v.x), bflo(v.y), bfhi(v.y)}; b = (f32x4){bflo(v.z), bfhi(v.z), bflo(v.w), bfhi(v.w)}; }
DI u32x4 pack8(const f32x4 a, const f32x4 b) { u32x4 r; r.x = pk2(a.x, a.y); r.y = pk2(a.z, a.w); r.z = pk2(b.x, b.y); r.w = pk2(b.z, b.w); return r; }
DI float sumsq8(const f32x4 a, const f32x4 b) { return (a.x * a.x + a.y * a.y) + (a.z * a.z + a.w * a.w) + (b.x * b.x + b.y * b.y) + (b.z * b.z + b.w * b.w); }
DI float wave_sum(float v) {
#pragma unroll
    for (int o = 1; o < 64; o <<= 1) v += __shfl_xor(v, o);
    return v; }
DI float wave_max(float v) {
#pragma unroll
    for (int o = 1; o < 64; o <<= 1) v = fmaxf(v, __shfl_xor(v, o));
    return v; }
DI float grp_sum8(float v) { v += __shfl_xor(v, 1); v += __shfl_xor(v, 2); v += __shfl_xor(v, 4); return v; }
DI float grp_sum16(float v) { v = grp_sum8(v); v += __shfl_xor(v, 8); return v; }
DI float rstd_of(float ss, float inv_n) { return 1.0f / sqrtf(ss * inv_n + EPS); }
DI float silu(float x) { return x / (1.0f + __expf(-x)); }
DI f32x4 silu4(f32x4 x) { return (f32x4){silu(x.x), silu(x.y), silu(x.z), silu(x.w)}; }
DI void rope8(f32x4& a, f32x4& b, int xr, bool first, const f32x4* tab) {
    f32x4 pa, pb;
    pa.x = __shfl_xor(a.x, xr); pa.y = __shfl_xor(a.y, xr); pa.z = __shfl_xor(a.z, xr); pa.w = __shfl_xor(a.w, xr);
    pb.x = __shfl_xor(b.x, xr); pb.y = __shfl_xor(b.y, xr); pb.z = __shfl_xor(b.z, xr); pb.w = __shfl_xor(b.w, xr);
    const float sg = first ? -1.f : 1.f;
    const f32x4 t0 = tab[0], t1 = tab[1], t2 = tab[2], t3 = tab[3];
    a.x = a.x * t0.x + sg * pa.x * t0.y; a.y = a.y * t0.z + sg * pa.y * t0.w; a.z = a.z * t1.x + sg * pa.z * t1.y; a.w = a.w * t1.z + sg * pa.w * t1.w;
    b.x = b.x * t2.x + sg * pb.x * t2.y; b.y = b.y * t2.z + sg * pb.y * t2.w; b.z = b.z * t3.x + sg * pb.z * t3.y; b.w = b.w * t3.z + sg * pb.w * t3.w;
}

namespace pg8 {
struct EpiProj {
    static constexpr bool PERM = true, AFTER_DRAIN = false;
    bf16_t* O; float* ssq; const float* gains; const f32x4* tab; LAS float* xch;
    __device__ __forceinline__ void operator()(const f32x4 (&acc)[2][2][4][2], const Unit& u, int wr, int wc, int fr, int fq) const {
        const int pn = u.pn, row0 = u.pm * BM + wr * 64 + fr, col0 = pn * BM + wc * 32 + 8 * fq;
        const bool kr = pn == 25;
        if ((pn >= 5 && pn < 13) || kr) {
#pragma unroll
            for (int ai = 0; ai < 2; ++ai)
#pragma unroll
                for (int m = 0; m < 4; ++m)
#pragma unroll
                    for (int bj = 0; bj < 2; ++bj) {
                        const f32x4 a = acc[ai][bj][m][0], c = acc[ai][bj][m][1];
                        float s = (a.x * a.x + a.y * a.y) + (a.z * a.z + a.w * a.w) + (c.x * c.x + c.y * c.y) + (c.z * c.z + c.w * c.w);
                        s += __shfl_xor(s, 16); s += __shfl_xor(s, 32);
                        if (fq == 0) xch[((ai * HALF + wr * 64 + m * 16 + fr) * 2 + bj) * 4 + wc] = s;
                    }
            asm volatile("s_waitcnt lgkmcnt(0)" ::: "memory"); __builtin_amdgcn_s_barrier(); asm volatile("" ::: "memory");
            const int lg = kr ? 4 * (wc & 1) + fq : 4 * wc + fq;
            const int goff = kr ? 256 : (pn < 9 ? 0 : 128);
            const f32x4 g0 = *(const f32x4*)(gains + goff + 4 * lg), g1 = *(const f32x4*)(gains + goff + (kr ? 32 : 64) + 4 * lg);
            const float scale = (pn < 9) ? QSCALE_DIL : 1.0f, inv_n = kr ? (1.0f / 64.0f) : (1.0f / 128.0f);
            if (!kr || wc < 2) {
#pragma unroll
            for (int ai = 0; ai < 2; ++ai)
#pragma unroll
                for (int m = 0; m < 4; ++m) {
                    const int row = row0 + ai * HALF + m * 16, t = row & (SEQ - 1);
                    const int ti = kr ? (int)(WS_TAB64 / 16) + (t * 32 + 4 * lg) / 2 : (t * 64 + 4 * lg) / 2;
                    const f32x4 tA = tab[ti], tB = tab[ti + 1];
#pragma unroll
                    for (int bj = 0; bj < 2; ++bj) {
                        if (kr && bj == 1) continue;
                        const f32x4 ps = *(const LAS f32x4*)(xch + ((ai * HALF + wr * 64 + m * 16 + fr) * 2 + bj) * 4);
                        const float tot = kr ? ps.x + ps.y : (ps.x + ps.y) + (ps.z + ps.w);
                        const float rstd = 1.0f / sqrtf(tot * inv_n + EPS);
                        const f32x4 x1 = acc[ai][bj][m][0] * rstd * g0, x2 = acc[ai][bj][m][1] * rstd * g1;
                        f32x4 o1, o2;
                        o1.x = x1.x * tA.x - x2.x * tA.y; o2.x = x2.x * tA.x + x1.x * tA.y;
                        o1.y = x1.y * tA.z - x2.y * tA.w; o2.y = x2.y * tA.z + x1.y * tA.w;
                        o1.z = x1.z * tB.x - x2.z * tB.y; o2.z = x2.z * tB.x + x1.z * tB.y;
                        o1.w = x1.w * tB.z - x2.w * tB.w; o2.w = x2.w * tB.z + x1.w * tB.w;
                        o1 = o1 * scale; o2 = o2 * scale;
                        u32x4 w; w.x = cvt_pk_bf16(o1.x, o1.y); w.y = cvt_pk_bf16(o1.z, o1.w); w.z = cvt_pk_bf16(o2.x, o2.y); w.w = cvt_pk_bf16(o2.z, o2.w);
                        *(u32x4*)(O + (size_t)row * NCP + col0 + bj * HALF) = w;
                    }
                }
            }
        } else {
            float* sq = ssq + (pn < 3 ? 0 : TOK);
#pragma unroll
            for (int ai = 0; ai < 2; ++ai)
#pragma unroll
                for (int m = 0; m < 4; ++m) {
                    const int row = row0 + ai * HALF + m * 16;
                    bf16_t* rowp = O + (size_t)row * NCP + col0;
                    float s = 0.f;
#pragma unroll
                    for (int bj = 0; bj < 2; ++bj) {
                        const f32x4 v0 = acc[ai][bj][m][0], v1 = acc[ai][bj][m][1];
                        s += (v0.x * v0.x + v0.y * v0.y) + (v0.z * v0.z + v0.w * v0.w) + (v1.x * v1.x + v1.y * v1.y) + (v1.z * v1.z + v1.w * v1.w);
                        u32x4 w; w.x = cvt_pk_bf16(v0.x, v0.y); w.y = cvt_pk_bf16(v0.z, v0.w); w.z = cvt_pk_bf16(v1.x, v1.y); w.w = cvt_pk_bf16(v1.z, v1.w);
                        *(u32x4*)(rowp + bj * HALF) = w;
                    }
                    if (pn < 5) { s += __shfl_xor(s, 16); s += __shfl_xor(s, 32); if (fq == 0) atomicAdd(sq + row, s); }
                }
        }
    }
};
struct EpiRowScale {
    static constexpr bool PERM = true, AFTER_DRAIN = false;
    bf16_t* O; int ldc; const float* ssq; float inv_n;
    __device__ __forceinline__ void operator()(const f32x4 (&acc)[2][2][4][2], const Unit& u, int wr, int wc, int fr, int fq) const {
        const int row0 = u.pm * BM + wr * 64 + fr, col0 = u.pn * BM + wc * 32 + 8 * fq;
#pragma unroll
        for (int ai = 0; ai < 2; ++ai)
#pragma unroll
            for (int m = 0; m < 4; ++m) {
                const int row = row0 + ai * HALF + m * 16;
                const float rstd = 1.0f / sqrtf(ssq[row] * inv_n + EPS);
                bf16_t* rowp = O + (size_t)row * ldc + col0;
#pragma unroll
                for (int bj = 0; bj < 2; ++bj) {
                    const f32x4 v0 = acc[ai][bj][m][0] * rstd, v1 = acc[ai][bj][m][1] * rstd;
                    u32x4 w; w.x = cvt_pk_bf16(v0.x, v0.y); w.y = cvt_pk_bf16(v0.z, v0.w); w.z = cvt_pk_bf16(v1.x, v1.y); w.w = cvt_pk_bf16(v1.z, v1.w);
                    *(u32x4*)(rowp + bj * HALF) = w;
                }
            }
    }
};
template <int MODE> struct EpiUp {
    static constexpr bool PERM = true, AFTER_DRAIN = false;
    bf16_t* O; int ldc; const float* ssq; float inv_k; const float* gain; const f32x4* tab64; LAS float* xch;
    __device__ __forceinline__ void operator()(const f32x4 (&acc)[2][2][4][2], const Unit& u, int wr, int wc, int fr, int fq) const {
        const int pn = u.pn, row0 = u.pm * BM + wr * 64 + fr, col0 = pn * BM + wc * 32 + 8 * fq;
        const bool ropet = (MODE == 0) && pn >= 4;
        float rs[2][4];
#pragma unroll
        for (int ai = 0; ai < 2; ++ai)
#pragma unroll
            for (int m = 0; m < 4; ++m) rs[ai][m] = 1.0f / sqrtf(ssq[row0 + ai * HALF + m * 16] * inv_k + EPS);
#pragma unroll
        for (int ai = 0; ai < 2; ++ai)
#pragma unroll
            for (int m = 0; m < 4; ++m)
#pragma unroll
                for (int bj = 0; bj < (MODE == 1 ? 1 : 2); ++bj) {
                    const f32x4 a = acc[ai][bj][m][0] * rs[ai][m], c = acc[ai][bj][m][1] * rs[ai][m];
                    float s = (a.x * a.x + a.y * a.y) + (a.z * a.z + a.w * a.w) + (c.x * c.x + c.y * c.y) + (c.z * c.z + c.w * c.w);
                    s += __shfl_xor(s, 16); s += __shfl_xor(s, 32);
                    if (fq == 0) xch[((ai * HALF + wr * 64 + m * 16 + fr) * 2 + bj) * 4 + wc] = s;
                }
        asm volatile("s_waitcnt lgkmcnt(0)" ::: "memory"); __builtin_amdgcn_s_barrier(); asm volatile("" ::: "memory");
        const int lg = 4 * (wc & 1) + fq;
        const int goff = ropet ? 128 + 4 * lg : 32 * wc + 8 * fq;
        const f32x4 g0 = *(const f32x4*)(gain + goff), g1 = *(const f32x4*)(gain + goff + (ropet ? 32 : 4));
        const float osc = MODE == 0 ? QSCALE_MLA : 1.0f, inv_n = ropet ? (1.0f / 64.0f) : (1.0f / 128.0f);
#pragma unroll
        for (int ai = 0; ai < 2; ++ai)
#pragma unroll
            for (int m = 0; m < 4; ++m) {
                const int row = row0 + ai * HALF + m * 16, t = row & (SEQ - 1);
                f32x4 tA = (f32x4){1.f, 0.f, 1.f, 0.f}, tB = tA;
                if (ropet) { const int ti = (t * 32 + 4 * lg) / 2; tA = tab64[ti]; tB = tab64[ti + 1]; }
                bf16_t* rowp = O + (size_t)row * ldc + col0;
#pragma unroll
                for (int bj = 0; bj < 2; ++bj) {
                    f32x4 o1, o2;
                    if (MODE == 1 && bj == 1) { o1 = acc[ai][bj][m][0] * rs[ai][m]; o2 = acc[ai][bj][m][1] * rs[ai][m]; }
                    else {
                        const f32x4 ps = *(const LAS f32x4*)(xch + ((ai * HALF + wr * 64 + m * 16 + fr) * 2 + bj) * 4);
                        const float tot = ropet ? ((wc & 2) ? ps.z + ps.w : ps.x + ps.y) : (ps.x + ps.y) + (ps.z + ps.w);
                        const float sc = rs[ai][m] * (1.0f / sqrtf(tot * inv_n + EPS)) * osc;
                        const f32x4 x1 = acc[ai][bj][m][0] * sc * g0, x2 = acc[ai][bj][m][1] * sc * g1;
                        if (ropet) {
                            o1.x = x1.x * tA.x - x2.x * tA.y; o2.x = x2.x * tA.x + x1.x * tA.y;
                            o1.y = x1.y * tA.z - x2.y * tA.w; o2.y = x2.y * tA.z + x1.y * tA.w;
                            o1.z = x1.z * tB.x - x2.z * tB.y; o2.z = x2.z * tB.x + x1.z * tB.y;
                            o1.w = x1.w * tB.z - x2.w * tB.w; o2.w = x2.w * tB.z + x1.w * tB.w;
                        } else { o1 = x1; o2 = x2; }
                    }
                    u32x4 w; w.x = cvt_pk_bf16(o1.x, o1.y); w.y = cvt_pk_bf16(o1.z, o1.w); w.z = cvt_pk_bf16(o2.x, o2.y); w.w = cvt_pk_bf16(o2.z, o2.w);
                    *(u32x4*)(rowp + bj * HALF) = w;
                }
            }
    }
};
}

DI int perm_half(int i, int half) { return i < half ? 8 * (i >> 2) + (i & 3) : 8 * ((i - half) >> 2) + 4 + (i & 3); }
DI int phys_in(int c) {
    if (c < 1280) return c;
    if (c < 1344) return C_KR + perm_half(c - 1280, 32);
    if (c < 2368) return C_GA + (c - 1344);
    if (c < 4416) { const int i0 = c - 2368; return C_QB + (i0 & ~127) + perm_half(i0 & 127, 64); }
    if (c < 5440) return C_VB + (c - 4416);
    return C_GB + (c - 5440);
}
DI int phys_uq(int c) { const int h = c / 192, i = c - 192 * h; return i < 128 ? 128 * h + i : 1024 + 64 * h + perm_half(i - 128, 32); }
template <int MODE>
DI void p0_transpose_item(const float* W, int K, int N, bf16_t* WT, LAS float* scr, int item, int lane, const float* gain) {
    const int nblk = N / 32, kb = item / nblk, nb = item % nblk, k0 = 64 * kb, n0 = 32 * nb;
    f32x4 wv[8];
#pragma unroll
    for (int i = 0; i < 8; ++i) wv[i] = *(const f32x4*)(W + (size_t)(k0 + 8 * i + (lane >> 3)) * N + n0 + 4 * (lane & 7));
#pragma unroll
    for (int i = 0; i < 8; ++i) { LAS float* d = scr + (8 * i + (lane >> 3)) * 33 + 4 * (lane & 7); d[0] = wv[i].x; d[1] = wv[i].y; d[2] = wv[i].z; d[3] = wv[i].w; }
    asm volatile("s_waitcnt lgkmcnt(0)" ::: "memory");
    const int c = lane & 7;
#pragma unroll
    for (int j = 0; j < 4; ++j) { const int n = (lane >> 3) + 8 * j; const LAS float* s = scr + (8 * c) * 33 + n;
        f32x4 ga = (f32x4){1.f, 1.f, 1.f, 1.f}, gb = ga;
        if (gain) { ga = *(const f32x4*)(gain + k0 + 8 * c); gb = *(const f32x4*)(gain + k0 + 8 * c + 4); }
        u32x4 o; o.x = pk2(s[0 * 33] * ga.x, s[1 * 33] * ga.y); o.y = pk2(s[2 * 33] * ga.z, s[3 * 33] * ga.w); o.z = pk2(s[4 * 33] * gb.x, s[5 * 33] * gb.y); o.w = pk2(s[6 * 33] * gb.z, s[7 * 33] * gb.w);
        const int nr = MODE == 1 ? phys_in(n0 + n) : (MODE == 2 ? phys_uq(n0 + n) : n0 + n);
        *(u32x4*)(WT + (size_t)nr * K + k0 + 8 * c) = o; }
    asm volatile("s_waitcnt lgkmcnt(0)" ::: "memory");
}
DI void phase0(const Params& p, LAS unsigned char* lds, int gw, int NGW, int lane, int wave, int part) {
    unsigned char* ws = p.ws;
    LAS float* scr = (LAS float*)(lds + wave * 16384);
    constexpr int I_IN = (DM / 64) * (NC / 32), I_UQ = (768 / 64) * (QA_W / 32), I_UKV = (512 / 64) * (KVA_W / 32), I_OUT = (DM / 64) * (DM / 32);
    constexpr int NITEMS = I_IN + I_UQ + I_UKV + I_OUT;
    const int it_lo = part == 0 ? 0 : I_IN, it_hi = part == 0 ? I_IN : NITEMS;
    for (int it = it_lo + gw; it < it_hi; it += NGW) {
        int r = it;
        if (r < I_IN) { p0_transpose_item<1>(p.in[2], DM, NC, (bf16_t*)(ws + WS_WIN), scr, r, lane, nullptr); continue; } r -= I_IN;
        if (r < I_UQ) { p0_transpose_item<2>(p.in[5], 768, QA_W, (bf16_t*)(ws + WS_WUQ), scr, r, lane, p.in[3]); continue; } r -= I_UQ;
        if (r < I_UKV) { p0_transpose_item<0>(p.in[6], 512, KVA_W, (bf16_t*)(ws + WS_WUKV), scr, r, lane, p.in[4]); continue; } r -= I_UKV;
        p0_transpose_item<0>(p.in[13], DM, DM, (bf16_t*)(ws + WS_WOUT), scr, r, lane, nullptr);
    }
    if (part == 1) return;
    const int gt = gw * 64 + lane, NGT = NGW * 64;
    for (int i = gt; i < 2 * TOK; i += NGT) ((float*)(ws + WS_SSQ))[i] = 0.f;
    if (gt < 320) ((float*)(ws + WS_GAINS))[gt] = gt < 128 ? p.in[9][gt] : (gt < 256 ? p.in[10][gt - 128] : p.in[8][128 + gt - 256]);
    {
        u32x4* z = (u32x4*)((bf16_t*)(ws + WS_WIN) + (size_t)NC * DM);
        for (int i = gt; i < (NCP - NC) * DM / 8; i += NGT) z[i] = (u32x4){0u, 0u, 0u, 0u};
    }
    for (int i = gt; i < SEQ * 96; i += NGT) {
        int s, j; float e; f32x2* dst;
        if (i < SEQ * 64) { s = i >> 6; j = i & 63; e = (float)(2 * j) * (1.0f / 128.0f); dst = (f32x2*)(ws + WS_TAB128) + i; }
        else { const int k = i - SEQ * 64; s = k >> 5; j = k & 31; e = (float)(2 * j) * (1.0f / 64.0f); dst = (f32x2*)(ws + WS_TAB64) + k; }
        const float inv = __builtin_amdgcn_exp2f(-e * 13.287712379549449f);
        const float ang = (float)s * inv;
        const double rev = (double)ang * 0.15915494309189535;
        const float fr = (float)(rev - rint(rev));
        *dst = (f32x2){__builtin_amdgcn_cosf(fr), __builtin_amdgcn_sinf(fr)};
    }
    const f32x4* g4 = (const f32x4*)p.in[1];
    for (int m = gw; m < TOK; m += NGW) {
        const f32x4* xr = (const f32x4*)(p.in[0] + (size_t)m * DM) + lane;
        f32x4 v[8]; float ss = 0.f;
#pragma unroll
        for (int j = 0; j < 8; ++j) { v[j] = __builtin_nontemporal_load(xr + 64 * j); ss += (v[j].x * v[j].x + v[j].y * v[j].y) + (v[j].z * v[j].z + v[j].w * v[j].w); }
        const float rstd = rstd_of(wave_sum(ss), 1.0f / DM);
        u32x2* o8 = (u32x2*)((bf16_t*)(ws + WS_HN) + (size_t)m * DM) + lane;
#pragma unroll
        for (int j = 0; j < 8; ++j) { const f32x4 g = g4[64 * j + lane]; const f32x4 y = v[j] * rstd * g; o8[64 * j] = (u32x2){pk2(y.x, y.y), pk2(y.z, y.w)}; }
    }
}

DI void e1_row(const Params& p, int row, int lane, bool dry) {
    unsigned char* ws = p.ws;
    const int t = row & (SEQ - 1);
    u32x4* r16 = (u32x4*)((bf16_t*)(ws + WS_PROJ) + (size_t)row * NCP);
    const int c8 = lane & 7, c16 = lane & 15;
    const u32x4 vq0 = r16[lane], vq1 = lane < 32 ? r16[64 + lane] : (u32x4){0u, 0u, 0u, 0u};
    const u32x4 vkv = r16[96 + lane], vkr = r16[160 + c8];
    u32x4 vh[4];
#pragma unroll
    for (int it = 0; it < 4; ++it) vh[it] = r16[(C_QB / 8) + it * 64 + lane];
    const f32x4* tb64 = (const f32x4*)(ws + WS_TAB64) + (t * 32 + (c8 & 3) * 8) / 2;
    const f32x4* tb128 = (const f32x4*)(ws + WS_TAB128) + (t * 64 + (c16 & 7) * 8) / 2;
    if (dry) return;
    {
        f32x4 a0, b0, a1, b1; unpack8(vq0, a0, b0); unpack8(vq1, a1, b1);
        const float rstd = rstd_of(wave_sum(sumsq8(a0, b0) + sumsq8(a1, b1)), 1.0f / 768.0f);
        const f32x4* g = (const f32x4*)p.in[3];
        r16[lane] = pack8(a0 * rstd * g[2 * lane], b0 * rstd * g[2 * lane + 1]);
        if (lane < 32) r16[64 + lane] = pack8(a1 * rstd * g[2 * (64 + lane)], b1 * rstd * g[2 * (64 + lane) + 1]);
    }
    {
        f32x4 a, b; unpack8(vkv, a, b);
        const float rstd = rstd_of(wave_sum(sumsq8(a, b)), 1.0f / 512.0f);
        const f32x4* g = (const f32x4*)p.in[4];
        r16[96 + lane] = pack8(a * rstd * g[2 * lane], b * rstd * g[2 * lane + 1]);
    }
    {
        f32x4 a, b; unpack8(vkr, a, b);
        const float rstd = rstd_of(grp_sum8(sumsq8(a, b)), 1.0f / 64.0f);
        const f32x4* g = (const f32x4*)p.in[8] + 32;
        a = a * rstd * g[2 * c8]; b = b * rstd * g[2 * c8 + 1];
        rope8(a, b, 4, c8 < 4, tb64);
        if (lane < 8) r16[160 + c8] = pack8(a, b);
    }
#pragma unroll
    for (int it = 0; it < 4; ++it) {
        f32x4 a, b; unpack8(vh[it], a, b);
        const float rstd = rstd_of(grp_sum16(sumsq8(a, b)), 1.0f / 128.0f);
        const f32x4* g = (const f32x4*)(it < 2 ? p.in[9] : p.in[10]);
        a = a * rstd * g[2 * c16]; b = b * rstd * g[2 * c16 + 1];
        rope8(a, b, 8, c16 < 8, tb128);
        if (it < 2) { a = a * QSCALE_DIL; b = b * QSCALE_DIL; }
        r16[(C_QB / 8) + it * 64 + lane] = pack8(a, b);
    }
}

DI void e2_row(const Params& p, int row, int lane, bool dry) {
    unsigned char* ws = p.ws;
    const int t = row & (SEQ - 1);
    u32x4* q16 = (u32x4*)((bf16_t*)(ws + WS_QA) + (size_t)row * QA_W);
    u32x4* kv16 = (u32x4*)((bf16_t*)(ws + WS_KVA) + (size_t)row * KVA_W);
    const f32x4* gq = (const f32x4*)p.in[7];
    const f32x4* gk = (const f32x4*)p.in[8];
    u32x4* pq[2]; u32x4* pk[2]; u32x4 vq[2], vk[2];
#pragma unroll
    for (int it = 0; it < 2; ++it) { const int idx = it * 64 + lane, h = idx >> 4, c = idx & 15; pq[it] = q16 + h * 24 + c; pk[it] = kv16 + h * 32 + c; vq[it] = *pq[it]; vk[it] = *pk[it]; }
    const int hr = lane >> 3, cr = lane & 7;
    u32x4* pr = q16 + hr * 24 + 16 + cr; const u32x4 vr = *pr;
    const f32x4* tb64 = (const f32x4*)(ws + WS_TAB64) + (t * 32 + (cr & 3) * 8) / 2;
    if (dry) return;
#pragma unroll
    for (int it = 0; it < 2; ++it) {
        const int c = lane & 15;
        f32x4 a, b; unpack8(vq[it], a, b);
        const float rstd = rstd_of(grp_sum16(sumsq8(a, b)), 1.0f / 128.0f) * QSCALE_MLA;
        *pq[it] = pack8(a * rstd * gq[2 * c], b * rstd * gq[2 * c + 1]);
    }
    {
        f32x4 a, b; unpack8(vr, a, b);
        const float rstd = rstd_of(grp_sum8(sumsq8(a, b)), 1.0f / 64.0f);
        a = a * rstd * gq[32 + 2 * cr]; b = b * rstd * gq[32 + 2 * cr + 1];
        rope8(a, b, 4, cr < 4, tb64);
        f32x4 xa, xb;
        xa.x = __shfl_xor(a.x, 4); xa.y = __shfl_xor(a.y, 4); xa.z = __shfl_xor(a.z, 4); xa.w = __shfl_xor(a.w, 4);
        xb.x = __shfl_xor(b.x, 4); xb.y = __shfl_xor(b.y, 4); xb.z = __shfl_xor(b.z, 4); xb.w = __shfl_xor(b.w, 4);
        u32x4* prp = q16 + hr * 24 + 16 + (cr < 4 ? 2 * cr : 2 * (cr - 4) + 1);
        *prp = cr < 4 ? pack8(a * QSCALE_MLA, xa * QSCALE_MLA) : pack8(xb * QSCALE_MLA, b * QSCALE_MLA);
    }
#pragma unroll
    for (int it = 0; it < 2; ++it) {
        const int c = lane & 15;
        f32x4 a, b; unpack8(vk[it], a, b);
        const float rstd = rstd_of(grp_sum16(sumsq8(a, b)), 1.0f / 128.0f);
        *pk[it] = pack8(a * rstd * gk[2 * c], b * rstd * gk[2 * c + 1]);
    }
}

DI void e3_row(const Params& p, int row, int lane) {
    unsigned char* ws = p.ws;
    const u32x4* r16 = (const u32x4*)((const bf16_t*)(ws + WS_PROJ) + (size_t)row * NCP);
    u32x4* y16 = (u32x4*)((bf16_t*)(ws + WS_Y) + (size_t)row * DM);
    {
        const u32x4* o16 = (const u32x4*)((const bf16_t*)(ws + WS_OA) + (size_t)row * 1024);
        f32x4 a0, b0, a1, b1; unpack8(o16[lane], a0, b0); unpack8(o16[64 + lane], a1, b1);
        const float rstd = rstd_of(wave_sum(sumsq8(a0, b0) + sumsq8(a1, b1)), 1.0f / 1024.0f);
        const f32x4* g = (const f32x4*)p.in[11];
        f32x4 ga0, gb0, ga1, gb1; unpack8(r16[C_GA / 8 + lane], ga0, gb0); unpack8(r16[C_GA / 8 + 64 + lane], ga1, gb1);
        y16[lane] = pack8(a0 * rstd * g[2 * lane] * silu4(ga0), b0 * rstd * g[2 * lane + 1] * silu4(gb0));
        y16[64 + lane] = pack8(a1 * rstd * g[2 * (64 + lane)] * silu4(ga1), b1 * rstd * g[2 * (64 + lane) + 1] * silu4(gb1));
    }
    {
        const float* lse = (const float*)(ws + WS_LSE);
        f32x4 oa[2], ob[2]; float ss = 0.f;
#pragma unroll
        for (int j = 0; j < 2; ++j) {
            const int cidx = j * 64 + lane, h = cidx >> 4;
            const float l0 = lse[(size_t)row * 8 + h], l1 = lse[(size_t)TOK * 8 + (size_t)row * 8 + h], l2 = lse[(size_t)2 * TOK * 8 + (size_t)row * 8 + h];
            const float mx = fmaxf(l0, fmaxf(l1, l2));
            float w0 = __expf(l0 - mx), w1 = __expf(l1 - mx), w2 = __expf(l2 - mx);
            const float inv = 1.0f / (w0 + w1 + w2); w0 *= inv; w1 *= inv; w2 *= inv;
            f32x4 a, b, c, d, e, f;
            unpack8(((const u32x4*)((const bf16_t*)(ws + WS_OD1) + (size_t)row * 1024))[cidx], a, b);
            unpack8(((const u32x4*)((const bf16_t*)(ws + WS_OD2) + (size_t)row * 1024))[cidx], c, d);
            unpack8(((const u32x4*)((const bf16_t*)(ws + WS_OD3) + (size_t)row * 1024))[cidx], e, f);
            oa[j] = a * w0 + c * w1 + e * w2; ob[j] = b * w0 + d * w1 + f * w2;
            ss += sumsq8(oa[j], ob[j]);
        }
        const float rstd = rstd_of(wave_sum(ss), 1.0f / 1024.0f);
        const f32x4* g = (const f32x4*)p.in[12];
#pragma unroll
        for (int j = 0; j < 2; ++j) {
            const int cidx = j * 64 + lane;
            f32x4 ga, gb; unpack8(r16[C_GB / 8 + cidx], ga, gb);
            y16[128 + cidx] = pack8(oa[j] * rstd * g[2 * cidx] * silu4(ga), ob[j] * rstd * g[2 * cidx + 1] * silu4(gb));
        }
    }
}

DI void naive_attn_row(const bf16_t* q, const bf16_t* k1, size_t k1s, const bf16_t* k2, size_t k2s, const bf16_t* v, size_t vs,
                       int t, int d, int nkeys, bf16_t* o, float* lse, LAS float* qs, int lane) {
    const int DK = k2 ? 192 : 128;
    for (int i = lane; i < DK; i += 64) qs[i] = __uint_as_float((unsigned)q[i] << 16);
    asm volatile("s_waitcnt lgkmcnt(0)" ::: "memory");
    float m = -1e30f, l = 0.f, o0 = 0.f, o1 = 0.f;
    for (int c0 = 0; c0 < nkeys; c0 += 64) {
        const int ik = c0 + lane; const bool valid = ik < nkeys; const int j = valid ? t - d * ik : t;
        float s = 0.f;
        const u32x4* kp = (const u32x4*)(k1 + (size_t)j * k1s);
#pragma unroll 4
        for (int ch = 0; ch < 16; ++ch) { f32x4 a, b; unpack8(kp[ch], a, b); const LAS f32x4* qq = (const LAS f32x4*)(qs + ch * 8); const f32x4 qa = qq[0], qb = qq[1];
            s += (a.x * qa.x + a.y * qa.y) + (a.z * qa.z + a.w * qa.w) + (b.x * qb.x + b.y * qb.y) + (b.z * qb.z + b.w * qb.w); }
        if (k2) { const u32x4* kp2 = (const u32x4*)(k2 + (size_t)j * k2s);
#pragma unroll 4
            for (int ch = 0; ch < 8; ++ch) { f32x4 a, b; unpack8(kp2[ch], a, b); const LAS f32x4* qq = (const LAS f32x4*)(qs + 128 + ch * 8); const f32x4 qa = qq[0], qb = qq[1];
                s += (a.x * qa.x + a.y * qa.y) + (a.z * qa.z + a.w * qa.w) + (b.x * qb.x + b.y * qb.y) + (b.z * qb.z + b.w * qb.w); } }
        s = valid ? s : -1e30f;
        const float mn = fmaxf(m, wave_max(s)); const float corr = exp2f(m - mn); const float pe = valid ? exp2f(s - mn) : 0.f;
        l = l * corr + wave_sum(pe); o0 *= corr; o1 *= corr; m = mn;
        const int cnt = min(64, nkeys - c0);
        for (int i = 0; i < cnt; ++i) { const float pi = __shfl(pe, i); const int jj = t - d * (c0 + i);
            const unsigned vv = *(const unsigned*)(v + (size_t)jj * vs + 2 * lane); o0 += pi * bflo(vv); o1 += pi * bfhi(vv); }
    }
    const float il = 1.0f / l;
    *(unsigned*)(o + 2 * lane) = pk2(o0 * il, o1 * il);
    if (lse && lane == 0) *lse = (m + log2f(l)) * LN2;
    asm volatile("s_waitcnt lgkmcnt(0)" ::: "memory");
}
DI void phase5_naive(const Params& p, LAS unsigned char* lds, int gw, int NGW, int lane, int wave, int type_lo, int type_hi) {
    unsigned char* ws = p.ws;
    LAS float* qs = (LAS float*)(lds + wave * 1024);
    const bf16_t* proj = (const bf16_t*)(ws + WS_PROJ); const bf16_t* qa = (const bf16_t*)(ws + WS_QA); const bf16_t* kva = (const bf16_t*)(ws + WS_KVA);
    for (int item = type_lo * TOK * 8 + gw; item < type_hi * TOK * 8; item += NGW) {
        const int type = item / (TOK * 8), rem = item % (TOK * 8), row = rem >> 3, h = rem & 7, b = row >> 12, t = row & (SEQ - 1);
        const size_t brow = (size_t)b * SEQ;
        if (type == 0) {
            naive_attn_row(qa + (size_t)row * QA_W + h * 192, kva + brow * KVA_W + h * 256, KVA_W, proj + brow * NCP + C_KR, NCP, kva + brow * KVA_W + h * 256 + 128, KVA_W,
                           t, 1, t + 1, (bf16_t*)(ws + WS_OA) + (size_t)row * 1024 + h * 128, nullptr, qs, lane);
        } else {
            const int pidx = type - 1, d = pidx == 0 ? 1 : (pidx == 1 ? 4 : 16);
            bf16_t* od = (bf16_t*)(ws + (pidx == 0 ? WS_OD1 : (pidx == 1 ? WS_OD2 : WS_OD3)));
            naive_attn_row(proj + (size_t)row * NCP + C_QB + h * 128, proj + brow * NCP + C_KB + h * 128, NCP, nullptr, 0, proj + brow * NCP + C_VB + h * 128, NCP,
                           t, d, min(t / d, 128) + 1, od + (size_t)row * 1024 + h * 128, (float*)(ws + WS_LSE) + (size_t)pidx * TOK * 8 + (size_t)row * 8 + h, qs, lane);
        }
    }
}

namespace fa {
typedef short bf16x8 __attribute__((ext_vector_type(8)));
typedef short s16x4 __attribute__((ext_vector_type(4)));
typedef float f32x16 __attribute__((ext_vector_type(16)));
#define FA_MFMA(a, b, c) __builtin_amdgcn_mfma_f32_32x32x16_bf16((a), (b), (c), 0, 0, 0)
struct Unit {
    const bf16_t* q; const bf16_t* q2; unsigned qs; const bf16_t* k1; unsigned k1s; const bf16_t* k2; unsigned k2s; const bf16_t* v; unsigned vs;
    bf16_t* o; unsigned os; float* lse; unsigned lses; int l0, kt_begin, W;
};
DI unsigned v_off(int row, int ch) { return 2048u * (row >> 3) + 512u * (ch >> 2) + 64u * (row & 7) + 16u * ((ch & 3) ^ ((row >> 2) & 3)); }

template <int DK>
DI void unit_run(const Unit& u, LAS unsigned char* lds, int tid, int lane, int wave) {
    constexpr int NKS = DK / 16;
    constexpr int K1BYTES = 64 * 256, K2BYTES = (DK == 192) ? 64 * 128 : 0, KBYTES = K1BYTES + K2BYTES, VBYTES = 64 * 256, STAGE = KBYTES + VBYTES;
    const int hi = lane >> 5, l31 = lane & 31;
    const int wq0 = u.l0 + 32 * wave, W = u.W;
    bf16x8 qf[NKS];
    {   const unsigned qo = (unsigned)(wq0 + l31) * u.qs + 8u * hi;
#pragma unroll
        for (int ks = 0; ks < NKS; ++ks) qf[ks] = ks < 8 ? *(const bf16x8*)(u.q + (qo + 16u * ks)) : *(const bf16x8*)(u.q2 + (qo + 16u * (ks - 8))); }
    const int ntiles = (u.l0 + 256 - u.kt_begin) >> 6;
#define FA_DMA(kt, st) do { LAS unsigned char* sb_ = lds + (st) * STAGE; \
        _Pragma("unroll") for (int n = 0; n < 2; ++n) { \
            { const int s = (2 * wave + n) * 64 + lane, row = s >> 4, cc = (s & 15) ^ (row & 15); \
              __builtin_amdgcn_global_load_lds((const unsigned*)(u.k1 + ((unsigned)((kt) + row) * u.k1s + 8u * cc)), (LAS unsigned*)(sb_ + (2 * wave + n) * 1024), 16, 0, 0); } \
            { const int s = (2 * wave + n) * 64 + lane, row = 8 * (s >> 7) + ((s >> 2) & 7), ch = 4 * ((s >> 5) & 3) + ((s & 3) ^ ((row >> 2) & 3)); \
              __builtin_amdgcn_global_load_lds((const unsigned*)(u.v + ((unsigned)((kt) + row) * u.vs + 8u * ch)), (LAS unsigned*)(sb_ + KBYTES + (2 * wave + n) * 1024), 16, 0, 0); } } \
        if (DK == 192) { const int s = wave * 64 + lane, row = s >> 3, cc = (s & 7) ^ ((row >> 1) & 7); \
            __builtin_amdgcn_global_load_lds((const unsigned*)(u.k2 + ((unsigned)((kt) + row) * u.k2s + 8u * cc)), (LAS unsigned*)(sb_ + K1BYTES + wave * 1024), 16, 0, 0); } } while (0)
    FA_DMA(u.kt_begin, 0);
    __syncthreads();
    f32x16 O[4];
#pragma unroll
    for (int c = 0; c < 4; ++c)
#pragma unroll
        for (int r = 0; r < 16; ++r) O[c][r] = 0.f;
    float m = -1e30f, l = 0.f;
    const unsigned x1 = (unsigned)(l31 & 15), x2 = (unsigned)((l31 >> 1) & 7);
    const unsigned ka1 = (unsigned)(l31 * 256) + 16u * ((hi ^ x1) & 1u), kx1 = 16u * (x1 & 14u);
    const unsigned ka2 = (unsigned)(K1BYTES + l31 * 128) + 16u * ((hi ^ x2) & 1u), kx2 = 16u * (x2 & 6u);
    const int q4 = (lane & 15) >> 2, p4 = lane & 3, blk = (lane >> 4) & 1;
    const unsigned va0 = (unsigned)(KBYTES + 64 * (4 * hi + q4) + 16 * ((2 * blk + (p4 >> 1)) ^ (hi)) + 8 * (p4 & 1));
    const unsigned va1 = (unsigned)(KBYTES + 64 * (4 * hi + q4) + 16 * ((2 * blk + (p4 >> 1)) ^ (2 + hi)) + 8 * (p4 & 1));
    for (int it = 0; it < ntiles; ++it) {
        const int kt0 = u.kt_begin + 64 * it, cur = it & 1;
        if (it + 1 < ntiles) FA_DMA(kt0 + 64, cur ^ 1);
        const bool relevant = (kt0 <= wq0 + 31) && (kt0 + 63 >= wq0 - W);
        if (relevant) {
            const LAS unsigned char* sb = lds + cur * STAGE;
            f32x16 S0, S1;
#pragma unroll
            for (int r = 0; r < 16; ++r) { S0[r] = 0.f; S1[r] = 0.f; }
#pragma unroll
            for (int ks = 0; ks < NKS; ++ks) {
                const unsigned ko = ks < 8 ? ka1 + ((32u * ks) ^ kx1) : ka2 + ((32u * (ks - 8)) ^ kx2);
                S0 = FA_MFMA(*(const LAS bf16x8*)(sb + ko), qf[ks], S0);
            }
#pragma unroll
            for (int ks = 0; ks < NKS; ++ks) {
                const unsigned ko = ks < 8 ? ka1 + ((32u * ks) ^ kx1) : ka2 + ((32u * (ks - 8)) ^ kx2);
                S1 = FA_MFMA(*(const LAS bf16x8*)(sb + ko + (ks < 8 ? 32 * 256 : 32 * 128)), qf[ks], S1);
            }
            const bool needmask = !((kt0 + 63 <= wq0) && (kt0 >= wq0 + 31 - W));
            const int dq = wq0 + l31 - kt0 - 4 * hi;
#define FA_HALF(S, KB) do { \
            if (needmask) { _Pragma("unroll") for (int r = 0; r < 16; ++r) { const int d0 = dq - 32 * (KB) - ((r & 3) + 8 * (r >> 2)); S[r] = (d0 >= 0 && d0 <= W) ? S[r] : -INFINITY; } } \
            float mx = fmaxf(S[0], S[1]); \
            _Pragma("unroll") for (int r = 2; r < 16; ++r) mx = fmaxf(mx, S[r]); \
            mx = fmaxf(mx, __shfl_xor(mx, 32)); \
            if (__builtin_amdgcn_ballot_w64(mx > m + 8.0f) != 0ull) {         \
                const float mn = fmaxf(m, mx); const float corr = __builtin_amdgcn_exp2f(m - mn); m = mn; l *= corr; \
                _Pragma("unroll") for (int c = 0; c < 4; ++c) _Pragma("unroll") for (int r = 0; r < 16; ++r) O[c][r] *= corr; } \
            float ps = 0.f; \
            _Pragma("unroll") for (int r = 0; r < 16; ++r) { S[r] = __builtin_amdgcn_exp2f(S[r] - m); ps += S[r]; } \
            l += ps; \
            bf16x8 P[2]; \
            _Pragma("unroll") for (int j = 0; j < 2; ++j) { u32x4 w; w.x = pk2(S[8 * j + 0], S[8 * j + 1]); w.y = pk2(S[8 * j + 2], S[8 * j + 3]); w.z = pk2(S[8 * j + 4], S[8 * j + 5]); w.w = pk2(S[8 * j + 6], S[8 * j + 7]); \
                P[j] = __builtin_bit_cast(bf16x8, w); } \
            _Pragma("unroll") for (int j = 0; j < 2; ++j) _Pragma("unroll") for (int c = 0; c < 4; ++c) { \
                const s16x4 lo = __builtin_amdgcn_ds_read_tr16_b64_v4i16((LAS s16x4*)(sb + va0 + 2048 * (4 * (KB) + 2 * j) + 512 * c)); \
                const s16x4 hv = __builtin_amdgcn_ds_read_tr16_b64_v4i16((LAS s16x4*)(sb + va1 + 2048 * (4 * (KB) + 2 * j + 1) + 512 * c)); \
                O[c] = FA_MFMA(__builtin_shufflevector(lo, hv, 0, 1, 2, 3, 4, 5, 6, 7), P[j], O[c]); } } while (0)
            FA_HALF(S0, 0);
            FA_HALF(S1, 1);
#undef FA_HALF
        }
        __syncthreads();
    }
#undef FA_DMA
    l += __shfl_xor(l, 32);
    const float il = 1.0f / l;
    LAS unsigned char* og = lds + wave * 8704;
#pragma unroll
    for (int c = 0; c < 4; ++c)
#pragma unroll
        for (int g = 0; g < 4; ++g) {
            u32x2 w; w.x = pk2(O[c][4 * g + 0] * il, O[c][4 * g + 1] * il); w.y = pk2(O[c][4 * g + 2] * il, O[c][4 * g + 3] * il);
            *(LAS u32x2*)(og + l31 * 272 + 2 * (32 * c + 8 * g + 4 * hi)) = w;
        }
    asm volatile("s_waitcnt lgkmcnt(0)" ::: "memory");
#pragma unroll
    for (int i = 0; i < 8; ++i) {
        const int row = (lane >> 4) + 4 * i;
        const u32x4 v = *(const LAS u32x4*)(og + row * 272 + 16 * (lane & 15));
        *(u32x4*)(u.o + ((unsigned)(wq0 + row) * u.os + 8u * (lane & 15))) = v;
    }
    if (u.lse && hi == 0) u.lse[(unsigned)(wq0 + l31) * u.lses] = (m + __builtin_amdgcn_logf(l)) * LN2;
    asm volatile("s_waitcnt lgkmcnt(0)" ::: "memory"); __builtin_amdgcn_s_barrier(); asm volatile("" ::: "memory");
}
}

DI void phase5_fast(const Params& p, LAS unsigned char* lds) {
    int tid = threadIdx.x; asm volatile("" : "+v"(tid));
    const int lane = tid & 63, wave = __builtin_amdgcn_readfirstlane(tid >> 6);
    unsigned char* ws = p.ws;
    const int G = gridDim.x, bid = blockIdx.x;
    const bf16_t* proj = (const bf16_t*)(ws + WS_PROJ); const bf16_t* qa = (const bf16_t*)(ws + WS_QA); const bf16_t* kva = (const bf16_t*)(ws + WS_KVA);
    if (FAST_MLA) for (int pi = bid; pi < 256; pi += G) {
        const int vv = pi >> 3, bh = (pi & 7) * 4 + (vv >> 3), j = vv & 7, b = bh >> 3, h = bh & 7;
        const size_t brow = (size_t)b * SEQ;
#pragma unroll 1
        for (int s = 0; s < 2; ++s) {
            const int qb = s == 0 ? 15 - j : j;
            fa::Unit u;
            u.q = qa + brow * QA_W + h * 128; u.q2 = qa + brow * QA_W + 1024 + h * 64; u.qs = QA_W;
            u.k1 = kva + brow * KVA_W + h * 256; u.k1s = KVA_W; u.k2 = proj + brow * NCP + C_KR; u.k2s = NCP;
            u.v = kva + brow * KVA_W + h * 256 + 128; u.vs = KVA_W;
            u.o = (bf16_t*)(ws + WS_OA) + brow * 1024 + h * 128; u.os = 1024; u.lse = nullptr; u.lses = 0;
            u.l0 = 256 * qb; u.kt_begin = 0; u.W = 1 << 30;
            fa::unit_run<192>(u, lds, tid, lane, wave);
        }
    }
    if (FAST_DIL)
#pragma unroll 1
    for (int ui = bid; ui < 1536; ui += G) {
        int pidx, b, h, sub;
        if (G == 256) { const int i6 = ui >> 8, x8 = ui & 7, k32 = (ui >> 3) & 31, bh = 4 * x8 + 2 * (i6 / 3) + (k32 >> 4); pidx = i6 % 3; b = bh >> 3; h = bh & 7; sub = k32 & 15; }
        else { const int xq = ui & 7, yq = (ui >> 3) & 31, grp = (ui >> 8) * 32 + (yq >> 3) * 8 + xq; h = yq & 7; pidx = grp >> 6; b = (grp >> 4) & 3; sub = grp & 15; }
        const int d = pidx == 0 ? 1 : (pidx == 1 ? 4 : 16), nub = 16 / d, r = sub / nub, ub = sub % nub;
        const size_t row0 = (size_t)b * SEQ + r;
        fa::Unit u;
        u.q = proj + row0 * NCP + C_QB + h * 128; u.q2 = nullptr; u.qs = (unsigned)d * NCP;
        u.k1 = proj + row0 * NCP + C_KB + h * 128; u.k1s = (unsigned)d * NCP; u.k2 = nullptr; u.k2s = 0;
        u.v = proj + row0 * NCP + C_VB + h * 128; u.vs = (unsigned)d * NCP;
        u.o = (bf16_t*)(ws + (pidx == 0 ? WS_OD1 : (pidx == 1 ? WS_OD2 : WS_OD3))) + row0 * 1024 + h * 128; u.os = (unsigned)d * 1024;
        u.lse = (float*)(ws + WS_LSE) + (size_t)pidx * TOK * 8 + row0 * 8 + h; u.lses = (unsigned)d * 8;
        u.l0 = 256 * ub; u.kt_begin = u.l0 >= 128 ? u.l0 - 128 : 0; u.W = 128;
        fa::unit_run<128>(u, lds, tid, lane, wave);
    }
}

#define XB_TMO      128
#define XB_XCNT(j)  (256  + 64 * (j))
#define XB_XSUB(j)  (1280 + 64 * (j))
#define XB_XGEN(j)  (2304 + 64 * (j))
#define XB_TOP      3328
#define XB_TOPGEN   3392
#define XCD_BAR_WORDS 3456
#define XB_SPIN_CAP (1u << 18)

__device__ __forceinline__ unsigned xb_ld(unsigned* p)              { return __hip_atomic_load(p, __ATOMIC_RELAXED, __HIP_MEMORY_SCOPE_AGENT); }
__device__ __forceinline__ unsigned xb_add(unsigned* p, unsigned v) { return __hip_atomic_fetch_add(p, v, __ATOMIC_RELAXED, __HIP_MEMORY_SCOPE_AGENT); }
__device__ __forceinline__ unsigned xb_xcc_id() { return (unsigned)__builtin_amdgcn_s_getreg((3 << 11) | 20) & 0xFu; }
#define XB_SPIN(cond, bar) do { unsigned _sp = 0; while (cond) { __builtin_amdgcn_s_sleep(1); \
    if ((++_sp & 255u) == 0u) { if (xb_ld(&(bar)[XB_TMO])) break; if (_sp > XB_SPIN_CAP) { atomicAdd(&(bar)[XB_TMO], 1u); break; } } } } while (0)

struct XcdBarrier {
    unsigned* bar; unsigned x;
    volatile LAS unsigned* st;
};

__device__ __forceinline__ XcdBarrier xcd_barrier_post(unsigned* bar, volatile LAS unsigned* st) {
    XcdBarrier b; b.bar = bar; b.x = xb_xcc_id(); b.st = st;
    if (threadIdx.x == 0) (void)xb_add(&bar[XB_XCNT(b.x)], 1u);
    return b;
}
__device__ __forceinline__ void xcd_barrier_complete(unsigned* bar, unsigned x, unsigned& nloc, unsigned& nx) {
    const unsigned G = gridDim.x * gridDim.y * gridDim.z;
    unsigned sum, cnt, mine, sp = 0u;
    for (;;) {
        sum = 0u; cnt = 0u; mine = 0u;
#pragma unroll
        for (unsigned j = 0; j < 16; ++j) { const unsigned c = xb_ld(&bar[XB_XCNT(j)]); sum += c; cnt += (c > 0u) ? 1u : 0u; mine = (j == x) ? c : mine; }
        if (sum == G) break;
        __builtin_amdgcn_s_sleep(1);
        if ((++sp & 255u) == 0u) { if (xb_ld(&bar[XB_TMO])) break; if (sp > XB_SPIN_CAP) { atomicAdd(&bar[XB_TMO], 1u); break; } }
    }
    nloc = mine > 0u ? mine : 1u; nx = cnt > 0u ? cnt : 1u;
}

__device__ __forceinline__ void xcd_barrier(const XcdBarrier& b) {
    asm volatile("s_waitcnt vmcnt(0)" ::: "memory");
    __syncthreads();
    if (threadIdx.x == 0) {
        unsigned* bar = b.bar;
        __builtin_amdgcn_s_waitcnt(0);
        unsigned nloc = b.st[0], nx = b.st[1];
        if (nloc == 0u) { xcd_barrier_complete(bar, b.x, nloc, nx); b.st[0] = nloc; b.st[1] = nx; }
        const unsigned old = xb_add(&bar[XB_XSUB(b.x)], 1u);
        const unsigned gen = old / nloc;
        if (old + 1u == (gen + 1u) * nloc) {
            __builtin_amdgcn_fence(__ATOMIC_RELEASE, "agent");
            asm volatile("s_waitcnt vmcnt(0)" ::: "memory");
            const unsigned og = xb_add(&bar[XB_TOP], 1u);
            const unsigned tg = og / nx;
            if (og + 1u == (tg + 1u) * nx) xb_add(&bar[XB_TOPGEN], 1u);
            else XB_SPIN(xb_ld(&bar[XB_TOPGEN]) == tg, bar);
            __builtin_amdgcn_fence(__ATOMIC_ACQUIRE, "agent");
            xb_add(&bar[XB_XGEN(b.x)], 1u);
            asm volatile("s_waitcnt vmcnt(0)" ::: "memory");
        } else {
            XB_SPIN(xb_ld(&bar[XB_XGEN(b.x)]) == gen, bar);
            __builtin_amdgcn_fence(__ATOMIC_ACQUIRE, "agent");
            asm volatile("s_waitcnt vmcnt(0)" ::: "memory");
        }
    }
    __syncthreads();
}

__global__ void __launch_bounds__(512, 2) fwd_kernel(Params p) {
    extern __shared__ __attribute__((aligned(16))) unsigned char lds_raw[];
    LAS unsigned char* lds = (LAS unsigned char*)lds_raw;
    cg::grid_group grid = cg::this_grid();
    const int tid = threadIdx.x, lane = tid & 63, wave = __builtin_amdgcn_readfirstlane(tid >> 6);
    const int G = gridDim.x, gw = blockIdx.x * 8 + wave, NGW = G * 8;
    unsigned char* ws = p.ws;
    const int lo = p.ph_lo, hi = p.ph_hi;
#define IN(k) (lo <= (k) && (k) < hi)
#ifndef COOP_SEAM
#define COOP_SEAM -1
#endif
    volatile LAS unsigned* bst = (volatile LAS unsigned*)(lds + LDS_BYTES - 64);
    if (tid == 0) { bst[0] = 0u; bst[1] = 0u; }
    __syncthreads();
    XcdBarrier bar = xcd_barrier_post((unsigned*)(ws + WS_CTL), bst);
    if (p.ph_lo < 0) grid.sync();
    unsigned long long t0_ = 0, t1_ = 0;
#define PB0(k) do { if (PROBE_PHASE == (k)) t0_ = __builtin_amdgcn_s_memrealtime(); } while (0)
#define PB1(k) do { if (PROBE_PHASE == (k)) t1_ = __builtin_amdgcn_s_memrealtime(); } while (0)
#define SEAM(k) do { if (IN(k) && IN((k) + 1)) { if ((k) == COOP_SEAM) grid.sync(); else xcd_barrier(bar); } } while (0)

    PB0(0);
    for (int rep_ = 0; rep_ < (DUP_PHASE == 0 ? 2 : 1); ++rep_) if (IN(0)) { phase0(p, lds, gw, NGW, lane, wave, 0); } SEAM(0); PB1(0);

    PB0(1);
    for (int rep_ = 0; rep_ < (DUP_PHASE == 1 ? 2 : 1); ++rep_) if (IN(1)) {
        pg8::Gemm g{(const bf16_t*)(ws + WS_HN), (const bf16_t*)(ws + WS_WIN), TOK, NCP, DM, DM}; pg8::StaticOrder S; S.init(TOK, NCP, G, (int)blockIdx.x);
        pg8::EpiProj E{(bf16_t*)(ws + WS_PROJ), (float*)(ws + WS_SSQ), (const float*)(ws + WS_GAINS), (const f32x4*)(ws + WS_TAB128), (LAS float*)(lds + XCH_OFF)};
        pg8::gemm_phase<pg8::EpiProj, pg8::StaticOrder, PG8_ALIGN, PG8_SP2>(lds, g, S, E);
        const int nfull = (TOK / 256) * (NCP / 256) % G, nidle = nfull == 0 ? G : G - nfull;
        if (nfull == 0 || (int)blockIdx.x >= nfull) phase0(p, lds, ((int)blockIdx.x - (nfull == 0 ? 0 : nfull)) * 8 + wave, nidle * 8, lane, wave, 1);
    } SEAM(1); PB1(1);


    PB0(3);
    for (int rep_ = 0; rep_ < (DUP_PHASE == 3 ? 2 : 1); ++rep_) if (IN(3)) {
        { pg8::Gemm g{(const bf16_t*)(ws + WS_PROJ) + C_CQ, (const bf16_t*)(ws + WS_WUQ), TOK, QA_W, 768, NCP}; pg8::StaticOrder S; S.init(TOK, QA_W, G, (int)blockIdx.x);
          pg8::EpiUp<0> E{(bf16_t*)(ws + WS_QA), QA_W, (const float*)(ws + WS_SSQ), 1.0f / 768.0f, p.in[7], (const f32x4*)(ws + WS_TAB64), (LAS float*)(lds + XCH_OFF)};
          pg8::gemm_phase<pg8::EpiUp<0>, pg8::StaticOrder, PG8_ALIGN, PG8_SP2>(lds, g, S, E); }
        __syncthreads();
        { pg8::Gemm g{(const bf16_t*)(ws + WS_PROJ) + C_CKV, (const bf16_t*)(ws + WS_WUKV), TOK, KVA_W, 512, NCP}; pg8::StaticOrder S; S.init(TOK, KVA_W, G, (int)blockIdx.x);
          pg8::EpiUp<1> E{(bf16_t*)(ws + WS_KVA), KVA_W, (const float*)(ws + WS_SSQ) + TOK, 1.0f / 512.0f, p.in[8], (const f32x4*)(ws + WS_TAB64), (LAS float*)(lds + XCH_OFF)};
          pg8::gemm_phase<pg8::EpiUp<1>, pg8::StaticOrder, PG8_ALIGN, PG8_SP2>(lds, g, S, E); }
    } SEAM(3); PB1(3);


    PB0(5);
    for (int rep_ = 0; rep_ < (DUP_PHASE == 5 ? 2 : 1); ++rep_) if (IN(5)) {
        if (!FAST_MLA) phase5_naive(p, lds, gw, NGW, lane, wave, 0, 1);
        if (!FAST_DIL) phase5_naive(p, lds, gw, NGW, lane, wave, 1, 4);
        if (FAST_MLA || FAST_DIL) { __syncthreads(); phase5_fast(p, lds); }
    } SEAM(5); PB1(5);

    PB0(6);
    for (int rep_ = 0; rep_ < (DUP_PHASE == 6 ? 2 : 1); ++rep_) if (IN(6)) { for (int m = gw; m < TOK; m += NGW) e3_row(p, m, lane); } SEAM(6); PB1(6);

    PB0(7);
    for (int rep_ = 0; rep_ < (DUP_PHASE == 7 ? 2 : 1); ++rep_) if (IN(7)) {
        pg8::Gemm g{(const bf16_t*)(ws + WS_Y), (const bf16_t*)(ws + WS_WOUT), TOK, DM, DM, DM}; pg8::StaticOrder S; S.init(TOK, DM, G, (int)blockIdx.x);
        pg8::EpiResF32 E{p.in[0], p.out, DM};
        pg8::gemm_phase<pg8::EpiResF32, pg8::StaticOrder, PG8_ALIGN, PG8_SP2>(lds, g, S, E);
    }
    if (PROBE_PHASE >= 0 && hi - lo > 1) {
        xcd_barrier(bar); PB1(7);
        if (blockIdx.x == 0 && tid == 0) p.out[0] += (float)(t1_ - t0_) * 0.01f;
    }
#if defined(EXTRA_SYNCS)
    if (hi - lo > 1) for (int i = 0; i < EXTRA_SYNCS; ++i) xcd_barrier(bar);
#endif
#undef IN
#undef SEAM
}

extern "C" void kernel_launch(void* const* d_in, const int* in_sizes, int n_in, void* d_out, int out_size, void* d_ws, size_t ws_size, hipStream_t stream) {
    static int grid = 0;
    if (grid == 0) {
        if (n_in != 14 || in_sizes[0] != TOK * DM || out_size != TOK * DM || ws_size < WS_END) {
            fprintf(stderr, "kernel_launch: unexpected shapes: n_in %d in0 %d out %d ws %zu (need %zu)\n", n_in, n_in > 0 ? in_sizes[0] : -1, out_size, ws_size, (size_t)WS_END); grid = -1; return; }
        int dev = 0, cus = 0, per_cu = 0;
        if (hipGetDevice(&dev) != hipSuccess || hipDeviceGetAttribute(&cus, hipDeviceAttributeMultiprocessorCount, dev) != hipSuccess) { fprintf(stderr, "kernel_launch: device query failed\n"); grid = -1; return; }
        if (hipFuncSetAttribute((const void*)fwd_kernel, hipFuncAttributeMaxDynamicSharedMemorySize, LDS_BYTES) != hipSuccess) { fprintf(stderr, "kernel_launch: hipFuncSetAttribute failed\n"); grid = -1; return; }
        if (hipOccupancyMaxActiveBlocksPerMultiprocessor(&per_cu, (const void*)fwd_kernel, 512, LDS_BYTES) != hipSuccess || per_cu < 1) { fprintf(stderr, "kernel_launch: occupancy query says %d blocks per CU\n", per_cu); (void)hipGetLastError(); grid = -1; return; }
        grid = cus * 1;
        fprintf(stderr, "kernel_launch: cus %d per_cu %d grid %d\n", cus, per_cu, grid);
    }
    if (grid < 0) return;
    if (hipMemsetAsync((char*)d_ws + WS_CTL, 0, CTL_BYTES, stream) != hipSuccess) { fprintf(stderr, "kernel_launch: memset of the barrier words failed\n"); return; }
    Params p{};
    for (int i = 0; i < 14; ++i) p.in[i] = (const float*)d_in[i];
    p.out = (float*)d_out; p.ws = (unsigned char*)d_ws;
#if MK_N_LAUNCHES == 1
    p.ph_lo = 0; p.ph_hi = NPH;
    void* args[] = {&p};
#if defined(PLAIN_LAUNCH)
    (void)args; hipLaunchKernelGGL(fwd_kernel, dim3(grid), dim3(512), LDS_BYTES, stream, p); const hipError_t e = hipPeekAtLastError();
#else
    const hipError_t e = hipLaunchCooperativeKernel((const void*)fwd_kernel, dim3(grid), dim3(512), args, LDS_BYTES, stream);
#endif
    if (e != hipSuccess) fprintf(stderr, "kernel_launch: cooperative launch failed: %s (grid %d)\n", hipGetErrorString(e), grid);
#else
    for (int ph = 0; ph < NPH; ++ph) {
        p.ph_lo = ph; p.ph_hi = ph + 1;
        hipLaunchKernelGGL(fwd_kernel, dim3(grid), dim3(512), LDS_BYTES, stream, p);
        const hipError_t e = hipPeekAtLastError();
        if (e != hipSuccess) { fprintf(stderr, "kernel_launch: launch %d failed: %s\n", ph, hipGetErrorName(e)); break; }
    }
#endif
}
```

```cpp
#include <hip/hip_runtime.h>
#include <hip/hip_cooperative_groups.h>
#include <cstdio>
#include <cstdint>
namespace cg = cooperative_groups;
namespace pg8 {
#define PG8_LAS __attribute__((address_space(3)))
typedef unsigned short bf16_t;
typedef short bf16x8 __attribute__((ext_vector_type(8)));
typedef float f32x4 __attribute__((ext_vector_type(4)));
typedef unsigned u32x4 __attribute__((ext_vector_type(4)));
constexpr int BM = 256, BK = 64, HALF = 128, HTB = HALF * BK * 2  , STAGE_BYTES = 8 * HTB, NXCD = 8, WGM = 8;

__host__ __device__ __forceinline__ int lds_byte(int r, int c) { const int st = (r >> 4) * 2 + (c >> 5), rr = r & 15, cc = c & 31, ob = rr * 64 + cc * 2; return st * 1024 + (ob ^ (((ob >> 9) & 1) << 5)); }
__host__ __device__ __forceinline__ void stage_rc(int b, int& R, int& C) { const int st = b / 1024, sb = b % 1024, swz = sb ^ (((sb >> 9) & 1) << 5); R = (st >> 1) * 16 + swz / 64; C = (st & 1) * 32 + (swz % 64) / 2; }
__host__ __device__ __forceinline__ int perm32(int rho) { const int n = rho >> 4, i = rho & 15; return 8 * (i >> 2) + 4 * n + (i & 3); }

struct Unit { int pm, pn; };
struct Gemm { const bf16_t* A; const bf16_t* Bt; int M, N, K, lda; };

struct StaticOrder {
    int nM, nN, nwg, G, c;
    __host__ __device__ void init(int M, int N, int G_, int c_) { nM = M / BM; nN = N / BM; nwg = nM * nN; G = G_; c = c_; }
    __host__ __device__ bool next(int i, Unit& u) const {
        const long L = (long)i * G + c; if (L >= nwg) return false;
        int wgid = (int)L; { const int q = nwg / NXCD, r = nwg % NXCD, xcd = wgid % NXCD, off = wgid / NXCD; wgid = (xcd < r ? xcd * (q + 1) : r * (q + 1) + (xcd - r) * q) + off; }
        const int nig = WGM * nN, gid = wgid / nig, fm = gid * WGM, gsz = (nM - fm) < WGM ? (nM - fm) : WGM;
        u.pm = fm + ((wgid % nig) % gsz); u.pn = (wgid % nig) / gsz; return true;
    }
    __device__ __forceinline__ void a_ready(const Unit&) const {}
    __device__ __forceinline__ void done(const Unit&) const {}
};

__device__ __forceinline__ unsigned cvt_pk_bf16(float lo, float hi) { unsigned r; asm volatile("v_cvt_pk_bf16_f32 %0, %1, %2" : "=v"(r) : "v"(lo), "v"(hi)); return r; }
typedef float f32x2 __attribute__((ext_vector_type(2)));
__device__ __forceinline__ f32x2 gelu_pk(f32x2 v) {
    const f32x2 av = __builtin_elementwise_abs(v), d = av * 0.2316418882f + 1.0f;
    f32x2 t; t.x = __builtin_amdgcn_rcpf(d.x); t.y = __builtin_amdgcn_rcpf(d.y);
    f32x2 q = t * 0.5307027145f + (-0.7265760135f); q = q * t + 0.7107068705f; q = q * t + (-0.142248368f); q = q * t + 0.127414796f; q = q * t;
    const f32x2 s = (v * v) * (-0.72134752044f);
    f32x2 e; e.x = __builtin_amdgcn_exp2f(s.x); e.y = __builtin_amdgcn_exp2f(s.y);
    const f32x2 m = v * (q * e), r = v - m;
    f32x2 o; o.x = v.x < 0.f ? m.x : r.x; o.y = v.y < 0.f ? m.y : r.y; return o;
}

template <int ACT  > struct EpiBf16 {
    static constexpr bool PERM = true, AFTER_DRAIN = false; static_assert(ACT == 0 || ACT == 1, "EpiBf16: ACT is 0 (none) or 1 (gelu_pk)");
    bf16_t* O; int ldc; const float* bias; int split_cols; size_t split_stride; float scale0;
    __device__ __forceinline__ void operator()(const f32x4 (&acc)[2][2][4][2], const Unit& u, int wr, int wc, int fr, int fq) const {
        const int row0 = u.pm * BM + wr * 64 + fr; int colt = u.pn * BM; bf16_t* base = O;
        float sc = 1.f; if (split_cols) { const int t = colt / split_cols; base += (size_t)t * split_stride; colt -= t * split_cols; if (t == 0) sc = scale0; }
        const int col0 = colt + wc * 32 + 8 * fq, bcol0 = u.pn * BM + wc * 32 + 8 * fq;
        f32x4 bv[2][2];
#pragma unroll
        for (int bj = 0; bj < 2; ++bj)
#pragma unroll
            for (int n = 0; n < 2; ++n) bv[bj][n] = bias ? *(const f32x4*)(bias + bcol0 + bj * HALF + 4 * n) : (f32x4){0.f, 0.f, 0.f, 0.f};
#pragma unroll
        for (int ai = 0; ai < 2; ++ai)
#pragma unroll
            for (int m = 0; m < 4; ++m) { bf16_t* rowp = base + (size_t)(row0 + ai * HALF + m * 16) * ldc + col0;
#pragma unroll
                for (int bj = 0; bj < 2; ++bj) { f32x4 v0 = acc[ai][bj][m][0] + bv[bj][0], v1 = acc[ai][bj][m][1] + bv[bj][1];
                    if (ACT == 1) { f32x2 a = gelu_pk((f32x2){v0[0], v0[1]}), b = gelu_pk((f32x2){v0[2], v0[3]}), c = gelu_pk((f32x2){v1[0], v1[1]}), d = gelu_pk((f32x2){v1[2], v1[3]});
                        v0 = (f32x4){a.x, a.y, b.x, b.y}; v1 = (f32x4){c.x, c.y, d.x, d.y}; }
                    v0 = v0 * sc; v1 = v1 * sc; u32x4 w; w.x = cvt_pk_bf16(v0[0], v0[1]); w.y = cvt_pk_bf16(v0[2], v0[3]); w.z = cvt_pk_bf16(v1[0], v1[1]); w.w = cvt_pk_bf16(v1[2], v1[3]);
                    *(u32x4*)(rowp + bj * HALF) = w; } }
    }
};

struct EpiResF32 {
    static constexpr bool PERM = true, AFTER_DRAIN = false;
    const float* base; float* out; int ldc;
    __device__ __forceinline__ void operator()(const f32x4 (&acc)[2][2][4][2], const Unit& u, int wr, int wc, int fr, int fq) const {
        const int row0 = u.pm * BM + wr * 64 + fr, col0 = u.pn * BM + wc * 32 + 8 * fq;
#pragma unroll
        for (int ai = 0; ai < 2; ++ai) {
            f32x4 pre[4][2][2];
#pragma unroll
            for (int m = 0; m < 4; ++m) { const size_t off = (size_t)(row0 + ai * HALF + m * 16) * ldc + col0;
#pragma unroll
                for (int bj = 0; bj < 2; ++bj) { pre[m][bj][0] = __builtin_nontemporal_load((const f32x4*)(base + off + bj * HALF)); pre[m][bj][1] = __builtin_nontemporal_load((const f32x4*)(base + off + bj * HALF + 4)); } }
#pragma unroll
            for (int m = 0; m < 4; ++m) { const size_t off = (size_t)(row0 + ai * HALF + m * 16) * ldc + col0;
#pragma unroll
                for (int bj = 0; bj < 2; ++bj) { __builtin_nontemporal_store(acc[ai][bj][m][0] + pre[m][bj][0], (f32x4*)(out + off + bj * HALF)); __builtin_nontemporal_store(acc[ai][bj][m][1] + pre[m][bj][1], (f32x4*)(out + off + bj * HALF + 4)); } }
        }
    }
};
template <class Epi, class Sched, bool ALIGN_EPI = false, bool SP2 = false>
__device__ __forceinline__ void gemm_phase(PG8_LAS unsigned char* lds, const Gemm g, const Sched& S, const Epi& E) {
    int tid = threadIdx.x; asm volatile("" : "+v"(tid));
    const int wid = __builtin_amdgcn_readfirstlane(tid >> 6), lane = tid & 63, wr = wid >> 2, wc = wid & 3, fr = lane & 15, fq = lane >> 4;
    const int K = g.K, nt = K / BK;
    unsigned voffA[2], voffB[2];
#pragma unroll
    for (int i = 0; i < 2; ++i) { int R, C; stage_rc(tid * 16 + i * 8192, R, C); const int Rb = Epi::PERM ? ((R & ~31) + perm32(R & 31)) : R;
        voffA[i] = (unsigned)(R * g.lda + C) * 2u; voffB[i] = (unsigned)(Rb * K + C) * 2u; }
    const size_t kstep = (size_t)(BK * 2);
    const size_t hstepA = (size_t)HALF * g.lda * 2, hstepB = (size_t)HALF * K * 2;
    const size_t tstepA = 2 * hstepA, tstepB = 2 * hstepB;
    const unsigned ldsw = (unsigned)wid * 1024u;
    const int aoff = lds_byte(wr * 64 + fr, fq * 8), boff = lds_byte(wc * 32 + fr, fq * 8);
#define PG8_SA(b, h) (((b) * 2 + (h)) * HTB)
#define PG8_SB(b, h) ((4 + (b) * 2 + (h)) * HTB)
#define PG8_STAGE(bufoff, gbase, voff) do { _Pragma("unroll") for (int _i = 0; _i < 2; ++_i) \
        __builtin_amdgcn_global_load_lds((const unsigned*)((const char*)(gbase) + (voff)[_i]), (PG8_LAS unsigned*)(lds + (bufoff) + ldsw + _i * 8192), 16, 0, 0); } while (0)
#define PG8_LDA(dst, b, h) do { _Pragma("unroll") for (int m = 0; m < 4; ++m) _Pragma("unroll") for (int k = 0; k < 2; ++k) dst[m][k] = *(const PG8_LAS bf16x8*)(lds + PG8_SA(b, h) + aoff + m * 2048 + k * 1024); } while (0)
#define PG8_LDB(dst, b, h) do { _Pragma("unroll") for (int n = 0; n < 2; ++n) _Pragma("unroll") for (int k = 0; k < 2; ++k) dst[n][k] = *(const PG8_LAS bf16x8*)(lds + PG8_SB(b, h) + boff + n * 2048 + k * 1024); } while (0)
#define PG8_MMA(ai, bj, At, Bt) do { __builtin_amdgcn_s_setprio(1); _Pragma("unroll") for (int m = 0; m < 4; ++m) _Pragma("unroll") for (int n = 0; n < 2; ++n) _Pragma("unroll") for (int k = 0; k < 2; ++k) \
        acc[ai][bj][m][n] = __builtin_amdgcn_mfma_f32_16x16x32_bf16(Bt[n][k], At[m][k], acc[ai][bj][m][n], 0, 0, 0); __builtin_amdgcn_s_setprio(0); } while (0)
#define PG8_WAIT_V(n) asm volatile("s_waitcnt vmcnt(" #n ")" ::: "memory")
#define PG8_WAIT_L(n) asm volatile("s_waitcnt lgkmcnt(" #n ")" ::: "memory")
#define PG8_BAR __builtin_amdgcn_s_barrier()
#define PG8_SCHED __builtin_amdgcn_sched_barrier(0)
    Unit cur, nxt; int ui = 0;
    if (!S.next(0, cur)) return;
    f32x4 acc[2][2][4][2];
#pragma unroll
    for (int a = 0; a < 2; ++a)
#pragma unroll
        for (int b = 0; b < 2; ++b)
#pragma unroll
            for (int m = 0; m < 4; ++m)
#pragma unroll
                for (int n = 0; n < 2; ++n) acc[a][b][m][n] = (f32x4){0.f, 0.f, 0.f, 0.f};
    bf16x8 At[4][2], B0[2][2], B1[2][2];
    const char* cA = (const char*)g.A + (size_t)cur.pm * tstepA; const char* cB = (const char*)g.Bt + (size_t)cur.pn * tstepB;
    S.a_ready(cur);
    if constexpr (SP2) {
        PG8_STAGE(PG8_SB(0, 0), cB, voffB); PG8_STAGE(PG8_SB(0, 1), cB + hstepB, voffB); PG8_STAGE(PG8_SA(0, 0), cA, voffA); PG8_STAGE(PG8_SA(0, 1), cA + hstepA, voffA);
        if (wr == 1) PG8_BAR;
        PG8_WAIT_V(2); PG8_BAR;
        PG8_STAGE(PG8_SB(1, 0), cB + kstep, voffB); PG8_STAGE(PG8_SA(1, 0), cA + kstep, voffA); PG8_STAGE(PG8_SB(1, 1), cB + hstepB + kstep, voffB);
        PG8_WAIT_V(6); PG8_BAR;
    } else {
        PG8_STAGE(PG8_SB(0, 0), cB, voffB); PG8_STAGE(PG8_SA(0, 0), cA, voffA); PG8_STAGE(PG8_SB(0, 1), cB + hstepB, voffB); PG8_STAGE(PG8_SA(0, 1), cA + hstepA, voffA);
        if (wr == 1) PG8_BAR;
        PG8_WAIT_V(4); PG8_BAR;
        PG8_STAGE(PG8_SB(1, 0), cB + kstep, voffB); PG8_STAGE(PG8_SA(1, 0), cA + kstep, voffA); PG8_STAGE(PG8_SB(1, 1), cB + hstepB + kstep, voffB);
        PG8_WAIT_V(6); PG8_BAR;
    }
    for (;;) {
        const bool has_next = S.next(ui + 1, nxt);
        const char* nA = has_next ? (const char*)g.A + (size_t)nxt.pm * tstepA : cA; const char* nB = has_next ? (const char*)g.Bt + (size_t)nxt.pn * tstepB : cB;
        for (int t = 0; t < nt; t += 2) {
            const bool last = (t == nt - 2);
            const char* a1 = cA + (size_t)(t + 1) * kstep;
            const char* a2 = last ? nA : cA + (size_t)(t + 2) * kstep; const char* b2 = last ? nB : cB + (size_t)(t + 2) * kstep;
            const char* a3 = a2 + kstep; const char* b3 = b2 + kstep;
            if (last && has_next) S.a_ready(nxt);
            if constexpr (SP2) {
            PG8_LDB(B0, 0, 0); PG8_LDB(B1, 0, 1); PG8_SCHED; PG8_LDA(At, 0, 0); PG8_STAGE(PG8_SA(1, 1), a1 + hstepA, voffA);
            PG8_WAIT_V(8); PG8_WAIT_L(0); PG8_BAR; PG8_MMA(0, 0, At, B0); PG8_MMA(0, 1, At, B1); PG8_BAR; PG8_SCHED;
            PG8_LDA(At, 0, 1); PG8_STAGE(PG8_SB(0, 0), b2, voffB); PG8_STAGE(PG8_SB(0, 1), b2 + hstepB, voffB); PG8_STAGE(PG8_SA(0, 0), a2, voffA);
            PG8_WAIT_V(8); PG8_WAIT_L(0); PG8_BAR; PG8_MMA(1, 0, At, B0); PG8_MMA(1, 1, At, B1); PG8_BAR; PG8_SCHED;
            PG8_LDB(B0, 1, 0); PG8_LDB(B1, 1, 1); PG8_SCHED; PG8_LDA(At, 1, 0); PG8_STAGE(PG8_SA(0, 1), a2 + hstepA, voffA);
            PG8_WAIT_V(8); PG8_WAIT_L(0); PG8_BAR; PG8_MMA(0, 0, At, B0); PG8_MMA(0, 1, At, B1); PG8_BAR; PG8_SCHED;
            PG8_LDA(At, 1, 1); PG8_STAGE(PG8_SB(1, 0), b3, voffB); PG8_STAGE(PG8_SB(1, 1), b3 + hstepB, voffB); PG8_STAGE(PG8_SA(1, 0), a3, voffA);
            PG8_WAIT_V(8); PG8_WAIT_L(0); PG8_BAR; PG8_MMA(1, 0, At, B0); PG8_MMA(1, 1, At, B1); PG8_BAR; PG8_SCHED;
            } else {
            PG8_LDB(B0, 0, 0); PG8_SCHED; PG8_LDA(At, 0, 0); PG8_STAGE(PG8_SA(1, 1), a1 + hstepA, voffA);
            PG8_WAIT_L(8); PG8_BAR; PG8_WAIT_L(0); PG8_MMA(0, 0, At, B0); PG8_BAR; PG8_SCHED;
            PG8_LDB(B1, 0, 1); PG8_STAGE(PG8_SB(0, 0), b2, voffB);
            PG8_BAR; PG8_WAIT_L(0); PG8_MMA(0, 1, At, B1); PG8_BAR;
            PG8_LDA(At, 0, 1); PG8_STAGE(PG8_SA(0, 0), a2, voffA);
            PG8_BAR; PG8_WAIT_L(0); PG8_MMA(1, 0, At, B0); PG8_BAR; PG8_SCHED;
            PG8_STAGE(PG8_SB(0, 1), b2 + hstepB, voffB);
            PG8_WAIT_V(6); PG8_BAR; PG8_MMA(1, 1, At, B1); PG8_BAR;
            PG8_LDB(B0, 1, 0); PG8_SCHED; PG8_LDA(At, 1, 0); PG8_STAGE(PG8_SA(0, 1), a2 + hstepA, voffA);
            PG8_WAIT_L(8); PG8_BAR; PG8_WAIT_L(0); PG8_MMA(0, 0, At, B0); PG8_BAR; PG8_SCHED;
            PG8_LDB(B1, 1, 1); PG8_STAGE(PG8_SB(1, 0), b3, voffB);
            PG8_BAR; PG8_WAIT_L(0); PG8_MMA(0, 1, At, B1); PG8_BAR;
            PG8_LDA(At, 1, 1); PG8_STAGE(PG8_SA(1, 0), a3, voffA);
            PG8_BAR; PG8_WAIT_L(0); PG8_MMA(1, 0, At, B0); PG8_BAR; PG8_SCHED;
            PG8_STAGE(PG8_SB(1, 1), b3 + hstepB, voffB);
            PG8_WAIT_V(6); PG8_BAR; PG8_MMA(1, 1, At, B1); PG8_BAR;
            }
        }
        if constexpr (ALIGN_EPI) { if (wr == 0) PG8_BAR; }
        if constexpr (!Epi::AFTER_DRAIN) { E(acc, cur, wr, wc, fr, fq); S.done(cur); }
        if (!has_next) break;
#pragma unroll
        for (int a = 0; a < 2; ++a)
#pragma unroll
            for (int b = 0; b < 2; ++b)
#pragma unroll
                for (int m = 0; m < 4; ++m)
#pragma unroll
                    for (int n = 0; n < 2; ++n) acc[a][b][m][n] = (f32x4){0.f, 0.f, 0.f, 0.f};
        cur = nxt; cA = nA; cB = nB; ++ui;
        if constexpr (ALIGN_EPI) { if (wr == 1) PG8_BAR; }
    }
    PG8_WAIT_V(0);
    if constexpr (!ALIGN_EPI) { if (wr == 0) PG8_BAR; }
    PG8_BAR;
    if constexpr (Epi::AFTER_DRAIN) { E.fused(acc, cur, wr, wc, fr, fq, lds, wid, lane); S.done(cur); }
#undef PG8_SA
#undef PG8_SB
#undef PG8_STAGE
#undef PG8_LDA
#undef PG8_LDB
#undef PG8_MMA
#undef PG8_WAIT_V
#undef PG8_WAIT_L
#undef PG8_BAR
#undef PG8_SCHED
}
}
#ifndef PG8_SP2
#define PG8_SP2 true
#endif
#ifndef PG8_ALIGN
#define PG8_ALIGN true
#endif
#ifndef MK_N_LAUNCHES
#define MK_N_LAUNCHES 1
#endif
#ifndef PROBE_PHASE
#define PROBE_PHASE -1
#endif
#ifndef DUP_PHASE
#define DUP_PHASE -1
#endif
#ifndef FAST_MLA
#define FAST_MLA 1
#endif
#ifndef FAST_DIL
#define FAST_DIL 1
#endif

constexpr int NBATCH = 4, SEQ = 4096, DM = 2048, TOK = NBATCH * SEQ;
constexpr int NC = 6464, NCP = 6656;
constexpr int C_CQ = 0, C_CKV = 768, C_QB = 1280, C_KB = 2304, C_VB = 3328, C_GA = 4352, C_GB = 5376, C_KR = 6400;
constexpr int QA_W = 1536, KVA_W = 2048;
constexpr float EPS = 1e-6f;
constexpr float LOG2E = 1.4426950408889634f, LN2 = 0.6931471805599453f;
constexpr float QSCALE_MLA = 0.07216878364870322f * LOG2E;
constexpr float QSCALE_DIL = 0.08838834764831845f * LOG2E;
constexpr int NPH = 8;

constexpr size_t MiB = 1u << 20;
constexpr size_t WS_GAINS = 3 * MiB + 196608;
constexpr size_t WS_SSQ = 3 * MiB + 65536;
constexpr size_t WS_TAB128 = 0, WS_TAB64 = 2 * MiB, WS_CTL = 3 * MiB, CTL_BYTES = 16384;
constexpr size_t WS_WIN = 4 * MiB, WS_WUQ = 30 * MiB, WS_WUKV = 33 * MiB, WS_WOUT = 35 * MiB;
constexpr size_t WS_PROJ = 44 * MiB;
constexpr size_t WS_HN = 252 * MiB;
constexpr size_t WS_OA = 252 * MiB, WS_OD1 = 284 * MiB;
constexpr size_t WS_QA = 316 * MiB;
constexpr size_t WS_KVA = 364 * MiB;
constexpr size_t WS_OD2 = 428 * MiB, WS_OD3 = 460 * MiB;
constexpr size_t WS_LSE = 492 * MiB;
constexpr size_t WS_Y = 316 * MiB;
constexpr size_t WS_END = 494 * MiB;
constexpr int LDS_BYTES = 143360, XCH_OFF = 131072;

#define LAS __attribute__((address_space(3)))
#define DI __device__ __forceinline__
typedef unsigned short bf16_t;
typedef unsigned u32x4 __attribute__((ext_vector_type(4)));
typedef unsigned u32x2 __attribute__((ext_vector_type(2)));
typedef float f32x4 __attribute__((ext_vector_type(4)));
typedef float f32x2 __attribute__((ext_vector_type(2)));

struct Params { const float* in[14]; float* out; unsigned char* ws; int ph_lo, ph_hi; };

DI float bflo(unsigned w) { return __uint_as_float(w << 16); }
DI float bfhi(unsigned w) { return __uint_as_float(w & 0xffff0000u); }
DI unsigned pk2(float lo, float hi) { return pg8::cvt_pk_bf16(lo, hi); }
DI void unpack8(const u32x4 v, f32x4& a, f32x4& b) { a = (f32x4){bflo(v.x), bfhi(v.x), bflo(v.y), bfhi(v.y)}; b = (f32x4){bflo(v.z), bfhi(v.z), bflo(v.w), bfhi(v.w)}; }
DI u32x4 pack8(const f32x4 a, const f32x4 b) { u32x4 r; r.x = pk2(a.x, a.y); r.y = pk2(a.z, a.w); r.z = pk2(b.x, b.y); r.w = pk2(b.z, b.w); return r; }
DI float sumsq8(const f32x4 a, const f32x4 b) { return (a.x * a.x + a.y * a.y) + (a.z * a.z + a.w * a.w) + (b.x * b.x + b.y * b.y) + (b.z * b.z + b.w * b.w); }
DI float wave_sum(float v) {
#pragma unroll
    for (int o = 1; o < 64; o <<= 1) v += __shfl_xor(v, o);
    return v; }
DI float wave_max(float v) {
#pragma unroll
    for (int o = 1; o < 64; o <<= 1) v = fmaxf(v, __shfl_xor(v, o));
    return v; }
DI float grp_sum8(float v) { v += __shfl_xor(v, 1); v += __shfl_xor(v, 2); v += __shfl_xor(v, 4); return v; }
DI float grp_sum16(float v) { v = grp_sum8(v); v += __shfl_xor(v, 8); return v; }
DI float rstd_of(float ss, float inv_n) { return 1.0f / sqrtf(ss * inv_n + EPS); }
DI float silu(float x) { return x / (1.0f + __expf(-x)); }
DI f32x4 silu4(f32x4 x) { return (f32x4){silu(x.x), silu(x.y), silu(x.z), silu(x.w)}; }
DI void rope8(f32x4& a, f32x4& b, int xr, bool first, const f32x4* tab) {
    f32x4 pa, pb;
    pa.x = __shfl_xor(a.x, xr); pa.y = __shfl_xor(a.y, xr); pa.z = __shfl_xor(a.z, xr); pa.w = __shfl_xor(a.w, xr);
    pb.x = __shfl_xor(b.x, xr); pb.y = __shfl_xor(b.y, xr); pb.z = __shfl_xor(b.z, xr); pb.w = __shfl_xor(b.w, xr);
    const float sg = first ? -1.f : 1.f;
    const f32x4 t0 = tab[0], t1 = tab[1], t2 = tab[2], t3 = tab[3];
    a.x = a.x * t0.x + sg * pa.x * t0.y; a.y = a.y * t0.z + sg * pa.y * t0.w; a.z = a.z * t1.x + sg * pa.z * t1.y; a.w = a.w * t1.z + sg * pa.w * t1.w;
    b.x = b.x * t2.x + sg * pb.x * t2.y; b.y = b.y * t2.z + sg * pb.y * t2.w; b.z = b.z * t3.x + sg * pb.z * t3.y; b.w = b.w * t3.z + sg * pb.w * t3.w;
}

namespace pg8 {
struct EpiProj {
    static constexpr bool PERM = true, AFTER_DRAIN = false;
    bf16_t* O; float* ssq; const float* gains; const f32x4* tab; LAS float* xch;
    __device__ __forceinline__ void operator()(const f32x4 (&acc)[2][2][4][2], const Unit& u, int wr, int wc, int fr, int fq) const {
        const int pn = u.pn, row0 = u.pm * BM + wr * 64 + fr, col0 = pn * BM + wc * 32 + 8 * fq;
        const bool kr = pn == 25;
        if ((pn >= 5 && pn < 13) || kr) {
#pragma unroll
            for (int ai = 0; ai < 2; ++ai)
#pragma unroll
                for (int m = 0; m < 4; ++m)
#pragma unroll
                    for (int bj = 0; bj < 2; ++bj) {
                        const f32x4 a = acc[ai][bj][m][0], c = acc[ai][bj][m][1];
                        float s = (a.x * a.x + a.y * a.y) + (a.z * a.z + a.w * a.w) + (c.x * c.x + c.y * c.y) + (c.z * c.z + c.w * c.w);
                        s += __shfl_xor(s, 16); s += __shfl_xor(s, 32);
                        if (fq == 0) xch[((ai * HALF + wr * 64 + m * 16 + fr) * 2 + bj) * 4 + wc] = s;
                    }
            asm volatile("s_waitcnt lgkmcnt(0)" ::: "memory"); __builtin_amdgcn_s_barrier(); asm volatile("" ::: "memory");
            const int lg = kr ? 4 * (wc & 1) + fq : 4 * wc + fq;
            const int goff = kr ? 256 : (pn < 9 ? 0 : 128);
            const f32x4 g0 = *(const f32x4*)(gains + goff + 4 * lg), g1 = *(const f32x4*)(gains + goff + (kr ? 32 : 64) + 4 * lg);
            const float scale = (pn < 9) ? QSCALE_DIL : 1.0f, inv_n = kr ? (1.0f / 64.0f) : (1.0f / 128.0f);
            if (!kr || wc < 2) {
#pragma unroll
            for (int ai = 0; ai < 2; ++ai)
#pragma unroll
                for (int m = 0; m < 4; ++m) {
                    const int row = row0 + ai * HALF + m * 16, t = row & (SEQ - 1);
                    const int ti = kr ? (int)(WS_TAB64 / 16) + (t * 32 + 4 * lg) / 2 : (t * 64 + 4 * lg) / 2;
                    const f32x4 tA = tab[ti], tB = tab[ti + 1];
#pragma unroll
                    for (int bj = 0; bj < 2; ++bj) {
                        if (kr && bj == 1) continue;
                        const f32x4 ps = *(const LAS f32x4*)(xch + ((ai * HALF + wr * 64 + m * 16 + fr) * 2 + bj) * 4);
                        const float tot = kr ? ps.x + ps.y : (ps.x + ps.y) + (ps.z + ps.w);
                        const float rstd = 1.0f / sqrtf(tot * inv_n + EPS);
                        const f32x4 x1 = acc[ai][bj][m][0] * rstd * g0, x2 = acc[ai][bj][m][1] * rstd * g1;
                        f32x4 o1, o2;
                        o1.x = x1.x * tA.x - x2.x * tA.y; o2.x = x2.x * tA.x + x1.x * tA.y;
                        o1.y = x1.y * tA.z - x2.y * tA.w; o2.y = x2.y * tA.z + x1.y * tA.w;
                        o1.z = x1.z * tB.x - x2.z * tB.y; o2.z = x2.z * tB.x + x1.z * tB.y;
                        o1.w = x1.w * tB.z - x2.w * tB.w; o2.w = x2.w * tB.z + x1.w * tB.w;
                        o1 = o1 * scale; o2 = o2 * scale;
                        u32x4 w; w.x = cvt_pk_bf16(o1.x, o1.y); w.y = cvt_pk_bf16(o1.z, o1.w); w.z = cvt_pk_bf16(o2.x, o2.y); w.w = cvt_pk_bf16(o2.z, o2.w);
                        *(u32x4*)(O + (size_t)row * NCP + col0 + bj * HALF) = w;
                    }
                }
            }
        } else {
            float* sq = ssq + (pn < 3 ? 0 : TOK);
#pragma unroll
            for (int ai = 0; ai < 2; ++ai)
#pragma unroll
                for (int m = 0; m < 4; ++m) {
                    const int row = row0 + ai * HALF + m * 16;
                    bf16_t* rowp = O + (size_t)row * NCP + col0;
                    float s = 0.f;
#pragma unroll
                    for (int bj = 0; bj < 2; ++bj) {
                        const f32x4 v0 = acc[ai][bj][m][0], v1 = acc[ai][bj][m][1];
                        s += (v0.x * v0.x + v0.y * v0.y) + (v0.z * v0.z + v0.w * v0.w) + (v1.x * v1.x + v1.y * v1.y) + (v1.z * v1.z + v1.w * v1.w);
                        u32x4 w; w.x = cvt_pk_bf16(v0.x, v0.y); w.y = cvt_pk_bf16(v0.z, v0.w); w.z = cvt_pk_bf16(v1.x, v1.y); w.w = cvt_pk_bf16(v1.z, v1.w);
                        *(u32x4*)(rowp + bj * HALF) = w;
                    }
                    if (pn < 5) { s += __shfl_xor(s, 16); s += __shfl_xor(s, 32); if (fq == 0) atomicAdd(sq + row, s); }
                }
        }
    }
};
struct EpiRowScale {
    static constexpr bool PERM = true, AFTER_DRAIN = false;
    bf16_t* O; int ldc; const float* ssq; float inv_n;
    __device__ __forceinline__ void operator()(const f32x4 (&acc)[2][2][4][2], const Unit& u, int wr, int wc, int fr, int fq) const {
        const int row0 = u.pm * BM + wr * 64 + fr, col0 = u.pn * BM + wc * 32 + 8 * fq;
#pragma unroll
        for (int ai = 0; ai < 2; ++ai)
#pragma unroll
            for (int m = 0; m < 4; ++m) {
                const int row = row0 + ai * HALF + m * 16;
                const float rstd = 1.0f / sqrtf(ssq[row] * inv_n + EPS);
                bf16_t* rowp = O + (size_t)row * ldc + col0;
#pragma unroll
                for (int bj = 0; bj < 2; ++bj) {
                    const f32x4 v0 = acc[ai][bj][m][0] * rstd, v1 = acc[ai][bj][m][1] * rstd;
                    u32x4 w; w.x = cvt_pk_bf16(v0.x, v0.y); w.y = cvt_pk_bf16(v0.z, v0.w); w.z = cvt_pk_bf16(v1.x, v1.y); w.w = cvt_pk_bf16(v1.z, v1.w);
                    *(u32x4*)(rowp + bj * HALF) = w;
                }
            }
    }
};
template <int MODE> struct EpiUp {
    static constexpr bool PERM = true, AFTER_DRAIN = false;
    bf16_t* O; int ldc; const float* ssq; float inv_k; const float* gain; const f32x4* tab64; LAS float* xch;
    __device__ __forceinline__ void operator()(const f32x4 (&acc)[2][2][4][2], const Unit& u, int wr, int wc, int fr, int fq) const {
        const int pn = u.pn, row0 = u.pm * BM + wr * 64 + fr, col0 = pn * BM + wc * 32 + 8 * fq;
        const bool ropet = (MODE == 0) && pn >= 4;
        float rs[2][4];
#pragma unroll
        for (int ai = 0; ai < 2; ++ai)
#pragma unroll
            for (int m = 0; m < 4; ++m) rs[ai][m] = 1.0f / sqrtf(ssq[row0 + ai * HALF + m * 16] * inv_k + EPS);
#pragma unroll
        for (int ai = 0; ai < 2; ++ai)
#pragma unroll
            for (int m = 0; m < 4; ++m)
#pragma unroll
                for (int bj = 0; bj < (MODE == 1 ? 1 : 2); ++bj) {
                    const f32x4 a = acc[ai][bj][m][0] * rs[ai][m], c = acc[ai][bj][m][1] * rs[ai][m];
                    float s = (a.x * a.x + a.y * a.y) + (a.z * a.z + a.w * a.w) + (c.x * c.x + c.y * c.y) + (c.z * c.z + c.w * c.w);
                    s += __shfl_xor(s, 16); s += __shfl_xor(s, 32);
                    if (fq == 0) xch[((ai * HALF + wr * 64 + m * 16 + fr) * 2 + bj) * 4 + wc] = s;
                }
        asm volatile("s_waitcnt lgkmcnt(0)" ::: "memory"); __builtin_amdgcn_s_barrier(); asm volatile("" ::: "memory");
        const int lg = 4 * (wc & 1) + fq;
        const int goff = ropet ? 128 + 4 * lg : 32 * wc + 8 * fq;
        const f32x4 g0 = *(const f32x4*)(gain + goff), g1 = *(const f32x4*)(gain + goff + (ropet ? 32 : 4));
        const float osc = MODE == 0 ? QSCALE_MLA : 1.0f, inv_n = ropet ? (1.0f / 64.0f) : (1.0f / 128.0f);
#pragma unroll
        for (int ai = 0; ai < 2; ++ai)
#pragma unroll
            for (int m = 0; m < 4; ++m) {
                const int row = row0 + ai * HALF + m * 16, t = row & (SEQ - 1);
                f32x4 tA = (f32x4){1.f, 0.f, 1.f, 0.f}, tB = tA;
                if (ropet) { const int ti = (t * 32 + 4 * lg) / 2; tA = tab64[ti]; tB = tab64[ti + 1]; }
                bf16_t* rowp = O + (size_t)row * ldc + col0;
#pragma unroll
                for (int bj = 0; bj < 2; ++bj) {
                    f32x4 o1, o2;
                    if (MODE == 1 && bj == 1) { o1 = acc[ai][bj][m][0] * rs[ai][m]; o2 = acc[ai][bj][m][1] * rs[ai][m]; }
                    else {
                        const f32x4 ps = *(const LAS f32x4*)(xch + ((ai * HALF + wr * 64 + m * 16 + fr) * 2 + bj) * 4);
                        const float tot = ropet ? ((wc & 2) ? ps.z + ps.w : ps.x + ps.y) : (ps.x + ps.y) + (ps.z + ps.w);
                        const float sc = rs[ai][m] * (1.0f / sqrtf(tot * inv_n + EPS)) * osc;
                        const f32x4 x1 = acc[ai][bj][m][0] * sc * g0, x2 = acc[ai][bj][m][1] * sc * g1;
                        if (ropet) {
                            o1.x = x1.x * tA.x - x2.x * tA.y; o2.x = x2.x * tA.x + x1.x * tA.y;
                            o1.y = x1.y * tA.z - x2.y * tA.w; o2.y = x2.y * tA.z + x1.y * tA.w;
                            o1.z = x1.z * tB.x - x2.z * tB.y; o2.z = x2.z * tB.x + x1.z * tB.y;
                            o1.w = x1.w * tB.z - x2.w * tB.w; o2.w = x2.w * tB.z + x1.w * tB.w;
                        } else { o1 = x1; o2 = x2; }
                    }
                    u32x4 w; w.x = cvt_pk_bf16(o1.x, o1.y); w.y = cvt_pk_bf16(o1.z, o1.w); w.z = cvt_pk_bf16(o2.x, o2.y); w.w = cvt_pk_bf16(o2.z, o2.w);
                    *(u32x4*)(rowp + bj * HALF) = w;
                }
            }
    }
};
}

DI int perm_half(int i, int half) { return i < half ? 8 * (i >> 2) + (i & 3) : 8 * ((i - half) >> 2) + 4 + (i & 3); }
DI int phys_in(int c) {
    if (c < 1280) return c;
    if (c < 1344) return C_KR + perm_half(c - 1280, 32);
    if (c < 2368) return C_GA + (c - 1344);
    if (c < 4416) { const int i0 = c - 2368; return C_QB + (i0 & ~127) + perm_half(i0 & 127, 64); }
    if (c < 5440) return C_VB + (c - 4416);
    return C_GB + (c - 5440);
}
DI int phys_uq(int c) { const int h = c / 192, i = c - 192 * h; return i < 128 ? 128 * h + i : 1024 + 64 * h + perm_half(i - 128, 32); }
template <int MODE>
DI void p0_transpose_item(const float* W, int K, int N, bf16_t* WT, LAS float* scr, int item, int lane, const float* gain) {
    const int nblk = N / 32, kb = item / nblk, nb = item % nblk, k0 = 64 * kb, n0 = 32 * nb;
    f32x4 wv[8];
#pragma unroll
    for (int i = 0; i < 8; ++i) wv[i] = *(const f32x4*)(W + (size_t)(k0 + 8 * i + (lane >> 3)) * N + n0 + 4 * (lane & 7));
#pragma unroll
    for (int i = 0; i < 8; ++i) { LAS float* d = scr + (8 * i + (lane >> 3)) * 33 + 4 * (lane & 7); d[0] = wv[i].x; d[1] = wv[i].y; d[2] = wv[i].z; d[3] = wv[i].w; }
    asm volatile("s_waitcnt lgkmcnt(0)" ::: "memory");
    const int c = lane & 7;
#pragma unroll
    for (int j = 0; j < 4; ++j) { const int n = (lane >> 3) + 8 * j; const LAS float* s = scr + (8 * c) * 33 + n;
        f32x4 ga = (f32x4){1.f, 1.f, 1.f, 1.f}, gb = ga;
        if (gain) { ga = *(const f32x4*)(gain + k0 + 8 * c); gb = *(const f32x4*)(gain + k0 + 8 * c + 4); }
        u32x4 o; o.x = pk2(s[0 * 33] * ga.x, s[1 * 33] * ga.y); o.y = pk2(s[2 * 33] * ga.z, s[3 * 33] * ga.w); o.z = pk2(s[4 * 33] * gb.x, s[5 * 33] * gb.y); o.w = pk2(s[6 * 33] * gb.z, s[7 * 33] * gb.w);
        const int nr = MODE == 1 ? phys_in(n0 + n) : (MODE == 2 ? phys_uq(n0 + n) : n0 + n);
        *(u32x4*)(WT + (size_t)nr * K + k0 + 8 * c) = o; }
    asm volatile("s_waitcnt lgkmcnt(0)" ::: "memory");
}
DI void phase0(const Params& p, LAS unsigned char* lds, int gw, int NGW, int lane, int wave, int part) {
    unsigned char* ws = p.ws;
    LAS float* scr = (LAS float*)(lds + wave * 16384);
    constexpr int I_IN = (DM / 64) * (NC / 32), I_UQ = (768 / 64) * (QA_W / 32), I_UKV = (512 / 64) * (KVA_W / 32), I_OUT = (DM / 64) * (DM / 32);
    constexpr int NITEMS = I_IN + I_UQ + I_UKV + I_OUT;
    const int it_lo = part == 0 ? 0 : I_IN, it_hi = part == 0 ? I_IN : NITEMS;
    for (int it = it_lo + gw; it < it_hi; it += NGW) {
        int r = it;
        if (r < I_IN) { p0_transpose_item<1>(p.in[2], DM, NC, (bf16_t*)(ws + WS_WIN), scr, r, lane, nullptr); continue; } r -= I_IN;
        if (r < I_UQ) { p0_transpose_item<2>(p.in[5], 768, QA_W, (bf16_t*)(ws + WS_WUQ), scr, r, lane, p.in[3]); continue; } r -= I_UQ;
        if (r < I_UKV) { p0_transpose_item<0>(p.in[6], 512, KVA_W, (bf16_t*)(ws + WS_WUKV), scr, r, lane, p.in[4]); continue; } r -= I_UKV;
        p0_transpose_item<0>(p.in[13], DM, DM, (bf16_t*)(ws + WS_WOUT), scr, r, lane, nullptr);
    }
    if (part == 1) return;
    const int gt = gw * 64 + lane, NGT = NGW * 64;
    for (int i = gt; i < 2 * TOK; i += NGT) ((float*)(ws + WS_SSQ))[i] = 0.f;
    if (gt < 320) ((float*)(ws + WS_GAINS))[gt] = gt < 128 ? p.in[9][gt] : (gt < 256 ? p.in[10][gt - 128] : p.in[8][128 + gt - 256]);
    {
        u32x4* z = (u32x4*)((bf16_t*)(ws + WS_WIN) + (size_t)NC * DM);
        for (int i = gt; i < (NCP - NC) * DM / 8; i += NGT) z[i] = (u32x4){0u, 0u, 0u, 0u};
    }
    for (int i = gt; i < SEQ * 96; i += NGT) {
        int s, j; float e; f32x2* dst;
        if (i < SEQ * 64) { s = i >> 6; j = i & 63; e = (float)(2 * j) * (1.0f / 128.0f); dst = (f32x2*)(ws + WS_TAB128) + i; }
        else { const int k = i - SEQ * 64; s = k >> 5; j = k & 31; e = (float)(2 * j) * (1.0f / 64.0f); dst = (f32x2*)(ws + WS_TAB64) + k; }
        const float inv = __builtin_amdgcn_exp2f(-e * 13.287712379549449f);
        const float ang = (float)s * inv;
        const double rev = (double)ang * 0.15915494309189535;
        const float fr = (float)(rev - rint(rev));
        *dst = (f32x2){__builtin_amdgcn_cosf(fr), __builtin_amdgcn_sinf(fr)};
    }
    const f32x4* g4 = (const f32x4*)p.in[1];
    for (int m = gw; m < TOK; m += NGW) {
        const f32x4* xr = (const f32x4*)(p.in[0] + (size_t)m * DM) + lane;
        f32x4 v[8]; float ss = 0.f;
#pragma unroll
        for (int j = 0; j < 8; ++j) { v[j] = __builtin_nontemporal_load(xr + 64 * j); ss += (v[j].x * v[j].x + v[j].y * v[j].y) + (v[j].z * v[j].z + v[j].w * v[j].w); }
        const float rstd = rstd_of(wave_sum(ss), 1.0f / DM);
        u32x2* o8 = (u32x2*)((bf16_t*)(ws + WS_HN) + (size_t)m * DM) + lane;
#pragma unroll
        for (int j = 0; j < 8; ++j) { const f32x4 g = g4[64 * j + lane]; const f32x4 y = v[j] * rstd * g; o8[64 * j] = (u32x2){pk2(y.x, y.y), pk2(y.z, y.w)}; }
    }
}

DI void e1_row(const Params& p, int row, int lane, bool dry) {
    unsigned char* ws = p.ws;
    const int t = row & (SEQ - 1);
    u32x4* r16 = (u32x4*)((bf16_t*)(ws + WS_PROJ) + (size_t)row * NCP);
    const int c8 = lane & 7, c16 = lane & 15;
    const u32x4 vq0 = r16[lane], vq1 = lane < 32 ? r16[64 + lane] : (u32x4){0u, 0u, 0u, 0u};
    const u32x4 vkv = r16[96 + lane], vkr = r16[160 + c8];
    u32x4 vh[4];
#pragma unroll
    for (int it = 0; it < 4; ++it) vh[it] = r16[(C_QB / 8) + it * 64 + lane];
    const f32x4* tb64 = (const f32x4*)(ws + WS_TAB64) + (t * 32 + (c8 & 3) * 8) / 2;
    const f32x4* tb128 = (const f32x4*)(ws + WS_TAB128) + (t * 64 + (c16 & 7) * 8) / 2;
    if (dry) return;
    {
        f32x4 a0, b0, a1, b1; unpack8(vq0, a0, b0); unpack8(vq1, a1, b1);
        const float rstd = rstd_of(wave_sum(sumsq8(a0, b0) + sumsq8(a1, b1)), 1.0f / 768.0f);
        const f32x4* g = (const f32x4*)p.in[3];
        r16[lane] = pack8(a0 * rstd * g[2 * lane], b0 * rstd * g[2 * lane + 1]);
        if (lane < 32) r16[64 + lane] = pack8(a1 * rstd * g[2 * (64 + lane)], b1 * rstd * g[2 * (64 + lane) + 1]);
    }
    {
        f32x4 a, b; unpack8(vkv, a, b);
        const float rstd = rstd_of(wave_sum(sumsq8(a, b)), 1.0f / 512.0f);
        const f32x4* g = (const f32x4*)p.in[4];
        r16[96 + lane] = pack8(a * rstd * g[2 * lane], b * rstd * g[2 * lane + 1]);
    }
    {
        f32x4 a, b; unpack8(vkr, a, b);
        const float rstd = rstd_of(grp_sum8(sumsq8(a, b)), 1.0f / 64.0f);
        const f32x4* g = (const f32x4*)p.in[8] + 32;
        a = a * rstd * g[2 * c8]; b = b * rstd * g[2 * c8 + 1];
        rope8(a, b, 4, c8 < 4, tb64);
        if (lane < 8) r16[160 + c8] = pack8(a, b);
    }
#pragma unroll
    for (int it = 0; it < 4; ++it) {
        f32x4 a, b; unpack8(vh[it], a, b);
        const float rstd = rstd_of(grp_sum16(sumsq8(a, b)), 1.0f / 128.0f);
        const f32x4* g = (const f32x4*)(it < 2 ? p.in[9] : p.in[10]);
        a = a * rstd * g[2 * c16]; b = b * rstd * g[2 * c16 + 1];
        rope8(a, b, 8, c16 < 8, tb128);
        if (it < 2) { a = a * QSCALE_DIL; b = b * QSCALE_DIL; }
        r16[(C_QB / 8) + it * 64 + lane] = pack8(a, b);
    }
}

DI void e2_row(const Params& p, int row, int lane, bool dry) {
    unsigned char* ws = p.ws;
    const int t = row & (SEQ - 1);
    u32x4* q16 = (u32x4*)((bf16_t*)(ws + WS_QA) + (size_t)row * QA_W);
    u32x4* kv16 = (u32x4*)((bf16_t*)(ws + WS_KVA) + (size_t)row * KVA_W);
    const f32x4* gq = (const f32x4*)p.in[7];
    const f32x4* gk = (const f32x4*)p.in[8];
    u32x4* pq[2]; u32x4* pk[2]; u32x4 vq[2], vk[2];
#pragma unroll
    for (int it = 0; it < 2; ++it) { const int idx = it * 64 + lane, h = idx >> 4, c = idx & 15; pq[it] = q16 + h * 24 + c; pk[it] = kv16 + h * 32 + c; vq[it] = *pq[it]; vk[it] = *pk[it]; }
    const int hr = lane >> 3, cr = lane & 7;
    u32x4* pr = q16 + hr * 24 + 16 + cr; const u32x4 vr = *pr;
    const f32x4* tb64 = (const f32x4*)(ws + WS_TAB64) + (t * 32 + (cr & 3) * 8) / 2;
    if (dry) return;
#pragma unroll
    for (int it = 0; it < 2; ++it) {
        const int c = lane & 15;
        f32x4 a, b; unpack8(vq[it], a, b);
        const float rstd = rstd_of(grp_sum16(sumsq8(a, b)), 1.0f / 128.0f) * QSCALE_MLA;
        *pq[it] = pack8(a * rstd * gq[2 * c], b * rstd * gq[2 * c + 1]);
    }
    {
        f32x4 a, b; unpack8(vr, a, b);
        const float rstd = rstd_of(grp_sum8(sumsq8(a, b)), 1.0f / 64.0f);
        a = a * rstd * gq[32 + 2 * cr]; b = b * rstd * gq[32 + 2 * cr + 1];
        rope8(a, b, 4, cr < 4, tb64);
        f32x4 xa, xb;
        xa.x = __shfl_xor(a.x, 4); xa.y = __shfl_xor(a.y, 4); xa.z = __shfl_xor(a.z, 4); xa.w = __shfl_xor(a.w, 4);
        xb.x = __shfl_xor(b.x, 4); xb.y = __shfl_xor(b.y, 4); xb.z = __shfl_xor(b.z, 4); xb.w = __shfl_xor(b.w, 4);
        u32x4* prp = q16 + hr * 24 + 16 + (cr < 4 ? 2 * cr : 2 * (cr - 4) + 1);
        *prp = cr < 4 ? pack8(a * QSCALE_MLA, xa * QSCALE_MLA) : pack8(xb * QSCALE_MLA, b * QSCALE_MLA);
    }
#pragma unroll
    for (int it = 0; it < 2; ++it) {
        const int c = lane & 15;
        f32x4 a, b; unpack8(vk[it], a, b);
        const float rstd = rstd_of(grp_sum16(sumsq8(a, b)), 1.0f / 128.0f);
        *pk[it] = pack8(a * rstd * gk[2 * c], b * rstd * gk[2 * c + 1]);
    }
}

DI void e3_row(const Params& p, int row, int lane) {
    unsigned char* ws = p.ws;
    const u32x4* r16 = (const u32x4*)((const bf16_t*)(ws + WS_PROJ) + (size_t)row * NCP);
    u32x4* y16 = (u32x4*)((bf16_t*)(ws + WS_Y) + (size_t)row * DM);
    {
        const u32x4* o16 = (const u32x4*)((const bf16_t*)(ws + WS_OA) + (size_t)row * 1024);
        f32x4 a0, b0, a1, b1; unpack8(o16[lane], a0, b0); unpack8(o16[64 + lane], a1, b1);
        const float rstd = rstd_of(wave_sum(sumsq8(a0, b0) + sumsq8(a1, b1)), 1.0f / 1024.0f);
        const f32x4* g = (const f32x4*)p.in[11];
        f32x4 ga0, gb0, ga1, gb1; unpack8(r16[C_GA / 8 + lane], ga0, gb0); unpack8(r16[C_GA / 8 + 64 + lane], ga1, gb1);
        y16[lane] = pack8(a0 * rstd * g[2 * lane] * silu4(ga0), b0 * rstd * g[2 * lane + 1] * silu4(gb0));
        y16[64 + lane] = pack8(a1 * rstd * g[2 * (64 + lane)] * silu4(ga1), b1 * rstd * g[2 * (64 + lane) + 1] * silu4(gb1));
    }
    {
        const float* lse = (const float*)(ws + WS_LSE);
        f32x4 oa[2], ob[2]; float ss = 0.f;
#pragma unroll
        for (int j = 0; j < 2; ++j) {
            const int cidx = j * 64 + lane, h = cidx >> 4;
            const float l0 = lse[(size_t)row * 8 + h], l1 = lse[(size_t)TOK * 8 + (size_t)row * 8 + h], l2 = lse[(size_t)2 * TOK * 8 + (size_t)row * 8 + h];
            const float mx = fmaxf(l0, fmaxf(l1, l2));
            float w0 = __expf(l0 - mx), w1 = __expf(l1 - mx), w2 = __expf(l2 - mx);
            const float inv = 1.0f / (w0 + w1 + w2); w0 *= inv; w1 *= inv; w2 *= inv;
            f32x4 a, b, c, d, e, f;
            unpack8(((const u32x4*)((const bf16_t*)(ws + WS_OD1) + (size_t)row * 1024))[cidx], a, b);
            unpack8(((const u32x4*)((const bf16_t*)(ws + WS_OD2) + (size_t)row * 1024))[cidx], c, d);
            unpack8(((const u32x4*)((const bf16_t*)(ws + WS_OD3) + (size_t)row * 1024))[cidx], e, f);
            oa[j] = a * w0 + c * w1 + e * w2; ob[j] = b * w0 + d * w1 + f * w2;
            ss += sumsq8(oa[j], ob[j]);
        }
        const float rstd = rstd_of(wave_sum(ss), 1.0f / 1024.0f);
        const f32x4* g = (const f32x4*)p.in[12];
#pragma unroll
        for (int j = 0; j < 2; ++j) {
            const int cidx = j * 64 + lane;
            f32x4 ga, gb; unpack8(r16[C_GB / 8 + cidx], ga, gb);
            y16[128 + cidx] = pack8(oa[j] * rstd * g[2 * cidx] * silu4(ga), ob[j] * rstd * g[2 * cidx + 1] * silu4(gb));
        }
    }
}

DI void naive_attn_row(const bf16_t* q, const bf16_t* k1, size_t k1s, const bf16_t* k2, size_t k2s, const bf16_t* v, size_t vs,
                       int t, int d, int nkeys, bf16_t* o, float* lse, LAS float* qs, int lane) {
    const int DK = k2 ? 192 : 128;
    for (int i = lane; i < DK; i += 64) qs[i] = __uint_as_float((unsigned)q[i] << 16);
    asm volatile("s_waitcnt lgkmcnt(0)" ::: "memory");
    float m = -1e30f, l = 0.f, o0 = 0.f, o1 = 0.f;
    for (int c0 = 0; c0 < nkeys; c0 += 64) {
        const int ik = c0 + lane; const bool valid = ik < nkeys; const int j = valid ? t - d * ik : t;
        float s = 0.f;
        const u32x4* kp = (const u32x4*)(k1 + (size_t)j * k1s);
#pragma unroll 4
        for (int ch = 0; ch < 16; ++ch) { f32x4 a, b; unpack8(kp[ch], a, b); const LAS f32x4* qq = (const LAS f32x4*)(qs + ch * 8); const f32x4 qa = qq[0], qb = qq[1];
            s += (a.x * qa.x + a.y * qa.y) + (a.z * qa.z + a.w * qa.w) + (b.x * qb.x + b.y * qb.y) + (b.z * qb.z + b.w * qb.w); }
        if (k2) { const u32x4* kp2 = (const u32x4*)(k2 + (size_t)j * k2s);
#pragma unroll 4
            for (int ch = 0; ch < 8; ++ch) { f32x4 a, b; unpack8(kp2[ch], a, b); const LAS f32x4* qq = (const LAS f32x4*)(qs + 128 + ch * 8); const f32x4 qa = qq[0], qb = qq[1];
                s += (a.x * qa.x + a.y * qa.y) + (a.z * qa.z + a.w * qa.w) + (b.x * qb.x + b.y * qb.y) + (b.z * qb.z + b.w * qb.w); } }
        s = valid ? s : -1e30f;
        const float mn = fmaxf(m, wave_max(s)); const float corr = exp2f(m - mn); const float pe = valid ? exp2f(s - mn) : 0.f;
        l = l * corr + wave_sum(pe); o0 *= corr; o1 *= corr; m = mn;
        const int cnt = min(64, nkeys - c0);
        for (int i = 0; i < cnt; ++i) { const float pi = __shfl(pe, i); const int jj = t - d * (c0 + i);
            const unsigned vv = *(const unsigned*)(v + (size_t)jj * vs + 2 * lane); o0 += pi * bflo(vv); o1 += pi * bfhi(vv); }
    }
    const float il = 1.0f / l;
    *(unsigned*)(o + 2 * lane) = pk2(o0 * il, o1 * il);
    if (lse && lane == 0) *lse = (m + log2f(l)) * LN2;
    asm volatile("s_waitcnt lgkmcnt(0)" ::: "memory");
}
DI void phase5_naive(const Params& p, LAS unsigned char* lds, int gw, int NGW, int lane, int wave, int type_lo, int type_hi) {
    unsigned char* ws = p.ws;
    LAS float* qs = (LAS float*)(lds + wave * 1024);
    const bf16_t* proj = (const bf16_t*)(ws + WS_PROJ); const bf16_t* qa = (const bf16_t*)(ws + WS_QA); const bf16_t* kva = (const bf16_t*)(ws + WS_KVA);
    for (int item = type_lo * TOK * 8 + gw; item < type_hi * TOK * 8; item += NGW) {
        const int type = item / (TOK * 8), rem = item % (TOK * 8), row = rem >> 3, h = rem & 7, b = row >> 12, t = row & (SEQ - 1);
        const size_t brow = (size_t)b * SEQ;
        if (type == 0) {
            naive_attn_row(qa + (size_t)row * QA_W + h * 192, kva + brow * KVA_W + h * 256, KVA_W, proj + brow * NCP + C_KR, NCP, kva + brow * KVA_W + h * 256 + 128, KVA_W,
                           t, 1, t + 1, (bf16_t*)(ws + WS_OA) + (size_t)row * 1024 + h * 128, nullptr, qs, lane);
        } else {
            const int pidx = type - 1, d = pidx == 0 ? 1 : (pidx == 1 ? 4 : 16);
            bf16_t* od = (bf16_t*)(ws + (pidx == 0 ? WS_OD1 : (pidx == 1 ? WS_OD2 : WS_OD3)));
            naive_attn_row(proj + (size_t)row * NCP + C_QB + h * 128, proj + brow * NCP + C_KB + h * 128, NCP, nullptr, 0, proj + brow * NCP + C_VB + h * 128, NCP,
                           t, d, min(t / d, 128) + 1, od + (size_t)row * 1024 + h * 128, (float*)(ws + WS_LSE) + (size_t)pidx * TOK * 8 + (size_t)row * 8 + h, qs, lane);
        }
    }
}

namespace fa {
typedef short bf16x8 __attribute__((ext_vector_type(8)));
typedef short s16x4 __attribute__((ext_vector_type(4)));
typedef float f32x16 __attribute__((ext_vector_type(16)));
#define FA_MFMA(a, b, c) __builtin_amdgcn_mfma_f32_32x32x16_bf16((a), (b), (c), 0, 0, 0)
struct Unit {
    const bf16_t* q; const bf16_t* q2; unsigned qs; const bf16_t* k1; unsigned k1s; const bf16_t* k2; unsigned k2s; const bf16_t* v; unsigned vs;
    bf16_t* o; unsigned os; float* lse; unsigned lses; int l0, kt_begin, W;
};
DI unsigned v_off(int row, int ch) { return 2048u * (row >> 3) + 512u * (ch >> 2) + 64u * (row & 7) + 16u * ((ch & 3) ^ ((row >> 2) & 3)); }

template <int DK>
DI void unit_run(const Unit& u, LAS unsigned char* lds, int tid, int lane, int wave) {
    constexpr int NKS = DK / 16;
    constexpr int K1BYTES = 64 * 256, K2BYTES = (DK == 192) ? 64 * 128 : 0, KBYTES = K1BYTES + K2BYTES, VBYTES = 64 * 256, STAGE = KBYTES + VBYTES;
    const int hi = lane >> 5, l31 = lane & 31;
    const int wq0 = u.l0 + 32 * wave, W = u.W;
    bf16x8 qf[NKS];
    if constexpr (DK == 192) {
        const unsigned qo = (unsigned)(wq0 + l31) * u.qs + 8u * hi;
#pragma unroll
        for (int ks = 0; ks < NKS; ++ks) qf[ks] = ks < 8 ? *(const bf16x8*)(u.q + (qo + 16u * ks)) : *(const bf16x8*)(u.q2 + (qo + 16u * (ks - 8)));
    } else {
#pragma unroll
        for (int n = 0; n < 8; ++n) { const int sl = n * 64 + lane, row = sl >> 4, cc = (sl & 15) ^ (row & 15);
            __builtin_amdgcn_global_load_lds((const unsigned*)(u.q + ((unsigned)(wq0 + row) * u.qs + 8u * cc)), (LAS unsigned*)(lds + 65536 + wave * 8192 + n * 1024), 16, 0, 0); }
    }
    const int ntiles = (u.l0 + 256 - u.kt_begin) >> 6;
#define FA_DMA(kt, st) do { LAS unsigned char* sb_ = lds + (st) * STAGE; \
        _Pragma("unroll") for (int n = 0; n < 2; ++n) { \
            { const int s = (2 * wave + n) * 64 + lane, row = s >> 4, cc = (s & 15) ^ (row & 15); \
              __builtin_amdgcn_global_load_lds((const unsigned*)(u.k1 + ((unsigned)((kt) + row) * u.k1s + 8u * cc)), (LAS unsigned*)(sb_ + (2 * wave + n) * 1024), 16, 0, 0); } \
            { const int s = (2 * wave + n) * 64 + lane, row = 8 * (s >> 7) + ((s >> 2) & 7), ch = 4 * ((s >> 5) & 3) + ((s & 3) ^ ((row >> 2) & 3)); \
              __builtin_amdgcn_global_load_lds((const unsigned*)(u.v + ((unsigned)((kt) + row) * u.vs + 8u * ch)), (LAS unsigned*)(sb_ + KBYTES + (2 * wave + n) * 1024), 16, 0, 0); } } \
        if (DK == 192) { const int s = wave * 64 + lane, row = s >> 3, cc = (s & 7) ^ ((row >> 1) & 7); \
            __builtin_amdgcn_global_load_lds((const unsigned*)(u.k2 + ((unsigned)((kt) + row) * u.k2s + 8u * cc)), (LAS unsigned*)(sb_ + K1BYTES + wave * 1024), 16, 0, 0); } } while (0)
    FA_DMA(u.kt_begin, 0);
    __syncthreads();
    if constexpr (DK == 128) {
        const unsigned xq1 = (unsigned)(l31 & 15), qa1 = (unsigned)(65536 + wave * 8192 + l31 * 256) + 16u * ((hi ^ xq1) & 1u), qx1 = 16u * (xq1 & 14u);
#pragma unroll
        for (int ks = 0; ks < NKS; ++ks) qf[ks] = *(const LAS bf16x8*)(lds + qa1 + ((32u * ks) ^ qx1));
    }
    f32x16 O[4];
#pragma unroll
    for (int c = 0; c < 4; ++c)
#pragma unroll
        for (int r = 0; r < 16; ++r) O[c][r] = 0.f;
    float m = -1e30f, l = 0.f;
    const unsigned x1 = (unsigned)(l31 & 15), x2 = (unsigned)((l31 >> 1) & 7);
    const unsigned ka1 = (unsigned)(l31 * 256) + 16u * ((hi ^ x1) & 1u), kx1 = 16u * (x1 & 14u);
    const unsigned ka2 = (unsigned)(K1BYTES + l31 * 128) + 16u * ((hi ^ x2) & 1u), kx2 = 16u * (x2 & 6u);
    const int q4 = (lane & 15) >> 2, p4 = lane & 3, blk = (lane >> 4) & 1;
    const unsigned va0 = (unsigned)(KBYTES + 64 * (4 * hi + q4) + 16 * ((2 * blk + (p4 >> 1)) ^ (hi)) + 8 * (p4 & 1));
    const unsigned va1 = (unsigned)(KBYTES + 64 * (4 * hi + q4) + 16 * ((2 * blk + (p4 >> 1)) ^ (2 + hi)) + 8 * (p4 & 1));
    for (int it = 0; it < ntiles; ++it) {
        const int kt0 = u.kt_begin + 64 * it, cur = it & 1;
        if (it + 1 < ntiles) FA_DMA(kt0 + 64, cur ^ 1);
        const bool relevant = (kt0 <= wq0 + 31) && (kt0 + 63 >= wq0 - W);
        if (relevant) {
            const LAS unsigned char* sb = lds + cur * STAGE;
            f32x16 S0, S1;
#pragma unroll
            for (int r = 0; r < 16; ++r) { S0[r] = 0.f; S1[r] = 0.f; }
#pragma unroll
            for (int ks = 0; ks < NKS; ++ks) {
                const unsigned ko = ks < 8 ? ka1 + ((32u * ks) ^ kx1) : ka2 + ((32u * (ks - 8)) ^ kx2);
                S0 = FA_MFMA(*(const LAS bf16x8*)(sb + ko), qf[ks], S0);
            }
#pragma unroll
            for (int ks = 0; ks < NKS; ++ks) {
                const unsigned ko = ks < 8 ? ka1 + ((32u * ks) ^ kx1) : ka2 + ((32u * (ks - 8)) ^ kx2);
                S1 = FA_MFMA(*(const LAS bf16x8*)(sb + ko + (ks < 8 ? 32 * 256 : 32 * 128)), qf[ks], S1);
            }
            const bool needmask = !((kt0 + 63 <= wq0) && (kt0 >= wq0 + 31 - W));
            const int dq = wq0 + l31 - kt0 - 4 * hi;
#define FA_HALF(S, KB) do { \
            if (needmask) { _Pragma("unroll") for (int r = 0; r < 16; ++r) { const int d0 = dq - 32 * (KB) - ((r & 3) + 8 * (r >> 2)); S[r] = (d0 >= 0 && d0 <= W) ? S[r] : -INFINITY; } } \
            float mx = fmaxf(S[0], S[1]); \
            _Pragma("unroll") for (int r = 2; r < 16; ++r) mx = fmaxf(mx, S[r]); \
            mx = fmaxf(mx, __shfl_xor(mx, 32)); \
            if (__builtin_amdgcn_ballot_w64(mx > m + 8.0f) != 0ull) {         \
                const float mn = fmaxf(m, mx); const float corr = __builtin_amdgcn_exp2f(m - mn); m = mn; l *= corr; \
                _Pragma("unroll") for (int c = 0; c < 4; ++c) _Pragma("unroll") for (int r = 0; r < 16; ++r) O[c][r] *= corr; } \
            float ps = 0.f; \
            _Pragma("unroll") for (int r = 0; r < 16; ++r) { S[r] = __builtin_amdgcn_exp2f(S[r] - m); ps += S[r]; } \
            l += ps; \
            bf16x8 P[2]; \
            _Pragma("unroll") for (int j = 0; j < 2; ++j) { u32x4 w; w.x = pk2(S[8 * j + 0], S[8 * j + 1]); w.y = pk2(S[8 * j + 2], S[8 * j + 3]); w.z = pk2(S[8 * j + 4], S[8 * j + 5]); w.w = pk2(S[8 * j + 6], S[8 * j + 7]); \
                P[j] = __builtin_bit_cast(bf16x8, w); } \
            _Pragma("unroll") for (int j = 0; j < 2; ++j) _Pragma("unroll") for (int c = 0; c < 4; ++c) { \
                const s16x4 lo = __builtin_amdgcn_ds_read_tr16_b64_v4i16((LAS s16x4*)(sb + va0 + 2048 * (4 * (KB) + 2 * j) + 512 * c)); \
                const s16x4 hv = __builtin_amdgcn_ds_read_tr16_b64_v4i16((LAS s16x4*)(sb + va1 + 2048 * (4 * (KB) + 2 * j + 1) + 512 * c)); \
                O[c] = FA_MFMA(__builtin_shufflevector(lo, hv, 0, 1, 2, 3, 4, 5, 6, 7), P[j], O[c]); } } while (0)
            FA_HALF(S0, 0);
            FA_HALF(S1, 1);
#undef FA_HALF
        }
        __syncthreads();
    }
#undef FA_DMA
    l += __shfl_xor(l, 32);
    const float il = 1.0f / l;
    LAS unsigned char* og = lds + wave * 8704;
#pragma unroll
    for (int c = 0; c < 4; ++c)
#pragma unroll
        for (int g = 0; g < 4; ++g) {
            u32x2 w; w.x = pk2(O[c][4 * g + 0] * il, O[c][4 * g + 1] * il); w.y = pk2(O[c][4 * g + 2] * il, O[c][4 * g + 3] * il);
            *(LAS u32x2*)(og + l31 * 272 + 2 * (32 * c + 8 * g + 4 * hi)) = w;
        }
    asm volatile("s_waitcnt lgkmcnt(0)" ::: "memory");
#pragma unroll
    for (int i = 0; i < 8; ++i) {
        const int row = (lane >> 4) + 4 * i;
        const u32x4 v = *(const LAS u32x4*)(og + row * 272 + 16 * (lane & 15));
        *(u32x4*)(u.o + ((unsigned)(wq0 + row) * u.os + 8u * (lane & 15))) = v;
    }
    if (u.lse && hi == 0) u.lse[(unsigned)(wq0 + l31) * u.lses] = (m + __builtin_amdgcn_logf(l)) * LN2;
    asm volatile("s_waitcnt lgkmcnt(0)" ::: "memory"); __builtin_amdgcn_s_barrier(); asm volatile("" ::: "memory");
}
}

DI void phase5_fast(const Params& p, LAS unsigned char* lds) {
    int tid = threadIdx.x; asm volatile("" : "+v"(tid));
    const int lane = tid & 63, wave = __builtin_amdgcn_readfirstlane(tid >> 6);
    unsigned char* ws = p.ws;
    const int G = gridDim.x, bid = blockIdx.x;
    const bf16_t* proj = (const bf16_t*)(ws + WS_PROJ); const bf16_t* qa = (const bf16_t*)(ws + WS_QA); const bf16_t* kva = (const bf16_t*)(ws + WS_KVA);
    if (FAST_MLA) for (int pi = bid; pi < 256; pi += G) {
        const int vv = pi >> 3, bh = (pi & 7) * 4 + (vv >> 3), j = vv & 7, b = bh >> 3, h = bh & 7;
        const size_t brow = (size_t)b * SEQ;
#pragma unroll 1
        for (int s = 0; s < 2; ++s) {
            const int qb = s == 0 ? 15 - j : j;
            fa::Unit u;
            u.q = qa + brow * QA_W + h * 128; u.q2 = qa + brow * QA_W + 1024 + h * 64; u.qs = QA_W;
            u.k1 = kva + brow * KVA_W + h * 256; u.k1s = KVA_W; u.k2 = proj + brow * NCP + C_KR; u.k2s = NCP;
            u.v = kva + brow * KVA_W + h * 256 + 128; u.vs = KVA_W;
            u.o = (bf16_t*)(ws + WS_OA) + brow * 1024 + h * 128; u.os = 1024; u.lse = nullptr; u.lses = 0;
            u.l0 = 256 * qb; u.kt_begin = 0; u.W = 1 << 30;
            fa::unit_run<192>(u, lds, tid, lane, wave);
        }
    }
    if (FAST_DIL)
#pragma unroll 1
    for (int ui = bid; ui < 1536; ui += G) {
        int pidx, b, h, sub;
        if (G == 256) { const int i6 = ui >> 8, x8 = ui & 7, k32 = (ui >> 3) & 31, bh = 4 * x8 + 2 * (i6 / 3) + (k32 >> 4); pidx = i6 % 3; b = bh >> 3; h = bh & 7; sub = k32 & 15; }
        else { const int xq = ui & 7, yq = (ui >> 3) & 31, grp = (ui >> 8) * 32 + (yq >> 3) * 8 + xq; h = yq & 7; pidx = grp >> 6; b = (grp >> 4) & 3; sub = grp & 15; }
        const int d = pidx == 0 ? 1 : (pidx == 1 ? 4 : 16), nub = 16 / d, r = sub / nub, ub = sub % nub;
        const size_t row0 = (size_t)b * SEQ + r;
        fa::Unit u;
        u.q = proj + row0 * NCP + C_QB + h * 128; u.q2 = nullptr; u.qs = (unsigned)d * NCP;
        u.k1 = proj + row0 * NCP + C_KB + h * 128; u.k1s = (unsigned)d * NCP; u.k2 = nullptr; u.k2s = 0;
        u.v = proj + row0 * NCP + C_VB + h * 128; u.vs = (unsigned)d * NCP;
        u.o = (bf16_t*)(ws + (pidx == 0 ? WS_OD1 : (pidx == 1 ? WS_OD2 : WS_OD3))) + row0 * 1024 + h * 128; u.os = (unsigned)d * 1024;
        u.lse = (float*)(ws + WS_LSE) + (size_t)pidx * TOK * 8 + row0 * 8 + h; u.lses = (unsigned)d * 8;
        u.l0 = 256 * ub; u.kt_begin = u.l0 >= 128 ? u.l0 - 128 : 0; u.W = 128;
        fa::unit_run<128>(u, lds, tid, lane, wave);
    }
}

#define XB_TMO      128
#define XB_XCNT(j)  (256  + 64 * (j))
#define XB_XSUB(j)  (1280 + 64 * (j))
#define XB_XGEN(j)  (2304 + 64 * (j))
#define XB_TOP      3328
#define XB_TOPGEN   3392
#define XCD_BAR_WORDS 3456
#define XB_SPIN_CAP (1u << 18)

__device__ __forceinline__ unsigned xb_ld(unsigned* p)              { return __hip_atomic_load(p, __ATOMIC_RELAXED, __HIP_MEMORY_SCOPE_AGENT); }
__device__ __forceinline__ unsigned xb_add(unsigned* p, unsigned v) { return __hip_atomic_fetch_add(p, v, __ATOMIC_RELAXED, __HIP_MEMORY_SCOPE_AGENT); }
__device__ __forceinline__ unsigned xb_xcc_id() { return (unsigned)__builtin_amdgcn_s_getreg((3 << 11) | 20) & 0xFu; }
#define XB_SPIN(cond, bar) do { unsigned _sp = 0; while (cond) { __builtin_amdgcn_s_sleep(1); \
    if ((++_sp & 255u) == 0u) { if (xb_ld(&(bar)[XB_TMO])) break; if (_sp > XB_SPIN_CAP) { atomicAdd(&(bar)[XB_TMO], 1u); break; } } } } while (0)

struct XcdBarrier {
    unsigned* bar; unsigned x;
    volatile LAS unsigned* st;
};

__device__ __forceinline__ XcdBarrier xcd_barrier_post(unsigned* bar, volatile LAS unsigned* st) {
    XcdBarrier b; b.bar = bar; b.x = xb_xcc_id(); b.st = st;
    if (threadIdx.x == 0) (void)xb_add(&bar[XB_XCNT(b.x)], 1u);
    return b;
}
__device__ __forceinline__ void xcd_barrier_complete(unsigned* bar, unsigned x, unsigned& nloc, unsigned& nx) {
    const unsigned G = gridDim.x * gridDim.y * gridDim.z;
    unsigned sum, cnt, mine, sp = 0u;
    for (;;) {
        sum = 0u; cnt = 0u; mine = 0u;
#pragma unroll
        for (unsigned j = 0; j < 16; ++j) { const unsigned c = xb_ld(&bar[XB_XCNT(j)]); sum += c; cnt += (c > 0u) ? 1u : 0u; mine = (j == x) ? c : mine; }
        if (sum == G) break;
        __builtin_amdgcn_s_sleep(1);
        if ((++sp & 255u) == 0u) { if (xb_ld(&bar[XB_TMO])) break; if (sp > XB_SPIN_CAP) { atomicAdd(&bar[XB_TMO], 1u); break; } }
    }
    nloc = mine > 0u ? mine : 1u; nx = cnt > 0u ? cnt : 1u;
}

__device__ __forceinline__ void xcd_barrier(const XcdBarrier& b) {
    asm volatile("s_waitcnt vmcnt(0)" ::: "memory");
    __syncthreads();
    if (threadIdx.x == 0) {
        unsigned* bar = b.bar;
        __builtin_amdgcn_s_waitcnt(0);
        unsigned nloc = b.st[0], nx = b.st[1];
        if (nloc == 0u) { xcd_barrier_complete(bar, b.x, nloc, nx); b.st[0] = nloc; b.st[1] = nx; }
        const unsigned old = xb_add(&bar[XB_XSUB(b.x)], 1u);
        const unsigned gen = old / nloc;
        if (old + 1u == (gen + 1u) * nloc) {
            __builtin_amdgcn_fence(__ATOMIC_RELEASE, "agent");
            asm volatile("s_waitcnt vmcnt(0)" ::: "memory");
            const unsigned og = xb_add(&bar[XB_TOP], 1u);
            const unsigned tg = og / nx;
            if (og + 1u == (tg + 1u) * nx) xb_add(&bar[XB_TOPGEN], 1u);
            else XB_SPIN(xb_ld(&bar[XB_TOPGEN]) == tg, bar);
            __builtin_amdgcn_fence(__ATOMIC_ACQUIRE, "agent");
            xb_add(&bar[XB_XGEN(b.x)], 1u);
            asm volatile("s_waitcnt vmcnt(0)" ::: "memory");
        } else {
            XB_SPIN(xb_ld(&bar[XB_XGEN(b.x)]) == gen, bar);
            __builtin_amdgcn_fence(__ATOMIC_ACQUIRE, "agent");
            asm volatile("s_waitcnt vmcnt(0)" ::: "memory");
        }
    }
    __syncthreads();
}

__global__ void __launch_bounds__(512, 2) fwd_kernel(Params p) {
    extern __shared__ __attribute__((aligned(16))) unsigned char lds_raw[];
    LAS unsigned char* lds = (LAS unsigned char*)lds_raw;
    cg::grid_group grid = cg::this_grid();
    const int tid = threadIdx.x, lane = tid & 63, wave = __builtin_amdgcn_readfirstlane(tid >> 6);
    const int G = gridDim.x, gw = blockIdx.x * 8 + wave, NGW = G * 8;
    unsigned char* ws = p.ws;
    const int lo = p.ph_lo, hi = p.ph_hi;
#define IN(k) (lo <= (k) && (k) < hi)
#ifndef COOP_SEAM
#define COOP_SEAM -1
#endif
    volatile LAS unsigned* bst = (volatile LAS unsigned*)(lds + LDS_BYTES - 64);
    if (tid == 0) { bst[0] = 0u; bst[1] = 0u; }
    __syncthreads();
    XcdBarrier bar = xcd_barrier_post((unsigned*)(ws + WS_CTL), bst);
    if (p.ph_lo < 0) grid.sync();
    unsigned long long t0_ = 0, t1_ = 0;
#define PB0(k) do { if (PROBE_PHASE == (k)) t0_ = __builtin_amdgcn_s_memrealtime(); } while (0)
#define PB1(k) do { if (PROBE_PHASE == (k)) t1_ = __builtin_amdgcn_s_memrealtime(); } while (0)
#define SEAM(k) do { if (IN(k) && IN((k) + 1)) { if ((k) == COOP_SEAM) grid.sync(); else xcd_barrier(bar); } } while (0)

    PB0(0);
    for (int rep_ = 0; rep_ < (DUP_PHASE == 0 ? 2 : 1); ++rep_) if (IN(0)) { phase0(p, lds, gw, NGW, lane, wave, 0); } SEAM(0); PB1(0);

    PB0(1);
    for (int rep_ = 0; rep_ < (DUP_PHASE == 1 ? 2 : 1); ++rep_) if (IN(1)) {
        pg8::Gemm g{(const bf16_t*)(ws + WS_HN), (const bf16_t*)(ws + WS_WIN), TOK, NCP, DM, DM}; pg8::StaticOrder S; S.init(TOK, NCP, G, (int)blockIdx.x);
        pg8::EpiProj E{(bf16_t*)(ws + WS_PROJ), (float*)(ws + WS_SSQ), (const float*)(ws + WS_GAINS), (const f32x4*)(ws + WS_TAB128), (LAS float*)(lds + XCH_OFF)};
        pg8::gemm_phase<pg8::EpiProj, pg8::StaticOrder, PG8_ALIGN, PG8_SP2>(lds, g, S, E);
        const int nfull = (TOK / 256) * (NCP / 256) % G, nidle = nfull == 0 ? G : G - nfull;
        if (nfull == 0 || (int)blockIdx.x >= nfull) phase0(p, lds, ((int)blockIdx.x - (nfull == 0 ? 0 : nfull)) * 8 + wave, nidle * 8, lane, wave, 1);
    } SEAM(1); PB1(1);


    PB0(3);
    for (int rep_ = 0; rep_ < (DUP_PHASE == 3 ? 2 : 1); ++rep_) if (IN(3)) {
        { pg8::Gemm g{(const bf16_t*)(ws + WS_PROJ) + C_CQ, (const bf16_t*)(ws + WS_WUQ), TOK, QA_W, 768, NCP}; pg8::StaticOrder S; S.init(TOK, QA_W, G, (int)blockIdx.x);
          pg8::EpiUp<0> E{(bf16_t*)(ws + WS_QA), QA_W, (const float*)(ws + WS_SSQ), 1.0f / 768.0f, p.in[7], (const f32x4*)(ws + WS_TAB64), (LAS float*)(lds + XCH_OFF)};
          pg8::gemm_phase<pg8::EpiUp<0>, pg8::StaticOrder, PG8_ALIGN, PG8_SP2>(lds, g, S, E); }
        __syncthreads();
        { pg8::Gemm g{(const bf16_t*)(ws + WS_PROJ) + C_CKV, (const bf16_t*)(ws + WS_WUKV), TOK, KVA_W, 512, NCP}; pg8::StaticOrder S; S.init(TOK, KVA_W, G, (int)blockIdx.x);
          pg8::EpiUp<1> E{(bf16_t*)(ws + WS_KVA), KVA_W, (const float*)(ws + WS_SSQ) + TOK, 1.0f / 512.0f, p.in[8], (const f32x4*)(ws + WS_TAB64), (LAS float*)(lds + XCH_OFF)};
          pg8::gemm_phase<pg8::EpiUp<1>, pg8::StaticOrder, PG8_ALIGN, PG8_SP2>(lds, g, S, E); }
    } SEAM(3); PB1(3);


    PB0(5);
    for (int rep_ = 0; rep_ < (DUP_PHASE == 5 ? 2 : 1); ++rep_) if (IN(5)) {
        if (!FAST_MLA) phase5_naive(p, lds, gw, NGW, lane, wave, 0, 1);
        if (!FAST_DIL) phase5_naive(p, lds, gw, NGW, lane, wave, 1, 4);
        if (FAST_MLA || FAST_DIL) { __syncthreads(); phase5_fast(p, lds); }
    } SEAM(5); PB1(5);

    PB0(6);
    for (int rep_ = 0; rep_ < (DUP_PHASE == 6 ? 2 : 1); ++rep_) if (IN(6)) { for (int m = gw; m < TOK; m += NGW) e3_row(p, m, lane); } SEAM(6); PB1(6);

    PB0(7);
    for (int rep_ = 0; rep_ < (DUP_PHASE == 7 ? 2 : 1); ++rep_) if (IN(7)) {
        pg8::Gemm g{(const bf16_t*)(ws + WS_Y), (const bf16_t*)(ws + WS_WOUT), TOK, DM, DM, DM}; pg8::StaticOrder S; S.init(TOK, DM, G, (int)blockIdx.x);
        pg8::EpiResF32 E{p.in[0], p.out, DM};
        pg8::gemm_phase<pg8::EpiResF32, pg8::StaticOrder, PG8_ALIGN, PG8_SP2>(lds, g, S, E);
    }
    if (PROBE_PHASE >= 0 && hi - lo > 1) {
        xcd_barrier(bar); PB1(7);
        if (blockIdx.x == 0 && tid == 0) p.out[0] += (float)(t1_ - t0_) * 0.01f;
    }
#if defined(EXTRA_SYNCS)
    if (hi - lo > 1) for (int i = 0; i < EXTRA_SYNCS; ++i) xcd_barrier(bar);
#endif
#undef IN
#undef SEAM
}

extern "C" void kernel_launch(void* const* d_in, const int* in_sizes, int n_in, void* d_out, int out_size, void* d_ws, size_t ws_size, hipStream_t stream) {
    static int grid = 0;
    if (grid == 0) {
        if (n_in != 14 || in_sizes[0] != TOK * DM || out_size != TOK * DM || ws_size < WS_END) {
            fprintf(stderr, "kernel_launch: unexpected shapes: n_in %d in0 %d out %d ws %zu (need %zu)\n", n_in, n_in > 0 ? in_sizes[0] : -1, out_size, ws_size, (size_t)WS_END); grid = -1; return; }
        int dev = 0, cus = 0, per_cu = 0;
        if (hipGetDevice(&dev) != hipSuccess || hipDeviceGetAttribute(&cus, hipDeviceAttributeMultiprocessorCount, dev) != hipSuccess) { fprintf(stderr, "kernel_launch: device query failed\n"); grid = -1; return; }
        if (hipFuncSetAttribute((const void*)fwd_kernel, hipFuncAttributeMaxDynamicSharedMemorySize, LDS_BYTES) != hipSuccess) { fprintf(stderr, "kernel_launch: hipFuncSetAttribute failed\n"); grid = -1; return; }
        if (hipOccupancyMaxActiveBlocksPerMultiprocessor(&per_cu, (const void*)fwd_kernel, 512, LDS_BYTES) != hipSuccess || per_cu < 1) { fprintf(stderr, "kernel_launch: occupancy query says %d blocks per CU\n", per_cu); (void)hipGetLastError(); grid = -1; return; }
        grid = cus * 1;
        fprintf(stderr, "kernel_launch: cus %d per_cu %d grid %d\n", cus, per_cu, grid);
    }
    if (grid < 0) return;
    if (hipMemsetAsync((char*)d_ws + WS_CTL, 0, CTL_BYTES, stream) != hipSuccess) { fprintf(stderr, "kernel_launch: memset of the barrier words failed\n"); return; }
    Params p{};
    for (int i = 0; i < 14; ++i) p.in[i] = (const float*)d_in[i];
    p.out = (float*)d_out; p.ws = (unsigned char*)d_ws;
#if MK_N_LAUNCHES == 1
    p.ph_lo = 0; p.ph_hi = NPH;
    void* args[] = {&p};
#if defined(PLAIN_LAUNCH)
    (void)args; hipLaunchKernelGGL(fwd_kernel, dim3(grid), dim3(512), LDS_BYTES, stream, p); const hipError_t e = hipPeekAtLastError();
#else
    const hipError_t e = hipLaunchCooperativeKernel((const void*)fwd_kernel, dim3(grid), dim3(512), args, LDS_BYTES, stream);
#endif
    if (e != hipSuccess) fprintf(stderr, "kernel_launch: cooperative launch failed: %s (grid %d)\n", hipGetErrorString(e), grid);
#else
    for (int ph = 0; ph < NPH; ++ph) {
        p.ph_lo = ph; p.ph_hi = ph + 1;
        hipLaunchKernelGGL(fwd_kernel, dim3(grid), dim3(512), LDS_BYTES, stream, p);
        const hipError_t e = hipPeekAtLastError();
        if (e != hipSuccess) { fprintf(stderr, "kernel_launch: launch %d failed: %s\n", ph, hipGetErrorName(e)); break; }
    }
#endif
}
```

```cpp
#include <hip/hip_runtime.h>
#include <hip/hip_cooperative_groups.h>
#include <cstdio>
#include <cstdint>
namespace cg = cooperative_groups;
namespace pg8 {
#define PG8_LAS __attribute__((address_space(3)))
typedef unsigned short bf16_t;
typedef short bf16x8 __attribute__((ext_vector_type(8)));
typedef float f32x4 __attribute__((ext_vector_type(4)));
typedef unsigned u32x4 __attribute__((ext_vector_type(4)));
constexpr int BM = 256, BK = 64, HALF = 128, HTB = HALF * BK * 2  , STAGE_BYTES = 8 * HTB, NXCD = 8, WGM = 8;

__host__ __device__ __forceinline__ int lds_byte(int r, int c) { const int st = (r >> 4) * 2 + (c >> 5), rr = r & 15, cc = c & 31, ob = rr * 64 + cc * 2; return st * 1024 + (ob ^ (((ob >> 9) & 1) << 5)); }
__host__ __device__ __forceinline__ void stage_rc(int b, int& R, int& C) { const int st = b / 1024, sb = b % 1024, swz = sb ^ (((sb >> 9) & 1) << 5); R = (st >> 1) * 16 + swz / 64; C = (st & 1) * 32 + (swz % 64) / 2; }
__host__ __device__ __forceinline__ int perm32(int rho) { const int n = rho >> 4, i = rho & 15; return 8 * (i >> 2) + 4 * n + (i & 3); }

struct Unit { int pm, pn; };
struct Gemm { const bf16_t* A; const bf16_t* Bt; int M, N, K, lda; };

struct StaticOrder {
    int nM, nN, nwg, G, c;
    __host__ __device__ void init(int M, int N, int G_, int c_) { nM = M / BM; nN = N / BM; nwg = nM * nN; G = G_; c = c_; }
    __host__ __device__ bool next(int i, Unit& u) const {
        const long L = (long)i * G + c; if (L >= nwg) return false;
        int wgid = (int)L; { const int q = nwg / NXCD, r = nwg % NXCD, xcd = wgid % NXCD, off = wgid / NXCD; wgid = (xcd < r ? xcd * (q + 1) : r * (q + 1) + (xcd - r) * q) + off; }
        const int nig = WGM * nN, gid = wgid / nig, fm = gid * WGM, gsz = (nM - fm) < WGM ? (nM - fm) : WGM;
        u.pm = fm + ((wgid % nig) % gsz); u.pn = (wgid % nig) / gsz; return true;
    }
    __device__ __forceinline__ void a_ready(const Unit&) const {}
    __device__ __forceinline__ void done(const Unit&) const {}
};

__device__ __forceinline__ unsigned cvt_pk_bf16(float lo, float hi) { unsigned r; asm volatile("v_cvt_pk_bf16_f32 %0, %1, %2" : "=v"(r) : "v"(lo), "v"(hi)); return r; }
typedef float f32x2 __attribute__((ext_vector_type(2)));
__device__ __forceinline__ f32x2 gelu_pk(f32x2 v) {
    const f32x2 av = __builtin_elementwise_abs(v), d = av * 0.2316418882f + 1.0f;
    f32x2 t; t.x = __builtin_amdgcn_rcpf(d.x); t.y = __builtin_amdgcn_rcpf(d.y);
    f32x2 q = t * 0.5307027145f + (-0.7265760135f); q = q * t + 0.7107068705f; q = q * t + (-0.142248368f); q = q * t + 0.127414796f; q = q * t;
    const f32x2 s = (v * v) * (-0.72134752044f);
    f32x2 e; e.x = __builtin_amdgcn_exp2f(s.x); e.y = __builtin_amdgcn_exp2f(s.y);
    const f32x2 m = v * (q * e), r = v - m;
    f32x2 o; o.x = v.x < 0.f ? m.x : r.x; o.y = v.y < 0.f ? m.y : r.y; return o;
}

template <int ACT  > struct EpiBf16 {
    static constexpr bool PERM = true, AFTER_DRAIN = false; static_assert(ACT == 0 || ACT == 1, "EpiBf16: ACT is 0 (none) or 1 (gelu_pk)");
    bf16_t* O; int ldc; const float* bias; int split_cols; size_t split_stride; float scale0;
    __device__ __forceinline__ void operator()(const f32x4 (&acc)[2][2][4][2], const Unit& u, int wr, int wc, int fr, int fq) const {
        const int row0 = u.pm * BM + wr * 64 + fr; int colt = u.pn * BM; bf16_t* base = O;
        float sc = 1.f; if (split_cols) { const int t = colt / split_cols; base += (size_t)t * split_stride; colt -= t * split_cols; if (t == 0) sc = scale0; }
        const int col0 = colt + wc * 32 + 8 * fq, bcol0 = u.pn * BM + wc * 32 + 8 * fq;
        f32x4 bv[2][2];
#pragma unroll
        for (int bj = 0; bj < 2; ++bj)
#pragma unroll
            for (int n = 0; n < 2; ++n) bv[bj][n] = bias ? *(const f32x4*)(bias + bcol0 + bj * HALF + 4 * n) : (f32x4){0.f, 0.f, 0.f, 0.f};
#pragma unroll
        for (int ai = 0; ai < 2; ++ai)
#pragma unroll
            for (int m = 0; m < 4; ++m) { bf16_t* rowp = base + (size_t)(row0 + ai * HALF + m * 16) * ldc + col0;
#pragma unroll
                for (int bj = 0; bj < 2; ++bj) { f32x4 v0 = acc[ai][bj][m][0] + bv[bj][0], v1 = acc[ai][bj][m][1] + bv[bj][1];
                    if (ACT == 1) { f32x2 a = gelu_pk((f32x2){v0[0], v0[1]}), b = gelu_pk((f32x2){v0[2], v0[3]}), c = gelu_pk((f32x2){v1[0], v1[1]}), d = gelu_pk((f32x2){v1[2], v1[3]});
                        v0 = (f32x4){a.x, a.y, b.x, b.y}; v1 = (f32x4){c.x, c.y, d.x, d.y}; }
                    v0 = v0 * sc; v1 = v1 * sc; u32x4 w; w.x = cvt_pk_bf16(v0[0], v0[1]); w.y = cvt_pk_bf16(v0[2], v0[3]); w.z = cvt_pk_bf16(v1[0], v1[1]); w.w = cvt_pk_bf16(v1[2], v1[3]);
                    *(u32x4*)(rowp + bj * HALF) = w; } }
    }
};

struct EpiResF32 {
    static constexpr bool PERM = true, AFTER_DRAIN = false;
    const float* base; float* out; int ldc;
    __device__ __forceinline__ void operator()(const f32x4 (&acc)[2][2][4][2], const Unit& u, int wr, int wc, int fr, int fq) const {
        const int row0 = u.pm * BM + wr * 64 + fr, col0 = u.pn * BM + wc * 32 + 8 * fq;
#pragma unroll
        for (int ai = 0; ai < 2; ++ai) {
            f32x4 pre[4][2][2];
#pragma unroll
            for (int m = 0; m < 4; ++m) { const size_t off = (size_t)(row0 + ai * HALF + m * 16) * ldc + col0;
#pragma unroll
                for (int bj = 0; bj < 2; ++bj) { pre[m][bj][0] = __builtin_nontemporal_load((const f32x4*)(base + off + bj * HALF)); pre[m][bj][1] = __builtin_nontemporal_load((const f32x4*)(base + off + bj * HALF + 4)); } }
#pragma unroll
            for (int m = 0; m < 4; ++m) { const size_t off = (size_t)(row0 + ai * HALF + m * 16) * ldc + col0;
#pragma unroll
                for (int bj = 0; bj < 2; ++bj) { __builtin_nontemporal_store(acc[ai][bj][m][0] + pre[m][bj][0], (f32x4*)(out + off + bj * HALF)); __builtin_nontemporal_store(acc[ai][bj][m][1] + pre[m][bj][1], (f32x4*)(out + off + bj * HALF + 4)); } }
        }
    }
};
template <class Epi, class Sched, bool ALIGN_EPI = false, bool SP2 = false>
__device__ __forceinline__ void gemm_phase(PG8_LAS unsigned char* lds, const Gemm g, const Sched& S, const Epi& E) {
    int tid = threadIdx.x; asm volatile("" : "+v"(tid));
    const int wid = __builtin_amdgcn_readfirstlane(tid >> 6), lane = tid & 63, wr = wid >> 2, wc = wid & 3, fr = lane & 15, fq = lane >> 4;
    const int K = g.K, nt = K / BK;
    unsigned voffA[2], voffB[2];
#pragma unroll
    for (int i = 0; i < 2; ++i) { int R, C; stage_rc(tid * 16 + i * 8192, R, C); const int Rb = Epi::PERM ? ((R & ~31) + perm32(R & 31)) : R;
        voffA[i] = (unsigned)(R * g.lda + C) * 2u; voffB[i] = (unsigned)(Rb * K + C) * 2u; }
    const size_t kstep = (size_t)(BK * 2);
    const size_t hstepA = (size_t)HALF * g.lda * 2, hstepB = (size_t)HALF * K * 2;
    const size_t tstepA = 2 * hstepA, tstepB = 2 * hstepB;
    const unsigned ldsw = (unsigned)wid * 1024u;
    const int aoff = lds_byte(wr * 64 + fr, fq * 8), boff = lds_byte(wc * 32 + fr, fq * 8);
#define PG8_SA(b, h) (((b) * 2 + (h)) * HTB)
#define PG8_SB(b, h) ((4 + (b) * 2 + (h)) * HTB)
#define PG8_STAGE(bufoff, gbase, voff) do { _Pragma("unroll") for (int _i = 0; _i < 2; ++_i) \
        __builtin_amdgcn_global_load_lds((const unsigned*)((const char*)(gbase) + (voff)[_i]), (PG8_LAS unsigned*)(lds + (bufoff) + ldsw + _i * 8192), 16, 0, 0); } while (0)
#define PG8_LDA(dst, b, h) do { _Pragma("unroll") for (int m = 0; m < 4; ++m) _Pragma("unroll") for (int k = 0; k < 2; ++k) dst[m][k] = *(const PG8_LAS bf16x8*)(lds + PG8_SA(b, h) + aoff + m * 2048 + k * 1024); } while (0)
#define PG8_LDB(dst, b, h) do { _Pragma("unroll") for (int n = 0; n < 2; ++n) _Pragma("unroll") for (int k = 0; k < 2; ++k) dst[n][k] = *(const PG8_LAS bf16x8*)(lds + PG8_SB(b, h) + boff + n * 2048 + k * 1024); } while (0)
#define PG8_MMA(ai, bj, At, Bt) do { __builtin_amdgcn_s_setprio(1); _Pragma("unroll") for (int m = 0; m < 4; ++m) _Pragma("unroll") for (int n = 0; n < 2; ++n) _Pragma("unroll") for (int k = 0; k < 2; ++k) \
        acc[ai][bj][m][n] = __builtin_amdgcn_mfma_f32_16x16x32_bf16(Bt[n][k], At[m][k], acc[ai][bj][m][n], 0, 0, 0); __builtin_amdgcn_s_setprio(0); } while (0)
#define PG8_WAIT_V(n) asm volatile("s_waitcnt vmcnt(" #n ")" ::: "memory")
#define PG8_WAIT_L(n) asm volatile("s_waitcnt lgkmcnt(" #n ")" ::: "memory")
#define PG8_BAR __builtin_amdgcn_s_barrier()
#define PG8_SCHED __builtin_amdgcn_sched_barrier(0)
    Unit cur, nxt; int ui = 0;
    if (!S.next(0, cur)) return;
    f32x4 acc[2][2][4][2];
#pragma unroll
    for (int a = 0; a < 2; ++a)
#pragma unroll
        for (int b = 0; b < 2; ++b)
#pragma unroll
            for (int m = 0; m < 4; ++m)
#pragma unroll
                for (int n = 0; n < 2; ++n) acc[a][b][m][n] = (f32x4){0.f, 0.f, 0.f, 0.f};
    bf16x8 At[4][2], B0[2][2], B1[2][2];
    const char* cA = (const char*)g.A + (size_t)cur.pm * tstepA; const char* cB = (const char*)g.Bt + (size_t)cur.pn * tstepB;
    S.a_ready(cur);
    if constexpr (SP2) {
        PG8_STAGE(PG8_SB(0, 0), cB, voffB); PG8_STAGE(PG8_SB(0, 1), cB + hstepB, voffB); PG8_STAGE(PG8_SA(0, 0), cA, voffA); PG8_STAGE(PG8_SA(0, 1), cA + hstepA, voffA);
        if (wr == 1) PG8_BAR;
        PG8_WAIT_V(2); PG8_BAR;
        PG8_STAGE(PG8_SB(1, 0), cB + kstep, voffB); PG8_STAGE(PG8_SA(1, 0), cA + kstep, voffA); PG8_STAGE(PG8_SB(1, 1), cB + hstepB + kstep, voffB);
        PG8_WAIT_V(6); PG8_BAR;
    } else {
        PG8_STAGE(PG8_SB(0, 0), cB, voffB); PG8_STAGE(PG8_SA(0, 0), cA, voffA); PG8_STAGE(PG8_SB(0, 1), cB + hstepB, voffB); PG8_STAGE(PG8_SA(0, 1), cA + hstepA, voffA);
        if (wr == 1) PG8_BAR;
        PG8_WAIT_V(4); PG8_BAR;
        PG8_STAGE(PG8_SB(1, 0), cB + kstep, voffB); PG8_STAGE(PG8_SA(1, 0), cA + kstep, voffA); PG8_STAGE(PG8_SB(1, 1), cB + hstepB + kstep, voffB);
        PG8_WAIT_V(6); PG8_BAR;
    }
    for (;;) {
        const bool has_next = S.next(ui + 1, nxt);
        const char* nA = has_next ? (const char*)g.A + (size_t)nxt.pm * tstepA : cA; const char* nB = has_next ? (const char*)g.Bt + (size_t)nxt.pn * tstepB : cB;
        for (int t = 0; t < nt; t += 2) {
            const bool last = (t == nt - 2);
            const char* a1 = cA + (size_t)(t + 1) * kstep;
            const char* a2 = last ? nA : cA + (size_t)(t + 2) * kstep; const char* b2 = last ? nB : cB + (size_t)(t + 2) * kstep;
            const char* a3 = a2 + kstep; const char* b3 = b2 + kstep;
            if (last && has_next) S.a_ready(nxt);
            if constexpr (SP2) {
            PG8_LDB(B0, 0, 0); PG8_LDB(B1, 0, 1); PG8_SCHED; PG8_LDA(At, 0, 0); PG8_STAGE(PG8_SA(1, 1), a1 + hstepA, voffA);
            PG8_WAIT_V(8); PG8_WAIT_L(0); PG8_BAR; PG8_MMA(0, 0, At, B0); PG8_MMA(0, 1, At, B1); PG8_BAR; PG8_SCHED;
            PG8_LDA(At, 0, 1); PG8_STAGE(PG8_SB(0, 0), b2, voffB); PG8_STAGE(PG8_SB(0, 1), b2 + hstepB, voffB); PG8_STAGE(PG8_SA(0, 0), a2, voffA);
            PG8_WAIT_V(8); PG8_WAIT_L(0); PG8_BAR; PG8_MMA(1, 0, At, B0); PG8_MMA(1, 1, At, B1); PG8_BAR; PG8_SCHED;
            PG8_LDB(B0, 1, 0); PG8_LDB(B1, 1, 1); PG8_SCHED; PG8_LDA(At, 1, 0); PG8_STAGE(PG8_SA(0, 1), a2 + hstepA, voffA);
            PG8_WAIT_V(8); PG8_WAIT_L(0); PG8_BAR; PG8_MMA(0, 0, At, B0); PG8_MMA(0, 1, At, B1); PG8_BAR; PG8_SCHED;
            PG8_LDA(At, 1, 1); PG8_STAGE(PG8_SB(1, 0), b3, voffB); PG8_STAGE(PG8_SB(1, 1), b3 + hstepB, voffB); PG8_STAGE(PG8_SA(1, 0), a3, voffA);
            PG8_WAIT_V(8); PG8_WAIT_L(0); PG8_BAR; PG8_MMA(1, 0, At, B0); PG8_MMA(1, 1, At, B1); PG8_BAR; PG8_SCHED;
            } else {
            PG8_LDB(B0, 0, 0); PG8_SCHED; PG8_LDA(At, 0, 0); PG8_STAGE(PG8_SA(1, 1), a1 + hstepA, voffA);
            PG8_WAIT_L(8); PG8_BAR; PG8_WAIT_L(0); PG8_MMA(0, 0, At, B0); PG8_BAR; PG8_SCHED;
            PG8_LDB(B1, 0, 1); PG8_STAGE(PG8_SB(0, 0), b2, voffB);
            PG8_BAR; PG8_WAIT_L(0); PG8_MMA(0, 1, At, B1); PG8_BAR;
            PG8_LDA(At, 0, 1); PG8_STAGE(PG8_SA(0, 0), a2, voffA);
            PG8_BAR; PG8_WAIT_L(0); PG8_MMA(1, 0, At, B0); PG8_BAR; PG8_SCHED;
            PG8_STAGE(PG8_SB(0, 1), b2 + hstepB, voffB);
            PG8_WAIT_V(6); PG8_BAR; PG8_MMA(1, 1, At, B1); PG8_BAR;
            PG8_LDB(B0, 1, 0); PG8_SCHED; PG8_LDA(At, 1, 0); PG8_STAGE(PG8_SA(0, 1), a2 + hstepA, voffA);
            PG8_WAIT_L(8); PG8_BAR; PG8_WAIT_L(0); PG8_MMA(0, 0, At, B0); PG8_BAR; PG8_SCHED;
            PG8_LDB(B1, 1, 1); PG8_STAGE(PG8_SB(1, 0), b3, voffB);
            PG8_BAR; PG8_WAIT_L(0); PG8_MMA(0, 1, At, B1); PG8_BAR;
            PG8_LDA(At, 1, 1); PG8_STAGE(PG8_SA(1, 0), a3, voffA);
            PG8_BAR; PG8_WAIT_L(0); PG8_MMA(1, 0, At, B0); PG8_BAR; PG8_SCHED;
            PG8_STAGE(PG8_SB(1, 1), b3 + hstepB, voffB);
            PG8_WAIT_V(6); PG8_BAR; PG8_MMA(1, 1, At, B1); PG8_BAR;
            }
        }
        if constexpr (ALIGN_EPI) { if (wr == 0) PG8_BAR; }
        if constexpr (!Epi::AFTER_DRAIN) { E(acc, cur, wr, wc, fr, fq); S.done(cur); }
        if (!has_next) break;
#pragma unroll
        for (int a = 0; a < 2; ++a)
#pragma unroll
            for (int b = 0; b < 2; ++b)
#pragma unroll
                for (int m = 0; m < 4; ++m)
#pragma unroll
                    for (int n = 0; n < 2; ++n) acc[a][b][m][n] = (f32x4){0.f, 0.f, 0.f, 0.f};
        cur = nxt; cA = nA; cB = nB; ++ui;
        if constexpr (ALIGN_EPI) { if (wr == 1) PG8_BAR; }
    }
    PG8_WAIT_V(0);
    if constexpr (!ALIGN_EPI) { if (wr == 0) PG8_BAR; }
    PG8_BAR;
    if constexpr (Epi::AFTER_DRAIN) { E.fused(acc, cur, wr, wc, fr, fq, lds, wid, lane); S.done(cur); }
#undef PG8_SA
#undef PG8_SB
#undef PG8_STAGE
#undef PG8_LDA
#undef PG8_LDB
#undef PG8_MMA
#undef PG8_WAIT_V
#undef PG8_WAIT_L
#undef PG8_BAR
#undef PG8_SCHED
}
}
#ifndef PG8_SP2
#define PG8_SP2 true
#endif
#ifndef PG8_ALIGN
#define PG8_ALIGN true
#endif
#ifndef MK_N_LAUNCHES
#define MK_N_LAUNCHES 1
#endif
#ifndef PROBE_PHASE
#define PROBE_PHASE -1
#endif
#ifndef DUP_PHASE
#define DUP_PHASE -1
#endif
#ifndef FAST_MLA
#define FAST_MLA 1
#endif
#ifndef FAST_DIL
#define FAST_DIL 1
#endif

constexpr int NBATCH = 4, SEQ = 4096, DM = 2048, TOK = NBATCH * SEQ;
constexpr int NC = 6464, NCP = 6656;
constexpr int C_CQ = 0, C_CKV = 768, C_QB = 1280, C_KB = 2304, C_VB = 3328, C_GA = 4352, C_GB = 5376, C_KR = 6400;
constexpr int QA_W = 1536, KVA_W = 2048;
constexpr float EPS = 1e-6f;
constexpr float LOG2E = 1.4426950408889634f, LN2 = 0.6931471805599453f;
constexpr float QSCALE_MLA = 0.07216878364870322f * LOG2E;
constexpr float QSCALE_DIL = 0.08838834764831845f * LOG2E;
constexpr int NPH = 8;

constexpr size_t MiB = 1u << 20;
constexpr size_t WS_GAINS = 3 * MiB + 196608;
constexpr size_t WS_SSQ = 3 * MiB + 65536;
constexpr size_t WS_TAB128 = 0, WS_TAB64 = 2 * MiB, WS_CTL = 3 * MiB, CTL_BYTES = 16384;
constexpr size_t WS_WIN = 4 * MiB, WS_WUQ = 30 * MiB, WS_WUKV = 33 * MiB, WS_WOUT = 35 * MiB;
constexpr size_t WS_PROJ = 44 * MiB;
constexpr size_t WS_HN = 252 * MiB;
constexpr size_t WS_OA = 252 * MiB, WS_OD1 = 284 * MiB;
constexpr size_t WS_QA = 316 * MiB;
constexpr size_t WS_KVA = 364 * MiB;
constexpr size_t WS_OD2 = 428 * MiB, WS_OD3 = 460 * MiB;
constexpr size_t WS_LSE = 492 * MiB;
constexpr size_t WS_Y = 316 * MiB;
constexpr size_t WS_END = 494 * MiB;
constexpr int LDS_BYTES = 143360, XCH_OFF = 131072;

#define LAS __attribute__((address_space(3)))
#define DI __device__ __forceinline__
typedef unsigned short bf16_t;
typedef unsigned u32x4 __attribute__((ext_vector_type(4)));
typedef unsigned u32x2 __attribute__((ext_vector_type(2)));
typedef float f32x4 __attribute__((ext_vector_type(4)));
typedef float f32x2 __attribute__((ext_vector_type(2)));

struct Params { const float* in[14]; float* out; unsigned char* ws; int ph_lo, ph_hi; };

DI float bflo(unsigned w) { return __uint_as_float(w << 16); }
DI float bfhi(unsigned w) { return __uint_as_float(w & 0xffff0000u); }
DI unsigned pk2(float lo, float hi) { return pg8::cvt_pk_bf16(lo, hi); }
DI void unpack8(const u32x4 v, f32x4& a, f32x4& b) { a = (f32x4){bflo(v.x), bfhi(v.x), bflo(v.y), bfhi(v.y)}; b = (f32x4){bflo(v.z), bfhi(v.z), bflo(v.w), bfhi(v.w)}; }
DI u32x4 pack8(const f32x4 a, const f32x4 b) { u32x4 r; r.x = pk2(a.x, a.y); r.y = pk2(a.z, a.w); r.z = pk2(b.x, b.y); r.w = pk2(b.z, b.w); return r; }
DI float sumsq8(const f32x4 a, const f32x4 b) { return (a.x * a.x + a.y * a.y) + (a.z * a.z + a.w * a.w) + (b.x * b.x + b.y * b.y) + (b.z * b.z + b.w * b.w); }
DI float wave_sum(float v) {
#pragma unroll
    for (int o = 1; o < 64; o <<= 1) v += __shfl_xor(v, o);
    return v; }
DI float wave_max(float v) {
#pragma unroll
    for (int o = 1; o < 64; o <<= 1) v = fmaxf(v, __shfl_xor(v, o));
    return v; }
DI float grp_sum8(float v) { v += __shfl_xor(v, 1); v += __shfl_xor(v, 2); v += __shfl_xor(v, 4); return v; }
DI float grp_sum16(float v) { v = grp_sum8(v); v += __shfl_xor(v, 8); return v; }
DI float rstd_of(float ss, float inv_n) { return 1.0f / sqrtf(ss * inv_n + EPS); }
DI float silu(float x) { return x / (1.0f + __expf(-x)); }
DI f32x4 silu4(f32x4 x) { return (f32x4){silu(x.x), silu(x.y), silu(x.z), silu(x.w)}; }
DI void rope8(f32x4& a, f32x4& b, int xr, bool first, const f32x4* tab) {
    f32x4 pa, pb;
    pa.x = __shfl_xor(a.x, xr); pa.y = __shfl_xor(a.y, xr); pa.z = __shfl_xor(a.z, xr); pa.w = __shfl_xor(a.w, xr);
    pb.x = __shfl_xor(b.x, xr); pb.y = __shfl_xor(b.y, xr); pb.z = __shfl_xor(b.z, xr); pb.w = __shfl_xor(b.w, xr);
    const float sg = first ? -1.f : 1.f;
    const f32x4 t0 = tab[0], t1 = tab[1], t2 = tab[2], t3 = tab[3];
    a.x = a.x * t0.x + sg * pa.x * t0.y; a.y = a.y * t0.z + sg * pa.y * t0.w; a.z = a.z * t1.x + sg * pa.z * t1.y; a.w = a.w * t1.z + sg * pa.w * t1.w;
    b.x = b.x * t2.x + sg * pb.x * t2.y; b.y = b.y * t2.z + sg * pb.y * t2.w; b.z = b.z * t3.x + sg * pb.z * t3.y; b.w = b.w * t3.z + sg * pb.w * t3.w;
}

namespace pg8 {
struct EpiProj {
    static constexpr bool PERM = true, AFTER_DRAIN = false;
    bf16_t* O; float* ssq; const float* gains; const f32x4* tab; LAS float* xch;
    __device__ __forceinline__ void operator()(const f32x4 (&acc)[2][2][4][2], const Unit& u, int wr, int wc, int fr, int fq) const {
        const int pn = u.pn, row0 = u.pm * BM + wr * 64 + fr, col0 = pn * BM + wc * 32 + 8 * fq;
        const bool kr = pn == 25;
        if ((pn >= 5 && pn < 13) || kr) {
#pragma unroll
            for (int ai = 0; ai < 2; ++ai)
#pragma unroll
                for (int m = 0; m < 4; ++m)
#pragma unroll
                    for (int bj = 0; bj < 2; ++bj) {
                        const f32x4 a = acc[ai][bj][m][0], c = acc[ai][bj][m][1];
                        float s = (a.x * a.x + a.y * a.y) + (a.z * a.z + a.w * a.w) + (c.x * c.x + c.y * c.y) + (c.z * c.z + c.w * c.w);
                        s += __shfl_xor(s, 16); s += __shfl_xor(s, 32);
                        if (fq == 0) xch[((ai * HALF + wr * 64 + m * 16 + fr) * 2 + bj) * 4 + wc] = s;
                    }
            asm volatile("s_waitcnt lgkmcnt(0)" ::: "memory"); __builtin_amdgcn_s_barrier(); asm volatile("" ::: "memory");
            const int lg = kr ? 4 * (wc & 1) + fq : 4 * wc + fq;
            const int goff = kr ? 256 : (pn < 9 ? 0 : 128);
            const f32x4 g0 = *(const f32x4*)(gains + goff + 4 * lg), g1 = *(const f32x4*)(gains + goff + (kr ? 32 : 64) + 4 * lg);
            const float scale = (pn < 9) ? QSCALE_DIL : 1.0f, inv_n = kr ? (1.0f / 64.0f) : (1.0f / 128.0f);
            if (!kr || wc < 2) {
#pragma unroll
            for (int ai = 0; ai < 2; ++ai)
#pragma unroll
                for (int m = 0; m < 4; ++m) {
                    const int row = row0 + ai * HALF + m * 16, t = row & (SEQ - 1);
                    const int ti = kr ? (int)(WS_TAB64 / 16) + (t * 32 + 4 * lg) / 2 : (t * 64 + 4 * lg) / 2;
                    const f32x4 tA = tab[ti], tB = tab[ti + 1];
#pragma unroll
                    for (int bj = 0; bj < 2; ++bj) {
                        if (kr && bj == 1) continue;
                        const f32x4 ps = *(const LAS f32x4*)(xch + ((ai * HALF + wr * 64 + m * 16 + fr) * 2 + bj) * 4);
                        const float tot = kr ? ps.x + ps.y : (ps.x + ps.y) + (ps.z + ps.w);
                        const float rstd = 1.0f / sqrtf(tot * inv_n + EPS);
                        const f32x4 x1 = acc[ai][bj][m][0] * rstd * g0, x2 = acc[ai][bj][m][1] * rstd * g1;
                        f32x4 o1, o2;
                        o1.x = x1.x * tA.x - x2.x * tA.y; o2.x = x2.x * tA.x + x1.x * tA.y;
                        o1.y = x1.y * tA.z - x2.y * tA.w; o2.y = x2.y * tA.z + x1.y * tA.w;
                        o1.z = x1.z * tB.x - x2.z * tB.y; o2.z = x2.z * tB.x + x1.z * tB.y;
                        o1.w = x1.w * tB.z - x2.w * tB.w; o2.w = x2.w * tB.z + x1.w * tB.w;
                        o1 = o1 * scale; o2 = o2 * scale;
                        u32x4 w; w.x = cvt_pk_bf16(o1.x, o1.y); w.y = cvt_pk_bf16(o1.z, o1.w); w.z = cvt_pk_bf16(o2.x, o2.y); w.w = cvt_pk_bf16(o2.z, o2.w);
                        *(u32x4*)(O + (size_t)row * NCP + col0 + bj * HALF) = w;
                    }
                }
            }
        } else {
            float* sq = ssq + (pn < 3 ? 0 : TOK);
#pragma unroll
            for (int ai = 0; ai < 2; ++ai)
#pragma unroll
                for (int m = 0; m < 4; ++m) {
                    const int row = row0 + ai * HALF + m * 16;
                    bf16_t* rowp = O + (size_t)row * NCP + col0;
                    float s = 0.f;
#pragma unroll
                    for (int bj = 0; bj < 2; ++bj) {
                        const f32x4 v0 = acc[ai][bj][m][0], v1 = acc[ai][bj][m][1];
                        s += (v0.x * v0.x + v0.y * v0.y) + (v0.z * v0.z + v0.w * v0.w) + (v1.x * v1.x + v1.y * v1.y) + (v1.z * v1.z + v1.w * v1.w);
                        u32x4 w; w.x = cvt_pk_bf16(v0.x, v0.y); w.y = cvt_pk_bf16(v0.z, v0.w); w.z = cvt_pk_bf16(v1.x, v1.y); w.w = cvt_pk_bf16(v1.z, v1.w);
                        *(u32x4*)(rowp + bj * HALF) = w;
                    }
                    if (pn < 5) { s += __shfl_xor(s, 16); s += __shfl_xor(s, 32); if (fq == 0) atomicAdd(sq + row, s); }
                }
        }
    }
};
struct EpiRowScale {
    static constexpr bool PERM = true, AFTER_DRAIN = false;
    bf16_t* O; int ldc; const float* ssq; float inv_n;
    __device__ __forceinline__ void operator()(const f32x4 (&acc)[2][2][4][2], const Unit& u, int wr, int wc, int fr, int fq) const {
        const int row0 = u.pm * BM + wr * 64 + fr, col0 = u.pn * BM + wc * 32 + 8 * fq;
#pragma unroll
        for (int ai = 0; ai < 2; ++ai)
#pragma unroll
            for (int m = 0; m < 4; ++m) {
                const int row = row0 + ai * HALF + m * 16;
                const float rstd = 1.0f / sqrtf(ssq[row] * inv_n + EPS);
                bf16_t* rowp = O + (size_t)row * ldc + col0;
#pragma unroll
                for (int bj = 0; bj < 2; ++bj) {
                    const f32x4 v0 = acc[ai][bj][m][0] * rstd, v1 = acc[ai][bj][m][1] * rstd;
                    u32x4 w; w.x = cvt_pk_bf16(v0.x, v0.y); w.y = cvt_pk_bf16(v0.z, v0.w); w.z = cvt_pk_bf16(v1.x, v1.y); w.w = cvt_pk_bf16(v1.z, v1.w);
                    *(u32x4*)(rowp + bj * HALF) = w;
                }
            }
    }
};
template <int MODE> struct EpiUp {
    static constexpr bool PERM = true, AFTER_DRAIN = false;
    bf16_t* O; int ldc; const float* ssq; float inv_k; const float* gain; const f32x4* tab64; LAS float* xch;
    __device__ __forceinline__ void operator()(const f32x4 (&acc)[2][2][4][2], const Unit& u, int wr, int wc, int fr, int fq) const {
        const int pn = u.pn, row0 = u.pm * BM + wr * 64 + fr, col0 = pn * BM + wc * 32 + 8 * fq;
        const bool ropet = (MODE == 0) && pn >= 4;
        float rs[2][4];
#pragma unroll
        for (int ai = 0; ai < 2; ++ai)
#pragma unroll
            for (int m = 0; m < 4; ++m) rs[ai][m] = 1.0f / sqrtf(ssq[row0 + ai * HALF + m * 16] * inv_k + EPS);
#pragma unroll
        for (int ai = 0; ai < 2; ++ai)
#pragma unroll
            for (int m = 0; m < 4; ++m)
#pragma unroll
                for (int bj = 0; bj < (MODE == 1 ? 1 : 2); ++bj) {
                    const f32x4 a = acc[ai][bj][m][0] * rs[ai][m], c = acc[ai][bj][m][1] * rs[ai][m];
                    float s = (a.x * a.x + a.y * a.y) + (a.z * a.z + a.w * a.w) + (c.x * c.x + c.y * c.y) + (c.z * c.z + c.w * c.w);
                    s += __shfl_xor(s, 16); s += __shfl_xor(s, 32);
                    if (fq == 0) xch[((ai * HALF + wr * 64 + m * 16 + fr) * 2 + bj) * 4 + wc] = s;
                }
        asm volatile("s_waitcnt lgkmcnt(0)" ::: "memory"); __builtin_amdgcn_s_barrier(); asm volatile("" ::: "memory");
        const int lg = 4 * (wc & 1) + fq;
        const int goff = ropet ? 128 + 4 * lg : 32 * wc + 8 * fq;
        const f32x4 g0 = *(const f32x4*)(gain + goff), g1 = *(const f32x4*)(gain + goff + (ropet ? 32 : 4));
        const float osc = MODE == 0 ? QSCALE_MLA : 1.0f, inv_n = ropet ? (1.0f / 64.0f) : (1.0f / 128.0f);
#pragma unroll
        for (int ai = 0; ai < 2; ++ai)
#pragma unroll
            for (int m = 0; m < 4; ++m) {
                const int row = row0 + ai * HALF + m * 16, t = row & (SEQ - 1);
                f32x4 tA = (f32x4){1.f, 0.f, 1.f, 0.f}, tB = tA;
                if (ropet) { const int ti = (t * 32 + 4 * lg) / 2; tA = tab64[ti]; tB = tab64[ti + 1]; }
                bf16_t* rowp = O + (size_t)row * ldc + col0;
#pragma unroll
                for (int bj = 0; bj < 2; ++bj) {
                    f32x4 o1, o2;
                    if (MODE == 1 && bj == 1) { o1 = acc[ai][bj][m][0] * rs[ai][m]; o2 = acc[ai][bj][m][1] * rs[ai][m]; }
                    else {
                        const f32x4 ps = *(const LAS f32x4*)(xch + ((ai * HALF + wr * 64 + m * 16 + fr) * 2 + bj) * 4);
                        const float tot = ropet ? ((wc & 2) ? ps.z + ps.w : ps.x + ps.y) : (ps.x + ps.y) + (ps.z + ps.w);
                        const float sc = rs[ai][m] * (1.0f / sqrtf(tot * inv_n + EPS)) * osc;
                        const f32x4 x1 = acc[ai][bj][m][0] * sc * g0, x2 = acc[ai][bj][m][1] * sc * g1;
                        if (ropet) {
                            o1.x = x1.x * tA.x - x2.x * tA.y; o2.x = x2.x * tA.x + x1.x * tA.y;
                            o1.y = x1.y * tA.z - x2.y * tA.w; o2.y = x2.y * tA.z + x1.y * tA.w;
                            o1.z = x1.z * tB.x - x2.z * tB.y; o2.z = x2.z * tB.x + x1.z * tB.y;
                            o1.w = x1.w * tB.z - x2.w * tB.w; o2.w = x2.w * tB.z + x1.w * tB.w;
                        } else { o1 = x1; o2 = x2; }
                    }
                    u32x4 w; w.x = cvt_pk_bf16(o1.x, o1.y); w.y = cvt_pk_bf16(o1.z, o1.w); w.z = cvt_pk_bf16(o2.x, o2.y); w.w = cvt_pk_bf16(o2.z, o2.w);
                    *(u32x4*)(rowp + bj * HALF) = w;
                }
            }
    }
};
}

DI int perm_half(int i, int half) { return i < half ? 8 * (i >> 2) + (i & 3) : 8 * ((i - half) >> 2) + 4 + (i & 3); }
DI int phys_in(int c) {
    if (c < 1280) return c;
    if (c < 1344) return C_KR + perm_half(c - 1280, 32);
    if (c < 2368) return C_GA + (c - 1344);
    if (c < 4416) { const int i0 = c - 2368; return C_QB + (i0 & ~127) + perm_half(i0 & 127, 64); }
    if (c < 5440) return C_VB + (c - 4416);
    return C_GB + (c - 5440);
}
DI int phys_uq(int c) { const int h = c / 192, i = c - 192 * h; return i < 128 ? 128 * h + i : 1024 + 64 * h + perm_half(i - 128, 32); }
template <int MODE>
DI void p0_transpose_item(const float* W, int K, int N, bf16_t* WT, LAS float* scr, int item, int lane, const float* gain) {
    const int nblk = N / 32, kb = item / nblk, nb = item % nblk, k0 = 64 * kb, n0 = 32 * nb;
    f32x4 wv[8];
#pragma unroll
    for (int i = 0; i < 8; ++i) wv[i] = *(const f32x4*)(W + (size_t)(k0 + 8 * i + (lane >> 3)) * N + n0 + 4 * (lane & 7));
#pragma unroll
    for (int i = 0; i < 8; ++i) { LAS float* d = scr + (8 * i + (lane >> 3)) * 33 + 4 * (lane & 7); d[0] = wv[i].x; d[1] = wv[i].y; d[2] = wv[i].z; d[3] = wv[i].w; }
    asm volatile("s_waitcnt lgkmcnt(0)" ::: "memory");
    const int c = lane & 7;
#pragma unroll
    for (int j = 0; j < 4; ++j) { const int n = (lane >> 3) + 8 * j; const LAS float* s = scr + (8 * c) * 33 + n;
        f32x4 ga = (f32x4){1.f, 1.f, 1.f, 1.f}, gb = ga;
        if (gain) { ga = *(const f32x4*)(gain + k0 + 8 * c); gb = *(const f32x4*)(gain + k0 + 8 * c + 4); }
        u32x4 o; o.x = pk2(s[0 * 33] * ga.x, s[1 * 33] * ga.y); o.y = pk2(s[2 * 33] * ga.z, s[3 * 33] * ga.w); o.z = pk2(s[4 * 33] * gb.x, s[5 * 33] * gb.y); o.w = pk2(s[6 * 33] * gb.z, s[7 * 33] * gb.w);
        const int nr = MODE == 1 ? phys_in(n0 + n) : (MODE == 2 ? phys_uq(n0 + n) : n0 + n);
        *(u32x4*)(WT + (size_t)nr * K + k0 + 8 * c) = o; }
    asm volatile("s_waitcnt lgkmcnt(0)" ::: "memory");
}
DI void phase0(const Params& p, LAS unsigned char* lds, int gw, int NGW, int lane, int wave, int part) {
    unsigned char* ws = p.ws;
    LAS float* scr = (LAS float*)(lds + wave * 16384);
    constexpr int I_IN = (DM / 64) * (NC / 32), I_UQ = (768 / 64) * (QA_W / 32), I_UKV = (512 / 64) * (KVA_W / 32), I_OUT = (DM / 64) * (DM / 32);
    constexpr int NITEMS = I_IN + I_UQ + I_UKV + I_OUT;
    const int it_lo = part == 0 ? 0 : I_IN, it_hi = part == 0 ? I_IN : NITEMS;
    for (int it = it_lo + gw; it < it_hi; it += NGW) {
        int r = it;
        if (r < I_IN) { p0_transpose_item<1>(p.in[2], DM, NC, (bf16_t*)(ws + WS_WIN), scr, r, lane, nullptr); continue; } r -= I_IN;
        if (r < I_UQ) { p0_transpose_item<2>(p.in[5], 768, QA_W, (bf16_t*)(ws + WS_WUQ), scr, r, lane, p.in[3]); continue; } r -= I_UQ;
        if (r < I_UKV) { p0_transpose_item<0>(p.in[6], 512, KVA_W, (bf16_t*)(ws + WS_WUKV), scr, r, lane, p.in[4]); continue; } r -= I_UKV;
        p0_transpose_item<0>(p.in[13], DM, DM, (bf16_t*)(ws + WS_WOUT), scr, r, lane, nullptr);
    }
    if (part == 1) return;
    const int gt = gw * 64 + lane, NGT = NGW * 64;
    for (int i = gt; i < 2 * TOK; i += NGT) ((float*)(ws + WS_SSQ))[i] = 0.f;
    if (gt < 320) ((float*)(ws + WS_GAINS))[gt] = gt < 128 ? p.in[9][gt] : (gt < 256 ? p.in[10][gt - 128] : p.in[8][128 + gt - 256]);
    {
        u32x4* z = (u32x4*)((bf16_t*)(ws + WS_WIN) + (size_t)NC * DM);
        for (int i = gt; i < (NCP - NC) * DM / 8; i += NGT) z[i] = (u32x4){0u, 0u, 0u, 0u};
    }
    for (int i = gt; i < SEQ * 96; i += NGT) {
        int s, j; float e; f32x2* dst;
        if (i < SEQ * 64) { s = i >> 6; j = i & 63; e = (float)(2 * j) * (1.0f / 128.0f); dst = (f32x2*)(ws + WS_TAB128) + i; }
        else { const int k = i - SEQ * 64; s = k >> 5; j = k & 31; e = (float)(2 * j) * (1.0f / 64.0f); dst = (f32x2*)(ws + WS_TAB64) + k; }
        const float inv = __builtin_amdgcn_exp2f(-e * 13.287712379549449f);
        const float ang = (float)s * inv;
        const double rev = (double)ang * 0.15915494309189535;
        const float fr = (float)(rev - rint(rev));
        *dst = (f32x2){__builtin_amdgcn_cosf(fr), __builtin_amdgcn_sinf(fr)};
    }
    const f32x4* g4 = (const f32x4*)p.in[1];
    for (int m = gw; m < TOK; m += NGW) {
        const f32x4* xr = (const f32x4*)(p.in[0] + (size_t)m * DM) + lane;
        f32x4 v[8]; float ss = 0.f;
#pragma unroll
        for (int j = 0; j < 8; ++j) { v[j] = __builtin_nontemporal_load(xr + 64 * j); ss += (v[j].x * v[j].x + v[j].y * v[j].y) + (v[j].z * v[j].z + v[j].w * v[j].w); }
        const float rstd = rstd_of(wave_sum(ss), 1.0f / DM);
        u32x2* o8 = (u32x2*)((bf16_t*)(ws + WS_HN) + (size_t)m * DM) + lane;
#pragma unroll
        for (int j = 0; j < 8; ++j) { const f32x4 g = g4[64 * j + lane]; const f32x4 y = v[j] * rstd * g; o8[64 * j] = (u32x2){pk2(y.x, y.y), pk2(y.z, y.w)}; }
    }
}

DI void e1_row(const Params& p, int row, int lane, bool dry) {
    unsigned char* ws = p.ws;
    const int t = row & (SEQ - 1);
    u32x4* r16 = (u32x4*)((bf16_t*)(ws + WS_PROJ) + (size_t)row * NCP);
    const int c8 = lane & 7, c16 = lane & 15;
    const u32x4 vq0 = r16[lane], vq1 = lane < 32 ? r16[64 + lane] : (u32x4){0u, 0u, 0u, 0u};
    const u32x4 vkv = r16[96 + lane], vkr = r16[160 + c8];
    u32x4 vh[4];
#pragma unroll
    for (int it = 0; it < 4; ++it) vh[it] = r16[(C_QB / 8) + it * 64 + lane];
    const f32x4* tb64 = (const f32x4*)(ws + WS_TAB64) + (t * 32 + (c8 & 3) * 8) / 2;
    const f32x4* tb128 = (const f32x4*)(ws + WS_TAB128) + (t * 64 + (c16 & 7) * 8) / 2;
    if (dry) return;
    {
        f32x4 a0, b0, a1, b1; unpack8(vq0, a0, b0); unpack8(vq1, a1, b1);
        const float rstd = rstd_of(wave_sum(sumsq8(a0, b0) + sumsq8(a1, b1)), 1.0f / 768.0f);
        const f32x4* g = (const f32x4*)p.in[3];
        r16[lane] = pack8(a0 * rstd * g[2 * lane], b0 * rstd * g[2 * lane + 1]);
        if (lane < 32) r16[64 + lane] = pack8(a1 * rstd * g[2 * (64 + lane)], b1 * rstd * g[2 * (64 + lane) + 1]);
    }
    {
        f32x4 a, b; unpack8(vkv, a, b);
        const float rstd = rstd_of(wave_sum(sumsq8(a, b)), 1.0f / 512.0f);
        const f32x4* g = (const f32x4*)p.in[4];
        r16[96 + lane] = pack8(a * rstd * g[2 * lane], b * rstd * g[2 * lane + 1]);
    }
    {
        f32x4 a, b; unpack8(vkr, a, b);
        const float rstd = rstd_of(grp_sum8(sumsq8(a, b)), 1.0f / 64.0f);
        const f32x4* g = (const f32x4*)p.in[8] + 32;
        a = a * rstd * g[2 * c8]; b = b * rstd * g[2 * c8 + 1];
        rope8(a, b, 4, c8 < 4, tb64);
        if (lane < 8) r16[160 + c8] = pack8(a, b);
    }
#pragma unroll
    for (int it = 0; it < 4; ++it) {
        f32x4 a, b; unpack8(vh[it], a, b);
        const float rstd = rstd_of(grp_sum16(sumsq8(a, b)), 1.0f / 128.0f);
        const f32x4* g = (const f32x4*)(it < 2 ? p.in[9] : p.in[10]);
        a = a * rstd * g[2 * c16]; b = b * rstd * g[2 * c16 + 1];
        rope8(a, b, 8, c16 < 8, tb128);
        if (it < 2) { a = a * QSCALE_DIL; b = b * QSCALE_DIL; }
        r16[(C_QB / 8) + it * 64 + lane] = pack8(a, b);
    }
}

DI void e2_row(const Params& p, int row, int lane, bool dry) {
    unsigned char* ws = p.ws;
    const int t = row & (SEQ - 1);
    u32x4* q16 = (u32x4*)((bf16_t*)(ws + WS_QA) + (size_t)row * QA_W);
    u32x4* kv16 = (u32x4*)((bf16_t*)(ws + WS_KVA) + (size_t)row * KVA_W);
    const f32x4* gq = (const f32x4*)p.in[7];
    const f32x4* gk = (const f32x4*)p.in[8];
    u32x4* pq[2]; u32x4* pk[2]; u32x4 vq[2], vk[2];
#pragma unroll
    for (int it = 0; it < 2; ++it) { const int idx = it * 64 + lane, h = idx >> 4, c = idx & 15; pq[it] = q16 + h * 24 + c; pk[it] = kv16 + h * 32 + c; vq[it] = *pq[it]; vk[it] = *pk[it]; }
    const int hr = lane >> 3, cr = lane & 7;
    u32x4* pr = q16 + hr * 24 + 16 + cr; const u32x4 vr = *pr;
    const f32x4* tb64 = (const f32x4*)(ws + WS_TAB64) + (t * 32 + (cr & 3) * 8) / 2;
    if (dry) return;
#pragma unroll
    for (int it = 0; it < 2; ++it) {
        const int c = lane & 15;
        f32x4 a, b; unpack8(vq[it], a, b);
        const float rstd = rstd_of(grp_sum16(sumsq8(a, b)), 1.0f / 128.0f) * QSCALE_MLA;
        *pq[it] = pack8(a * rstd * gq[2 * c], b * rstd * gq[2 * c + 1]);
    }
    {
        f32x4 a, b; unpack8(vr, a, b);
        const float rstd = rstd_of(grp_sum8(sumsq8(a, b)), 1.0f / 64.0f);
        a = a * rstd * gq[32 + 2 * cr]; b = b * rstd * gq[32 + 2 * cr + 1];
        rope8(a, b, 4, cr < 4, tb64);
        f32x4 xa, xb;
        xa.x = __shfl_xor(a.x, 4); xa.y = __shfl_xor(a.y, 4); xa.z = __shfl_xor(a.z, 4); xa.w = __shfl_xor(a.w, 4);
        xb.x = __shfl_xor(b.x, 4); xb.y = __shfl_xor(b.y, 4); xb.z = __shfl_xor(b.z, 4); xb.w = __shfl_xor(b.w, 4);
        u32x4* prp = q16 + hr * 24 + 16 + (cr < 4 ? 2 * cr : 2 * (cr - 4) + 1);
        *prp = cr < 4 ? pack8(a * QSCALE_MLA, xa * QSCALE_MLA) : pack8(xb * QSCALE_MLA, b * QSCALE_MLA);
    }
#pragma unroll
    for (int it = 0; it < 2; ++it) {
        const int c = lane & 15;
        f32x4 a, b; unpack8(vk[it], a, b);
        const float rstd = rstd_of(grp_sum16(sumsq8(a, b)), 1.0f / 128.0f);
        *pk[it] = pack8(a * rstd * gk[2 * c], b * rstd * gk[2 * c + 1]);
    }
}

DI void e3_row(const Params& p, int row, int lane) {
    unsigned char* ws = p.ws;
    const u32x4* r16 = (const u32x4*)((const bf16_t*)(ws + WS_PROJ) + (size_t)row * NCP);
    u32x4* y16 = (u32x4*)((bf16_t*)(ws + WS_Y) + (size_t)row * DM);
    {
        const u32x4* o16 = (const u32x4*)((const bf16_t*)(ws + WS_OA) + (size_t)row * 1024);
        f32x4 a0, b0, a1, b1; unpack8(o16[lane], a0, b0); unpack8(o16[64 + lane], a1, b1);
        const float rstd = rstd_of(wave_sum(sumsq8(a0, b0) + sumsq8(a1, b1)), 1.0f / 1024.0f);
        const f32x4* g = (const f32x4*)p.in[11];
        f32x4 ga0, gb0, ga1, gb1; unpack8(r16[C_GA / 8 + lane], ga0, gb0); unpack8(r16[C_GA / 8 + 64 + lane], ga1, gb1);
        y16[lane] = pack8(a0 * rstd * g[2 * lane] * silu4(ga0), b0 * rstd * g[2 * lane + 1] * silu4(gb0));
        y16[64 + lane] = pack8(a1 * rstd * g[2 * (64 + lane)] * silu4(ga1), b1 * rstd * g[2 * (64 + lane) + 1] * silu4(gb1));
    }
    {
        const float* lse = (const float*)(ws + WS_LSE);
        f32x4 oa[2], ob[2]; float ss = 0.f;
#pragma unroll
        for (int j = 0; j < 2; ++j) {
            const int cidx = j * 64 + lane, h = cidx >> 4;
            const float l0 = lse[(size_t)row * 8 + h], l1 = lse[(size_t)TOK * 8 + (size_t)row * 8 + h], l2 = lse[(size_t)2 * TOK * 8 + (size_t)row * 8 + h];
            const float mx = fmaxf(l0, fmaxf(l1, l2));
            float w0 = __expf(l0 - mx), w1 = __expf(l1 - mx), w2 = __expf(l2 - mx);
            const float inv = 1.0f / (w0 + w1 + w2); w0 *= inv; w1 *= inv; w2 *= inv;
            f32x4 a, b, c, d, e, f;
            unpack8(((const u32x4*)((const bf16_t*)(ws + WS_OD1) + (size_t)row * 1024))[cidx], a, b);
            unpack8(((const u32x4*)((const bf16_t*)(ws + WS_OD2) + (size_t)row * 1024))[cidx], c, d);
            unpack8(((const u32x4*)((const bf16_t*)(ws + WS_OD3) + (size_t)row * 1024))[cidx], e, f);
            oa[j] = a * w0 + c * w1 + e * w2; ob[j] = b * w0 + d * w1 + f * w2;
            ss += sumsq8(oa[j], ob[j]);
        }
        const float rstd = rstd_of(wave_sum(ss), 1.0f / 1024.0f);
        const f32x4* g = (const f32x4*)p.in[12];
#pragma unroll
        for (int j = 0; j < 2; ++j) {
            const int cidx = j * 64 + lane;
            f32x4 ga, gb; unpack8(r16[C_GB / 8 + cidx], ga, gb);
            y16[128 + cidx] = pack8(oa[j] * rstd * g[2 * cidx] * silu4(ga), ob[j] * rstd * g[2 * cidx + 1] * silu4(gb));
        }
    }
}

DI void naive_attn_row(const bf16_t* q, const bf16_t* k1, size_t k1s, const bf16_t* k2, size_t k2s, const bf16_t* v, size_t vs,
                       int t, int d, int nkeys, bf16_t* o, float* lse, LAS float* qs, int lane) {
    const int DK = k2 ? 192 : 128;
    for (int i = lane; i < DK; i += 64) qs[i] = __uint_as_float((unsigned)q[i] << 16);
    asm volatile("s_waitcnt lgkmcnt(0)" ::: "memory");
    float m = -1e30f, l = 0.f, o0 = 0.f, o1 = 0.f;
    for (int c0 = 0; c0 < nkeys; c0 += 64) {
        const int ik = c0 + lane; const bool valid = ik < nkeys; const int j = valid ? t - d * ik : t;
        float s = 0.f;
        const u32x4* kp = (const u32x4*)(k1 + (size_t)j * k1s);
#pragma unroll 4
        for (int ch = 0; ch < 16; ++ch) { f32x4 a, b; unpack8(kp[ch], a, b); const LAS f32x4* qq = (const LAS f32x4*)(qs + ch * 8); const f32x4 qa = qq[0], qb = qq[1];
            s += (a.x * qa.x + a.y * qa.y) + (a.z * qa.z + a.w * qa.w) + (b.x * qb.x + b.y * qb.y) + (b.z * qb.z + b.w * qb.w); }
        if (k2) { const u32x4* kp2 = (const u32x4*)(k2 + (size_t)j * k2s);
#pragma unroll 4
            for (int ch = 0; ch < 8; ++ch) { f32x4 a, b; unpack8(kp2[ch], a, b); const LAS f32x4* qq = (const LAS f32x4*)(qs + 128 + ch * 8); const f32x4 qa = qq[0], qb = qq[1];
                s += (a.x * qa.x + a.y * qa.y) + (a.z * qa.z + a.w * qa.w) + (b.x * qb.x + b.y * qb.y) + (b.z * qb.z + b.w * qb.w); } }
        s = valid ? s : -1e30f;
        const float mn = fmaxf(m, wave_max(s)); const float corr = exp2f(m - mn); const float pe = valid ? exp2f(s - mn) : 0.f;
        l = l * corr + wave_sum(pe); o0 *= corr; o1 *= corr; m = mn;
        const int cnt = min(64, nkeys - c0);
        for (int i = 0; i < cnt; ++i) { const float pi = __shfl(pe, i); const int jj = t - d * (c0 + i);
            const unsigned vv = *(const unsigned*)(v + (size_t)jj * vs + 2 * lane); o0 += pi * bflo(vv); o1 += pi * bfhi(vv); }
    }
    const float il = 1.0f / l;
    *(unsigned*)(o + 2 * lane) = pk2(o0 * il, o1 * il);
    if (lse && lane == 0) *lse = (m + log2f(l)) * LN2;
    asm volatile("s_waitcnt lgkmcnt(0)" ::: "memory");
}
DI void phase5_naive(const Params& p, LAS unsigned char* lds, int gw, int NGW, int lane, int wave, int type_lo, int type_hi) {
    unsigned char* ws = p.ws;
    LAS float* qs = (LAS float*)(lds + wave * 1024);
    const bf16_t* proj = (const bf16_t*)(ws + WS_PROJ); const bf16_t* qa = (const bf16_t*)(ws + WS_QA); const bf16_t* kva = (const bf16_t*)(ws + WS_KVA);
    for (int item = type_lo * TOK * 8 + gw; item < type_hi * TOK * 8; item += NGW) {
        const int type = item / (TOK * 8), rem = item % (TOK * 8), row = rem >> 3, h = rem & 7, b = row >> 12, t = row & (SEQ - 1);
        const size_t brow = (size_t)b * SEQ;
        if (type == 0) {
            naive_attn_row(qa + (size_t)row * QA_W + h * 192, kva + brow * KVA_W + h * 256, KVA_W, proj + brow * NCP + C_KR, NCP, kva + brow * KVA_W + h * 256 + 128, KVA_W,
                           t, 1, t + 1, (bf16_t*)(ws + WS_OA) + (size_t)row * 1024 + h * 128, nullptr, qs, lane);
        } else {
            const int pidx = type - 1, d = pidx == 0 ? 1 : (pidx == 1 ? 4 : 16);
            bf16_t* od = (bf16_t*)(ws + (pidx == 0 ? WS_OD1 : (pidx == 1 ? WS_OD2 : WS_OD3)));
            naive_attn_row(proj + (size_t)row * NCP + C_QB + h * 128, proj + brow * NCP + C_KB + h * 128, NCP, nullptr, 0, proj + brow * NCP + C_VB + h * 128, NCP,
                           t, d, min(t / d, 128) + 1, od + (size_t)row * 1024 + h * 128, (float*)(ws + WS_LSE) + (size_t)pidx * TOK * 8 + (size_t)row * 8 + h, qs, lane);
        }
    }
}

namespace fa {
typedef short bf16x8 __attribute__((ext_vector_type(8)));
typedef short s16x4 __attribute__((ext_vector_type(4)));
typedef float f32x16 __attribute__((ext_vector_type(16)));
#define FA_MFMA(a, b, c) __builtin_amdgcn_mfma_f32_32x32x16_bf16((a), (b), (c), 0, 0, 0)
struct Unit {
    const bf16_t* q; const bf16_t* q2; unsigned qs; const bf16_t* k1; unsigned k1s; const bf16_t* k2; unsigned k2s; const bf16_t* v; unsigned vs;
    bf16_t* o; unsigned os; float* lse; unsigned lses; int l0, kt_begin, W;
};
DI unsigned v_off(int row, int ch) { return 2048u * (row >> 3) + 512u * (ch >> 2) + 64u * (row & 7) + 16u * ((ch & 3) ^ ((row >> 2) & 3)); }

template <int DK>
DI void unit_run(const Unit& u, LAS unsigned char* lds, int tid, int lane, int wave) {
    constexpr int NKS = DK / 16;
    constexpr int K1BYTES = 64 * 256, K2BYTES = (DK == 192) ? 64 * 128 : 0, KBYTES = K1BYTES + K2BYTES, VBYTES = 64 * 256, STAGE = KBYTES + VBYTES;
    const int hi = lane >> 5, l31 = lane & 31;
    const int wq0 = u.l0 + 32 * wave, W = u.W;
    bf16x8 qf[NKS];
    if constexpr (DK == 192) {
        const unsigned qo = (unsigned)(wq0 + l31) * u.qs + 8u * hi;
#pragma unroll
        for (int ks = 0; ks < NKS; ++ks) qf[ks] = ks < 8 ? *(const bf16x8*)(u.q + (qo + 16u * ks)) : *(const bf16x8*)(u.q2 + (qo + 16u * (ks - 8)));
    } else {
#pragma unroll
        for (int n = 0; n < 8; ++n) { const int sl = n * 64 + lane, row = sl >> 4, cc = (sl & 15) ^ (row & 15);
            __builtin_amdgcn_global_load_lds((const unsigned*)(u.q + ((unsigned)(wq0 + row) * u.qs + 8u * cc)), (LAS unsigned*)(lds + 65536 + wave * 8192 + n * 1024), 16, 0, 0); }
    }
    const int ntiles = (u.l0 + 256 - u.kt_begin) >> 6;
#define FA_DMA(kt, st) do { LAS unsigned char* sb_ = lds + (st) * STAGE; \
        _Pragma("unroll") for (int n = 0; n < 2; ++n) { \
            { const int s = (2 * wave + n) * 64 + lane, row = s >> 4, cc = (s & 15) ^ (row & 15); \
              __builtin_amdgcn_global_load_lds((const unsigned*)(u.k1 + ((unsigned)((kt) + row) * u.k1s + 8u * cc)), (LAS unsigned*)(sb_ + (2 * wave + n) * 1024), 16, 0, 0); } \
            { const int s = (2 * wave + n) * 64 + lane, row = 8 * (s >> 7) + ((s >> 2) & 7), ch = 4 * ((s >> 5) & 3) + ((s & 3) ^ ((row >> 2) & 3)); \
              __builtin_amdgcn_global_load_lds((const unsigned*)(u.v + ((unsigned)((kt) + row) * u.vs + 8u * ch)), (LAS unsigned*)(sb_ + KBYTES + (2 * wave + n) * 1024), 16, 0, 0); } } \
        if (DK == 192) { const int s = wave * 64 + lane, row = s >> 3, cc = (s & 7) ^ ((row >> 1) & 7); \
            __builtin_amdgcn_global_load_lds((const unsigned*)(u.k2 + ((unsigned)((kt) + row) * u.k2s + 8u * cc)), (LAS unsigned*)(sb_ + K1BYTES + wave * 1024), 16, 0, 0); } } while (0)
    FA_DMA(u.kt_begin, 0);
    __syncthreads();
    if constexpr (DK == 128) {
        const unsigned xq1 = (unsigned)(l31 & 15), qa1 = (unsigned)(65536 + wave * 8192 + l31 * 256) + 16u * ((hi ^ xq1) & 1u), qx1 = 16u * (xq1 & 14u);
#pragma unroll
        for (int ks = 0; ks < NKS; ++ks) qf[ks] = *(const LAS bf16x8*)(lds + qa1 + ((32u * ks) ^ qx1));
    }
    f32x16 O[4];
#pragma unroll
    for (int c = 0; c < 4; ++c)
#pragma unroll
        for (int r = 0; r < 16; ++r) O[c][r] = 0.f;
    float m = -1e30f, l = 0.f;
    const unsigned x1 = (unsigned)(l31 & 15), x2 = (unsigned)((l31 >> 1) & 7);
    const unsigned ka1 = (unsigned)(l31 * 256) + 16u * ((hi ^ x1) & 1u), kx1 = 16u * (x1 & 14u);
    const unsigned ka2 = (unsigned)(K1BYTES + l31 * 128) + 16u * ((hi ^ x2) & 1u), kx2 = 16u * (x2 & 6u);
    const int q4 = (lane & 15) >> 2, p4 = lane & 3, blk = (lane >> 4) & 1;
    const unsigned va0 = (unsigned)(KBYTES + 64 * (4 * hi + q4) + 16 * ((2 * blk + (p4 >> 1)) ^ (hi)) + 8 * (p4 & 1));
    const unsigned va1 = (unsigned)(KBYTES + 64 * (4 * hi + q4) + 16 * ((2 * blk + (p4 >> 1)) ^ (2 + hi)) + 8 * (p4 & 1));
    for (int it = 0; it < ntiles; ++it) {
        const int kt0 = u.kt_begin + 64 * it, cur = it & 1;
        if (it + 1 < ntiles) FA_DMA(kt0 + 64, cur ^ 1);
        const bool relevant = (kt0 <= wq0 + 31) && (kt0 + 63 >= wq0 - W);
        if (relevant) {
            const LAS unsigned char* sb = lds + cur * STAGE;
            f32x16 S0, S1;
#pragma unroll
            for (int r = 0; r < 16; ++r) { S0[r] = 0.f; S1[r] = 0.f; }
#pragma unroll
            for (int ks = 0; ks < NKS; ++ks) {
                const unsigned ko = ks < 8 ? ka1 + ((32u * ks) ^ kx1) : ka2 + ((32u * (ks - 8)) ^ kx2);
                S0 = FA_MFMA(*(const LAS bf16x8*)(sb + ko), qf[ks], S0);
            }
#pragma unroll
            for (int ks = 0; ks < NKS; ++ks) {
                const unsigned ko = ks < 8 ? ka1 + ((32u * ks) ^ kx1) : ka2 + ((32u * (ks - 8)) ^ kx2);
                S1 = FA_MFMA(*(const LAS bf16x8*)(sb + ko + (ks < 8 ? 32 * 256 : 32 * 128)), qf[ks], S1);
            }
            const bool needmask = !((kt0 + 63 <= wq0) && (kt0 >= wq0 + 31 - W));
            const int dq = wq0 + l31 - kt0 - 4 * hi;
#define FA_HALF(S, KB) do { \
            if (needmask) { _Pragma("unroll") for (int r = 0; r < 16; ++r) { const int d0 = dq - 32 * (KB) - ((r & 3) + 8 * (r >> 2)); S[r] = (d0 >= 0 && d0 <= W) ? S[r] : -INFINITY; } } \
            float mx = fmaxf(S[0], S[1]); \
            _Pragma("unroll") for (int r = 2; r < 16; ++r) mx = fmaxf(mx, S[r]); \
            mx = fmaxf(mx, __shfl_xor(mx, 32)); \
            if (__builtin_amdgcn_ballot_w64(mx > m + 8.0f) != 0ull) {         \
                const float mn = fmaxf(m, mx); const float corr = __builtin_amdgcn_exp2f(m - mn); m = mn; l *= corr; \
                _Pragma("unroll") for (int c = 0; c < 4; ++c) _Pragma("unroll") for (int r = 0; r < 16; ++r) O[c][r] *= corr; } \
            float ps = 0.f; \
            _Pragma("unroll") for (int r = 0; r < 16; ++r) { S[r] = __builtin_amdgcn_exp2f(S[r] - m); ps += S[r]; } \
            l += ps; \
            bf16x8 P[2]; \
            _Pragma("unroll") for (int j = 0; j < 2; ++j) { u32x4 w; w.x = pk2(S[8 * j + 0], S[8 * j + 1]); w.y = pk2(S[8 * j + 2], S[8 * j + 3]); w.z = pk2(S[8 * j + 4], S[8 * j + 5]); w.w = pk2(S[8 * j + 6], S[8 * j + 7]); \
                P[j] = __builtin_bit_cast(bf16x8, w); } \
            _Pragma("unroll") for (int j = 0; j < 2; ++j) _Pragma("unroll") for (int c = 0; c < 4; ++c) { \
                const s16x4 lo = __builtin_amdgcn_ds_read_tr16_b64_v4i16((LAS s16x4*)(sb + va0 + 2048 * (4 * (KB) + 2 * j) + 512 * c)); \
                const s16x4 hv = __builtin_amdgcn_ds_read_tr16_b64_v4i16((LAS s16x4*)(sb + va1 + 2048 * (4 * (KB) + 2 * j + 1) + 512 * c)); \
                O[c] = FA_MFMA(__builtin_shufflevector(lo, hv, 0, 1, 2, 3, 4, 5, 6, 7), P[j], O[c]); } } while (0)
            FA_HALF(S0, 0);
            FA_HALF(S1, 1);
#undef FA_HALF
        }
        __syncthreads();
    }
#undef FA_DMA
    l += __shfl_xor(l, 32);
    const float il = 1.0f / l;
    LAS unsigned char* og = lds + wave * 8704;
#pragma unroll
    for (int c = 0; c < 4; ++c)
#pragma unroll
        for (int g = 0; g < 4; ++g) {
            u32x2 w; w.x = pk2(O[c][4 * g + 0] * il, O[c][4 * g + 1] * il); w.y = pk2(O[c][4 * g + 2] * il, O[c][4 * g + 3] * il);
            *(LAS u32x2*)(og + l31 * 272 + 2 * (32 * c + 8 * g + 4 * hi)) = w;
        }
    asm volatile("s_waitcnt lgkmcnt(0)" ::: "memory");
#pragma unroll
    for (int i = 0; i < 8; ++i) {
        const int row = (lane >> 4) + 4 * i;
        const u32x4 v = *(const LAS u32x4*)(og + row * 272 + 16 * (lane & 15));
        *(u32x4*)(u.o + ((unsigned)(wq0 + row) * u.os + 8u * (lane & 15))) = v;
    }
    if (u.lse && hi == 0) u.lse[(unsigned)(wq0 + l31) * u.lses] = (m + __builtin_amdgcn_logf(l)) * LN2;
    asm volatile("s_waitcnt lgkmcnt(0)" ::: "memory"); __builtin_amdgcn_s_barrier(); asm volatile("" ::: "memory");
}
}

DI void phase5_fast(const Params& p, LAS unsigned char* lds) {
    int tid = threadIdx.x; asm volatile("" : "+v"(tid));
    const int lane = tid & 63, wave = __builtin_amdgcn_readfirstlane(tid >> 6);
    unsigned char* ws = p.ws;
    const int G = gridDim.x, bid = blockIdx.x;
    const bf16_t* proj = (const bf16_t*)(ws + WS_PROJ); const bf16_t* qa = (const bf16_t*)(ws + WS_QA); const bf16_t* kva = (const bf16_t*)(ws + WS_KVA);
    if (FAST_MLA) for (int pi = bid; pi < 256; pi += G) {
        const int vv = pi >> 3, bh = (pi & 7) * 4 + (vv >> 3), j = vv & 7, b = bh >> 3, h = bh & 7;
        const size_t brow = (size_t)b * SEQ;
#pragma unroll 1
        for (int s = 0; s < 2; ++s) {
            const int qb = s == 0 ? 15 - j : j;
            fa::Unit u;
            u.q = qa + brow * QA_W + h * 128; u.q2 = qa + brow * QA_W + 1024 + h * 64; u.qs = QA_W;
            u.k1 = kva + brow * KVA_W + h * 256; u.k1s = KVA_W; u.k2 = proj + brow * NCP + C_KR; u.k2s = NCP;
            u.v = kva + brow * KVA_W + h * 256 + 128; u.vs = KVA_W;
            u.o = (bf16_t*)(ws + WS_OA) + brow * 1024 + h * 128; u.os = 1024; u.lse = nullptr; u.lses = 0;
            u.l0 = 256 * qb; u.kt_begin = 0; u.W = 1 << 30;
            fa::unit_run<192>(u, lds, tid, lane, wave);
        }
    }
    if (FAST_DIL)
#pragma unroll 1
    for (int ui = bid; ui < 1536; ui += G) {
        int pidx, b, h, sub;
        if (G == 256) { const int i6 = ui >> 8, x8 = ui & 7, k32 = (ui >> 3) & 31, bh = 4 * x8 + 2 * (i6 / 3) + (k32 >> 4); pidx = i6 % 3; b = bh >> 3; h = bh & 7; sub = k32 & 15; }
        else { const int xq = ui & 7, yq = (ui >> 3) & 31, grp = (ui >> 8) * 32 + (yq >> 3) * 8 + xq; h = yq & 7; pidx = grp >> 6; b = (grp >> 4) & 3; sub = grp & 15; }
        const int d = pidx == 0 ? 1 : (pidx == 1 ? 4 : 16), nub = 16 / d, r = sub / nub, ub = sub % nub;
        const size_t row0 = (size_t)b * SEQ + r;
        fa::Unit u;
        u.q = proj + row0 * NCP + C_QB + h * 128; u.q2 = nullptr; u.qs = (unsigned)d * NCP;
        u.k1 = proj + row0 * NCP + C_KB + h * 128; u.k1s = (unsigned)d * NCP; u.k2 = nullptr; u.k2s = 0;
        u.v = proj + row0 * NCP + C_VB + h * 128; u.vs = (unsigned)d * NCP;
        u.o = (bf16_t*)(ws + (pidx == 0 ? WS_OD1 : (pidx == 1 ? WS_OD2 : WS_OD3))) + row0 * 1024 + h * 128; u.os = (unsigned)d * 1024;
        u.lse = (float*)(ws + WS_LSE) + (size_t)pidx * TOK * 8 + row0 * 8 + h; u.lses = (unsigned)d * 8;
        u.l0 = 256 * ub; u.kt_begin = u.l0 >= 128 ? u.l0 - 128 : 0; u.W = 128;
        fa::unit_run<128>(u, lds, tid, lane, wave);
    }
}

#define XB_TMO      128
#define XB_XCNT(j)  (256  + 64 * (j))
#define XB_XSUB(j)  (1280 + 64 * (j))
#define XB_XGEN(j)  (2304 + 64 * (j))
#define XB_TOP      3328
#define XB_TOPGEN   3392
#define XCD_BAR_WORDS 3456
#define XB_SPIN_CAP (1u << 18)

__device__ __forceinline__ unsigned xb_ld(unsigned* p)              { return __hip_atomic_load(p, __ATOMIC_RELAXED, __HIP_MEMORY_SCOPE_AGENT); }
__device__ __forceinline__ unsigned xb_add(unsigned* p, unsigned v) { return __hip_atomic_fetch_add(p, v, __ATOMIC_RELAXED, __HIP_MEMORY_SCOPE_AGENT); }
__device__ __forceinline__ unsigned xb_xcc_id() { return (unsigned)__builtin_amdgcn_s_getreg((3 << 11) | 20) & 0xFu; }
#define XB_SPIN(cond, bar) do { unsigned _sp = 0; while (cond) { __builtin_amdgcn_s_sleep(1); \
    if ((++_sp & 255u) == 0u) { if (xb_ld(&(bar)[XB_TMO])) break; if (_sp > XB_SPIN_CAP) { atomicAdd(&(bar)[XB_TMO], 1u); break; } } } } while (0)

struct XcdBarrier {
    unsigned* bar; unsigned x;
    volatile LAS unsigned* st;
};

__device__ __forceinline__ XcdBarrier xcd_barrier_post(unsigned* bar, volatile LAS unsigned* st) {
    XcdBarrier b; b.bar = bar; b.x = xb_xcc_id(); b.st = st;
    if (threadIdx.x == 0) (void)xb_add(&bar[XB_XCNT(b.x)], 1u);
    return b;
}
__device__ __forceinline__ void xcd_barrier_complete(unsigned* bar, unsigned x, unsigned& nloc, unsigned& nx) {
    const unsigned G = gridDim.x * gridDim.y * gridDim.z;
    unsigned sum, cnt, mine, sp = 0u;
    for (;;) {
        sum = 0u; cnt = 0u; mine = 0u;
#pragma unroll
        for (unsigned j = 0; j < 16; ++j) { const unsigned c = xb_ld(&bar[XB_XCNT(j)]); sum += c; cnt += (c > 0u) ? 1u : 0u; mine = (j == x) ? c : mine; }
        if (sum == G) break;
        __builtin_amdgcn_s_sleep(1);
        if ((++sp & 255u) == 0u) { if (xb_ld(&bar[XB_TMO])) break; if (sp > XB_SPIN_CAP) { atomicAdd(&bar[XB_TMO], 1u); break; } }
    }
    nloc = mine > 0u ? mine : 1u; nx = cnt > 0u ? cnt : 1u;
}

__device__ __forceinline__ void xcd_barrier(const XcdBarrier& b) {
    asm volatile("s_waitcnt vmcnt(0)" ::: "memory");
    __syncthreads();
    if (threadIdx.x == 0) {
        unsigned* bar = b.bar;
        __builtin_amdgcn_s_waitcnt(0);
        unsigned nloc = b.st[0], nx = b.st[1];
        if (nloc == 0u) { xcd_barrier_complete(bar, b.x, nloc, nx); b.st[0] = nloc; b.st[1] = nx; }
        const unsigned old = xb_add(&bar[XB_XSUB(b.x)], 1u);
        const unsigned gen = old / nloc;
        if (old + 1u == (gen + 1u) * nloc) {
            __builtin_amdgcn_fence(__ATOMIC_RELEASE, "agent");
            asm volatile("s_waitcnt vmcnt(0)" ::: "memory");
            const unsigned og = xb_add(&bar[XB_TOP], 1u);
            const unsigned tg = og / nx;
            if (og + 1u == (tg + 1u) * nx) xb_add(&bar[XB_TOPGEN], 1u);
            else XB_SPIN(xb_ld(&bar[XB_TOPGEN]) == tg, bar);
            __builtin_amdgcn_fence(__ATOMIC_ACQUIRE, "agent");
            xb_add(&bar[XB_XGEN(b.x)], 1u);
            asm volatile("s_waitcnt vmcnt(0)" ::: "memory");
        } else {
            XB_SPIN(xb_ld(&bar[XB_XGEN(b.x)]) == gen, bar);
            __builtin_amdgcn_fence(__ATOMIC_ACQUIRE, "agent");
            asm volatile("s_waitcnt vmcnt(0)" ::: "memory");
        }
    }
    __syncthreads();
}

__global__ void __launch_bounds__(512, 2) fwd_kernel(Params p) {
    extern __shared__ __attribute__((aligned(16))) unsigned char lds_raw[];
    LAS unsigned char* lds = (LAS unsigned char*)lds_raw;
    cg::grid_group grid = cg::this_grid();
    const int tid = threadIdx.x, lane = tid & 63, wave = __builtin_amdgcn_readfirstlane(tid >> 6);
    const int G = gridDim.x, gw = blockIdx.x * 8 + wave, NGW = G * 8;
    unsigned char* ws = p.ws;
    const int lo = p.ph_lo, hi = p.ph_hi;
#define IN(k) (lo <= (k) && (k) < hi)
#ifndef COOP_SEAM
#define COOP_SEAM -1
#endif
    volatile LAS unsigned* bst = (volatile LAS unsigned*)(lds + LDS_BYTES - 64);
    if (tid == 0) { bst[0] = 0u; bst[1] = 0u; }
    __syncthreads();
    XcdBarrier bar = xcd_barrier_post((unsigned*)(ws + WS_CTL), bst);
    if (p.ph_lo < 0) grid.sync();
    unsigned long long t0_ = 0, t1_ = 0;
#define PB0(k) do { if (PROBE_PHASE == (k)) t0_ = __builtin_amdgcn_s_memrealtime(); } while (0)
#define PB1(k) do { if (PROBE_PHASE == (k)) t1_ = __builtin_amdgcn_s_memrealtime(); } while (0)
#define SEAM(k) do { if (IN(k) && IN((k) + 1)) { if ((k) == COOP_SEAM) grid.sync(); else xcd_barrier(bar); } } while (0)

    PB0(0);
    for (int rep_ = 0; rep_ < (DUP_PHASE == 0 ? 2 : 1); ++rep_) if (IN(0)) { phase0(p, lds, gw, NGW, lane, wave, 0); } SEAM(0); PB1(0);

    PB0(1);
    for (int rep_ = 0; rep_ < (DUP_PHASE == 1 ? 2 : 1); ++rep_) if (IN(1)) {
        pg8::Gemm g{(const bf16_t*)(ws + WS_HN), (const bf16_t*)(ws + WS_WIN), TOK, NCP, DM, DM}; pg8::StaticOrder S; S.init(TOK, NCP, G, (int)blockIdx.x);
        pg8::EpiProj E{(bf16_t*)(ws + WS_PROJ), (float*)(ws + WS_SSQ), (const float*)(ws + WS_GAINS), (const f32x4*)(ws + WS_TAB128), (LAS float*)(lds + XCH_OFF)};
        pg8::gemm_phase<pg8::EpiProj, pg8::StaticOrder, PG8_ALIGN, PG8_SP2>(lds, g, S, E);
        const int nfull = (TOK / 256) * (NCP / 256) % G, nidle = nfull == 0 ? G : G - nfull;
        if (nfull == 0 || (int)blockIdx.x >= nfull) phase0(p, lds, ((int)blockIdx.x - (nfull == 0 ? 0 : nfull)) * 8 + wave, nidle * 8, lane, wave, 1);
    } SEAM(1); PB1(1);


    PB0(3);
    for (int rep_ = 0; rep_ < (DUP_PHASE == 3 ? 2 : 1); ++rep_) if (IN(3)) {
        { pg8::Gemm g{(const bf16_t*)(ws + WS_PROJ) + C_CQ, (const bf16_t*)(ws + WS_WUQ), TOK, QA_W, 768, NCP}; pg8::StaticOrder S; S.init(TOK, QA_W, G, (int)blockIdx.x);
          pg8::EpiUp<0> E{(bf16_t*)(ws + WS_QA), QA_W, (const float*)(ws + WS_SSQ), 1.0f / 768.0f, p.in[7], (const f32x4*)(ws + WS_TAB64), (LAS float*)(lds + XCH_OFF)};
          pg8::gemm_phase<pg8::EpiUp<0>, pg8::StaticOrder, PG8_ALIGN, PG8_SP2>(lds, g, S, E); }
        __syncthreads();
        { pg8::Gemm g{(const bf16_t*)(ws + WS_PROJ) + C_CKV, (const bf16_t*)(ws + WS_WUKV), TOK, KVA_W, 512, NCP}; pg8::StaticOrder S; S.init(TOK, KVA_W, G, (int)blockIdx.x);
          pg8::EpiUp<1> E{(bf16_t*)(ws + WS_KVA), KVA_W, (const float*)(ws + WS_SSQ) + TOK, 1.0f / 512.0f, p.in[8], (const f32x4*)(ws + WS_TAB64), (LAS float*)(lds + XCH_OFF)};
          pg8::gemm_phase<pg8::EpiUp<1>, pg8::StaticOrder, PG8_ALIGN, PG8_SP2>(lds, g, S, E); }
    } SEAM(3); PB1(3);


    PB0(5);
    for (int rep_ = 0; rep_ < (DUP_PHASE == 5 ? 2 : 1); ++rep_) if (IN(5)) {
        if (!FAST_MLA) phase5_naive(p, lds, gw, NGW, lane, wave, 0, 1);
        if (!FAST_DIL) phase5_naive(p, lds, gw, NGW, lane, wave, 1, 4);
        if (FAST_MLA || FAST_DIL) { __syncthreads(); phase5_fast(p, lds); }
    } SEAM(5); PB1(5);

    PB0(6);
    for (int rep_ = 0; rep_ < (DUP_PHASE == 6 ? 2 : 1); ++rep_) if (IN(6)) { for (int m = gw; m < TOK; m += NGW) e3_row(p, m, lane); } SEAM(6); PB1(6);

    PB0(7);
    for (int rep_ = 0; rep_ < (DUP_PHASE == 7 ? 2 : 1); ++rep_) if (IN(7)) {
        pg8::Gemm g{(const bf16_t*)(ws + WS_Y), (const bf16_t*)(ws + WS_WOUT), TOK, DM, DM, DM}; pg8::StaticOrder S; S.init(TOK, DM, G, (int)blockIdx.x);
        pg8::EpiResF32 E{p.in[0], p.out, DM};
        pg8::gemm_phase<pg8::EpiResF32, pg8::StaticOrder, false, PG8_SP2>(lds, g, S, E);
    }
    if (PROBE_PHASE >= 0 && hi - lo > 1) {
        xcd_barrier(bar); PB1(7);
        if (blockIdx.x == 0 && tid == 0) p.out[0] += (float)(t1_ - t0_) * 0.01f;
    }
#if defined(EXTRA_SYNCS)
    if (hi - lo > 1) for (int i = 0; i < EXTRA_SYNCS; ++i) xcd_barrier(bar);
#endif
#undef IN
#undef SEAM
}

extern "C" void kernel_launch(void* const* d_in, const int* in_sizes, int n_in, void* d_out, int out_size, void* d_ws, size_t ws_size, hipStream_t stream) {
    static int grid = 0;
    if (grid == 0) {
        if (n_in != 14 || in_sizes[0] != TOK * DM || out_size != TOK * DM || ws_size < WS_END) {
            fprintf(stderr, "kernel_launch: unexpected shapes: n_in %d in0 %d out %d ws %zu (need %zu)\n", n_in, n_in > 0 ? in_sizes[0] : -1, out_size, ws_size, (size_t)WS_END); grid = -1; return; }
        int dev = 0, cus = 0, per_cu = 0;
        if (hipGetDevice(&dev) != hipSuccess || hipDeviceGetAttribute(&cus, hipDeviceAttributeMultiprocessorCount, dev) != hipSuccess) { fprintf(stderr, "kernel_launch: device query failed\n"); grid = -1; return; }
        if (hipFuncSetAttribute((const void*)fwd_kernel, hipFuncAttributeMaxDynamicSharedMemorySize, LDS_BYTES) != hipSuccess) { fprintf(stderr, "kernel_launch: hipFuncSetAttribute failed\n"); grid = -1; return; }
        if (hipOccupancyMaxActiveBlocksPerMultiprocessor(&per_cu, (const void*)fwd_kernel, 512, LDS_BYTES) != hipSuccess || per_cu < 1) { fprintf(stderr, "kernel_launch: occupancy query says %d blocks per CU\n", per_cu); (void)hipGetLastError(); grid = -1; return; }
        grid = cus * 1;
        fprintf(stderr, "kernel_launch: cus %d per_cu %d grid %d\n", cus, per_cu, grid);
    }
    if (grid < 0) return;
    if (hipMemsetAsync((char*)d_ws + WS_CTL, 0, CTL_BYTES, stream) != hipSuccess) { fprintf(stderr, "kernel_launch: memset of the barrier words failed\n"); return; }
    Params p{};
    for (int i = 0; i < 14; ++i) p.in[i] = (const float*)d_in[i];
    p.out = (float*)d_out; p.ws = (unsigned char*)d_ws;
#if MK_N_LAUNCHES == 1
    p.ph_lo = 0; p.ph_hi = NPH;
    void* args[] = {&p};
#if defined(PLAIN_LAUNCH)
    (void)args; hipLaunchKernelGGL(fwd_kernel, dim3(grid), dim3(512), LDS_BYTES, stream, p); const hipError_t e = hipPeekAtLastError();
#else
    const hipError_t e = hipLaunchCooperativeKernel((const void*)fwd_kernel, dim3(grid), dim3(512), args, LDS_BYTES, stream);
#endif
    if (e != hipSuccess) fprintf(stderr, "kernel_launch: cooperative launch failed: %s (grid %d)\n", hipGetErrorString(e), grid);
#else
    for (int ph = 0; ph < NPH; ++ph) {
        p.ph_lo = ph; p.ph_hi = ph + 1;
        hipLaunchKernelGGL(fwd_kernel, dim3(grid), dim3(512), LDS_BYTES, stream, p);
        const hipError_t e = hipPeekAtLastError();
        if (e != hipSuccess) { fprintf(stderr, "kernel_launch: launch %d failed: %s\n", ph, hipGetErrorName(e)); break; }
    }
#endif
}
```
